# Optimizing an MI355X kernel written in HIP

```python
import math
import jax, jax.numpy as jnp
from jax import lax
import numpy as np

D_MODEL = 4096
BATCH = 1
SEQ = 8192
DEPTH = 1

CHUNK = 64
GMLP_BLOCK = 128
GMLP_GROUPS = 16
GMLP_WIDTH = D_MODEL // 2
GMLP_GROUP_DIM = GMLP_WIDTH // GMLP_GROUPS
SB_HEAD_DIM = 128
SB_HEADS = (D_MODEL // 2) // SB_HEAD_DIM
SB_WIDTH = SB_HEADS * SB_HEAD_DIM
Q_BLOCK = 128
D_FF = 4 * D_MODEL
N_MOD = 6
EPS = 1e-6
IN_COLS = 2 * GMLP_WIDTH + 3 * SB_WIDTH + 2 * D_MODEL

kernel_name = "hybrid_gmlp_stickbreaking_block"


def rms_norm(x, g):
    xf = x.astype(jnp.float32)
    inv = lax.rsqrt(jnp.mean(xf * xf, axis=-1, keepdims=True) + EPS)
    return (xf * inv * g.astype(jnp.float32)).astype(x.dtype)


def layer_norm(x, g):
    xf = x.astype(jnp.float32)
    mu = jnp.mean(xf, axis=-1, keepdims=True)
    xc = xf - mu
    inv = lax.rsqrt(jnp.mean(xc * xc, axis=-1, keepdims=True) + EPS)
    return (xc * inv * g.astype(jnp.float32)).astype(x.dtype)


def gmlp_branch(zuv, g_v, w_s, b_s):
    B, S, _ = zuv.shape
    zuv = jax.nn.gelu(zuv, approximate=False)
    u, v = jnp.split(zuv, 2, axis=-1)
    v = layer_norm(v, g_v)
    nblk = S // GMLP_BLOCK
    v = v.reshape(B, nblk, GMLP_BLOCK, GMLP_GROUPS, GMLP_GROUP_DIM)
    pos = jnp.arange(GMLP_BLOCK)
    mask = (pos[:, None] // CHUNK) >= (pos[None, :] // CHUNK)
    w = jnp.where(mask[None], w_s, jnp.zeros((), w_s.dtype))
    y = jnp.einsum('gts,bnsgc->bntgc', w, v) + b_s.T[None, None, :, :, None]
    y = y.reshape(B, S, GMLP_WIDTH)
    return u * y


def stick_breaking_branch(q, k, v):
    B, S, _ = q.shape
    to_heads = lambda t: t.reshape(B, S, SB_HEADS, SB_HEAD_DIM).transpose(0, 2, 1, 3)
    qh = to_heads(q).astype(jnp.float32)
    kh = to_heads(k).astype(jnp.float32)
    vh = to_heads(v).astype(jnp.float32)
    nb = S // Q_BLOCK
    qb = qh.reshape(B, SB_HEADS, nb, Q_BLOCK, SB_HEAD_DIM).transpose(2, 0, 1, 3, 4)
    key_pos = jnp.arange(S)
    scale = 1.0 / math.sqrt(SB_HEAD_DIM)

    def one_block(args):
        q_blk, blk = args
        z = jnp.einsum('bhqd,bhkd->bhqk', q_blk, kh) * scale
        qpos = blk * Q_BLOCK + jnp.arange(Q_BLOCK)
        mask = key_pos[None, :] < qpos[:, None]
        log_beta = jax.nn.log_sigmoid(z)
        log_one_minus = jnp.where(mask, jax.nn.log_sigmoid(-z), 0.0)
        between = lax.cumsum(log_one_minus, axis=3, reverse=True) - log_one_minus
        a = jnp.where(mask, jnp.exp(log_beta + between), 0.0)
        return jnp.einsum('bhqk,bhkd->bhqd', a, vh)

    o = lax.map(one_block, (qb, jnp.arange(nb)))
    o = o.transpose(1, 0, 3, 2, 4).reshape(B, S, SB_WIDTH)
    return o.astype(q.dtype)


def setup_inputs(seed: int = 0) -> dict:
    key = jax.random.key(seed)
    ks = jax.random.split(key, 20)
    f32 = jnp.float32
    nrm = lambda k, shape, s: jax.random.normal(k, shape, f32) * s
    L = DEPTH
    return {
        "x": nrm(ks[0], (BATCH, SEQ, D_MODEL), 1.0),
        "c": nrm(ks[1], (BATCH, D_MODEL), 1.0),
        "w_ada": nrm(ks[2], (L, D_MODEL, N_MOD * D_MODEL), 0.2 * D_MODEL ** -0.5),
        "b_ada": nrm(ks[3], (L, N_MOD * D_MODEL), 0.05),
        "g_pre_mix": 1.0 + nrm(ks[4], (L, D_MODEL), 0.05),
        "w_in": nrm(ks[5], (L, D_MODEL, IN_COLS), D_MODEL ** -0.5),
        "g_v": 1.0 + nrm(ks[6], (L, GMLP_WIDTH), 0.05),
        "w_s": nrm(ks[7], (L, GMLP_GROUPS, GMLP_BLOCK, GMLP_BLOCK), GMLP_BLOCK ** -0.5),
        "b_s": 1.0 + nrm(ks[8], (L, GMLP_GROUPS, GMLP_BLOCK), 0.1),
        "w_proj_a": nrm(ks[9], (L, GMLP_WIDTH, D_MODEL), GMLP_WIDTH ** -0.5),
        "w_proj_b": nrm(ks[10], (L, SB_WIDTH, D_MODEL), SB_WIDTH ** -0.5),
        "w_o": nrm(ks[11], (L, D_MODEL, D_MODEL), D_MODEL ** -0.5),
        "g_post_mix": 1.0 + nrm(ks[12], (L, D_MODEL), 0.05),
        "g_pre_mlp": 1.0 + nrm(ks[13], (L, D_MODEL), 0.05),
        "w_ff1": nrm(ks[14], (L, D_MODEL, D_FF), D_MODEL ** -0.5),
        "w_ff2": nrm(ks[15], (L, D_FF, D_MODEL), D_FF ** -0.5),
        "g_post_mlp": 1.0 + nrm(ks[16], (L, D_MODEL), 0.05),
    }


def reference(x, c, w_ada, b_ada, g_pre_mix, w_in, g_v, w_s, b_s, w_proj_a,
              w_proj_b, w_o, g_post_mix, g_pre_mlp, w_ff1, w_ff2, g_post_mlp):
    cut = [int(i) for i in np.cumsum([2 * GMLP_WIDTH, SB_WIDTH, SB_WIDTH, SB_WIDTH, D_MODEL])]
    for l in range(DEPTH):
        mod = (jax.nn.silu(c) @ w_ada[l] + b_ada[l])[:, None, :]
        sh1, sc1, gt1, sh2, sc2, gt2 = jnp.split(mod, N_MOD, axis=-1)

        h = rms_norm(x, g_pre_mix[l]) * (1.0 + sc1) + sh1
        proj = h @ w_in[l]
        zuv, q, k, v, gate_a, gate_b = jnp.split(proj, cut, axis=-1)
        y_a = gmlp_branch(zuv, g_v[l], w_s[l], b_s[l]) @ w_proj_a[l]
        y_b = stick_breaking_branch(q, k, v) @ w_proj_b[l]
        mix = (jax.nn.sigmoid(gate_a) * y_a + jax.nn.sigmoid(gate_b) * y_b) @ w_o[l]
        x = x + gt1 * rms_norm(mix, g_post_mix[l])

        h2 = rms_norm(x, g_pre_mlp[l]) * (1.0 + sc2) + sh2
        ff = jnp.square(jax.nn.relu(h2 @ w_ff1[l])) @ w_ff2[l]
        x = x + gt2 * rms_norm(ff, g_post_mlp[l])
    return x
```

```cpp
#include <hip/hip_runtime.h>
#include <cstdio>
#include <cstdint>
namespace pg8 {
#define PG8_LAS __attribute__((address_space(3)))
typedef unsigned short bf16_t;
typedef short bf16x8 __attribute__((ext_vector_type(8)));
typedef float f32x4 __attribute__((ext_vector_type(4)));
typedef unsigned u32x4 __attribute__((ext_vector_type(4)));
constexpr int BM = 256, BK = 64, HALF = 128, HTB = HALF * BK * 2  , STAGE_BYTES = 8 * HTB, NXCD = 8, WGM = 8;

__host__ __device__ __forceinline__ int lds_byte(int r, int c) { const int st = (r >> 4) * 2 + (c >> 5), rr = r & 15, cc = c & 31, ob = rr * 64 + cc * 2; return st * 1024 + (ob ^ (((ob >> 9) & 1) << 5)); }
__host__ __device__ __forceinline__ void stage_rc(int b, int& R, int& C) { const int st = b / 1024, sb = b % 1024, swz = sb ^ (((sb >> 9) & 1) << 5); R = (st >> 1) * 16 + swz / 64; C = (st & 1) * 32 + (swz % 64) / 2; }
__host__ __device__ __forceinline__ int perm32(int rho) { const int n = rho >> 4, i = rho & 15; return 8 * (i >> 2) + 4 * n + (i & 3); }

struct Unit { int pm, pn; };
struct Gemm { const bf16_t* A; const bf16_t* Bt; int M, N, K; };

struct StaticOrder {
    int nM, nN, nwg, G, c;
    __host__ __device__ void init(int M, int N, int G_, int c_) { nM = M / BM; nN = N / BM; nwg = nM * nN; G = G_; c = c_; }
    __host__ __device__ bool next(int i, Unit& u) const {
        const long L = (long)i * G + c; if (L >= nwg) return false;
        int wgid = (int)L; { const int q = nwg / NXCD, r = nwg % NXCD, xcd = wgid % NXCD, off = wgid / NXCD; wgid = (xcd < r ? xcd * (q + 1) : r * (q + 1) + (xcd - r) * q) + off; }
        const int nig = WGM * nN, gid = wgid / nig, fm = gid * WGM, gsz = (nM - fm) < WGM ? (nM - fm) : WGM;
        u.pm = fm + ((wgid % nig) % gsz); u.pn = (wgid % nig) / gsz; return true;
    }
    __device__ __forceinline__ void a_ready(const Unit&) const {}
    __device__ __forceinline__ void done(const Unit&) const {}
};

typedef float f32x2_c __attribute__((ext_vector_type(2))); typedef __bf16 bf16x2_c __attribute__((ext_vector_type(2)));
__device__ __forceinline__ unsigned cvt_pk_bf16(float lo, float hi) { f32x2_c v = {lo, hi}; bf16x2_c b = __builtin_convertvector(v, bf16x2_c); return __builtin_bit_cast(unsigned, b); }
typedef float f32x2 __attribute__((ext_vector_type(2)));
__device__ __forceinline__ f32x2 gelu_pk(f32x2 v) {
    const f32x2 av = __builtin_elementwise_abs(v), d = av * 0.2316418882f + 1.0f;
    f32x2 t; t.x = __builtin_amdgcn_rcpf(d.x); t.y = __builtin_amdgcn_rcpf(d.y);
    f32x2 q = t * 0.5307027145f + (-0.7265760135f); q = q * t + 0.7107068705f; q = q * t + (-0.142248368f); q = q * t + 0.127414796f; q = q * t;
    const f32x2 s = (v * v) * (-0.72134752044f);
    f32x2 e; e.x = __builtin_amdgcn_exp2f(s.x); e.y = __builtin_amdgcn_exp2f(s.y);
    const f32x2 m = v * (q * e), r = v - m;
    f32x2 o; o.x = v.x < 0.f ? m.x : r.x; o.y = v.y < 0.f ? m.y : r.y; return o;
}
__device__ __forceinline__ float sigmoid_f(float x) { return __builtin_amdgcn_rcpf(1.0f + __builtin_amdgcn_exp2f(-1.4426950408889634f * x)); }
__device__ __forceinline__ float bf_lo(unsigned u) { return __builtin_bit_cast(float, u << 16); }
__device__ __forceinline__ float bf_hi(unsigned u) { return __builtin_bit_cast(float, u & 0xffff0000u); }

template <int ACT> __device__ __forceinline__ void epi_store_tile(const f32x4 (&acc)[2][2][4][2], bf16_t* base, size_t ld, size_t bjstride, int row0, int c8, float scale) {
#pragma unroll
    for (int ai = 0; ai < 2; ++ai)
#pragma unroll
        for (int m = 0; m < 4; ++m) { bf16_t* rowp = base + (size_t)(row0 + ai * HALF + m * 16) * ld + c8;
#pragma unroll
            for (int bj = 0; bj < 2; ++bj) { f32x4 v0 = acc[ai][bj][m][0], v1 = acc[ai][bj][m][1];
                if (ACT == 1) {
#pragma unroll
                    for (int e = 0; e < 4; ++e) { const float a = fmaxf(v0[e], 0.f), b = fmaxf(v1[e], 0.f); v0[e] = a * a; v1[e] = b * b; } }
                if (ACT == 2) { f32x2 a = gelu_pk((f32x2){v0[0], v0[1]}), b = gelu_pk((f32x2){v0[2], v0[3]}), c = gelu_pk((f32x2){v1[0], v1[1]}), d = gelu_pk((f32x2){v1[2], v1[3]});
                    v0 = (f32x4){a.x, a.y, b.x, b.y}; v1 = (f32x4){c.x, c.y, d.x, d.y}; }
                if (ACT == 3) {
#pragma unroll
                    for (int e = 0; e < 4; ++e) { v0[e] = sigmoid_f(v0[e]); v1[e] = sigmoid_f(v1[e]); } }
                if (ACT == 4) { v0 = v0 * scale; v1 = v1 * scale; }
                u32x4 w; w.x = cvt_pk_bf16(v0[0], v0[1]); w.y = cvt_pk_bf16(v0[2], v0[3]); w.z = cvt_pk_bf16(v1[0], v1[1]); w.w = cvt_pk_bf16(v1[2], v1[3]);
                *(u32x4*)(rowp + bj * bjstride) = w; } }
}
template <int ACT> struct EpiAct {
    static constexpr bool PERM = true, AFTER_DRAIN = false;
    bf16_t* O; int ldc;
    __device__ __forceinline__ void operator()(const f32x4 (&acc)[2][2][4][2], const Unit& u, int wr, int wc, int fr, int fq) const {
        epi_store_tile<ACT>(acc, O + (size_t)u.pn * BM, (size_t)ldc, (size_t)HALF, u.pm * BM + wr * 64 + fr, wc * 32 + 8 * fq, 1.f);
    }
};
struct EpiQKV {
    static constexpr bool PERM = true, AFTER_DRAIN = false;
    bf16_t* QKV; int M; float qscale;
    __device__ __forceinline__ void operator()(const f32x4 (&acc)[2][2][4][2], const Unit& u, int wr, int wc, int fr, int fq) const {
        const int t = u.pn >> 3, hp = u.pn & 7;
        epi_store_tile<4>(acc, QKV + (size_t)(t * 16 + 2 * hp) * M * 128, 128, (size_t)M * 128, u.pm * BM + wr * 64 + fr, wc * 32 + 8 * fq, t == 0 ? qscale : 1.f);
    }
};
template <bool FIRST> struct EpiGate {
    static constexpr bool PERM = true, AFTER_DRAIN = false;
    const bf16_t* G; int ldg; bf16_t* T; int ldc;
    __device__ __forceinline__ void operator()(const f32x4 (&acc)[2][2][4][2], const Unit& u, int wr, int wc, int fr, int fq) const {
        const int row0 = u.pm * BM + wr * 64 + fr; const size_t col0 = (size_t)u.pn * BM + wc * 32 + 8 * fq;
#pragma unroll
        for (int ai = 0; ai < 2; ++ai)
#pragma unroll
            for (int m = 0; m < 4; ++m) { const size_t off = (size_t)(row0 + ai * HALF + m * 16) * ldc + col0, goff = (size_t)(row0 + ai * HALF + m * 16) * ldg + col0;
#pragma unroll
                for (int bj = 0; bj < 2; ++bj) { const u32x4 g = *(const u32x4*)(G + goff + bj * HALF);
                    const f32x4 a0 = acc[ai][bj][m][0], a1 = acc[ai][bj][m][1];
                    float o[8] = {a0[0] * bf_lo(g.x), a0[1] * bf_hi(g.x), a0[2] * bf_lo(g.y), a0[3] * bf_hi(g.y), a1[0] * bf_lo(g.z), a1[1] * bf_hi(g.z), a1[2] * bf_lo(g.w), a1[3] * bf_hi(g.w)};
                    if (!FIRST) { const u32x4 p = *(const u32x4*)(T + off + bj * HALF);
                        o[0] += bf_lo(p.x); o[1] += bf_hi(p.x); o[2] += bf_lo(p.y); o[3] += bf_hi(p.y); o[4] += bf_lo(p.z); o[5] += bf_hi(p.z); o[6] += bf_lo(p.w); o[7] += bf_hi(p.w); }
                    u32x4 w; w.x = cvt_pk_bf16(o[0], o[1]); w.y = cvt_pk_bf16(o[2], o[3]); w.z = cvt_pk_bf16(o[4], o[5]); w.w = cvt_pk_bf16(o[6], o[7]);
                    *(u32x4*)(T + off + bj * HALF) = w; } }
    }
};
template <class Epi, class Sched, bool ALIGN_EPI = false, bool SP2 = false>
__device__ __forceinline__ void gemm_phase(PG8_LAS unsigned char* lds, const Gemm g, const Sched& S, const Epi& E) {
    const int tid = threadIdx.x, wid = __builtin_amdgcn_readfirstlane(tid >> 6), lane = tid & 63, wr = wid >> 2, wc = wid & 3, fr = lane & 15, fq = lane >> 4;
    const int K = g.K, nt = K / BK;
    unsigned voffA[2], voffB[2];
#pragma unroll
    for (int i = 0; i < 2; ++i) { int R, C; stage_rc(tid * 16 + i * 8192, R, C); const int Rb = Epi::PERM ? ((R & ~31) + perm32(R & 31)) : R;
        voffA[i] = (unsigned)(R * K + C) * 2u; voffB[i] = (unsigned)(Rb * K + C) * 2u; }
    const size_t kstep = (size_t)(BK * 2);
    const size_t hstep = (size_t)HALF * K * 2;
    const size_t tstep = 2 * hstep;
    const unsigned ldsw = (unsigned)wid * 1024u;
    const int aoff = lds_byte(wr * 64 + fr, fq * 8), boff = lds_byte(wc * 32 + fr, fq * 8);
#define PG8_SA(b, h) (((b) * 2 + (h)) * HTB)
#define PG8_SB(b, h) ((4 + (b) * 2 + (h)) * HTB)
#define PG8_STAGE(bufoff, gbase, voff) do { _Pragma("unroll") for (int _i = 0; _i < 2; ++_i) \
        __builtin_amdgcn_global_load_lds((const unsigned*)((const char*)(gbase) + (voff)[_i]), (PG8_LAS unsigned*)(lds + (bufoff) + ldsw + _i * 8192), 16, 0, 0); } while (0)
#define PG8_LDA(dst, b, h) do { _Pragma("unroll") for (int m = 0; m < 4; ++m) _Pragma("unroll") for (int k = 0; k < 2; ++k) dst[m][k] = *(const PG8_LAS bf16x8*)(lds + PG8_SA(b, h) + aoff + m * 2048 + k * 1024); } while (0)
#define PG8_LDB(dst, b, h) do { _Pragma("unroll") for (int n = 0; n < 2; ++n) _Pragma("unroll") for (int k = 0; k < 2; ++k) dst[n][k] = *(const PG8_LAS bf16x8*)(lds + PG8_SB(b, h) + boff + n * 2048 + k * 1024); } while (0)
#define PG8_MMA(ai, bj, At, Bt) do { __builtin_amdgcn_s_setprio(1); _Pragma("unroll") for (int m = 0; m < 4; ++m) _Pragma("unroll") for (int n = 0; n < 2; ++n) _Pragma("unroll") for (int k = 0; k < 2; ++k) \
        acc[ai][bj][m][n] = __builtin_amdgcn_mfma_f32_16x16x32_bf16(Bt[n][k], At[m][k], acc[ai][bj][m][n], 0, 0, 0); __builtin_amdgcn_s_setprio(0); } while (0)
#define PG8_WAIT_V(n) asm volatile("s_waitcnt vmcnt(" #n ")" ::: "memory")
#define PG8_WAIT_L(n) asm volatile("s_waitcnt lgkmcnt(" #n ")" ::: "memory")
#define PG8_BAR __builtin_amdgcn_s_barrier()
#define PG8_SCHED __builtin_amdgcn_sched_barrier(0)
    Unit cur, nxt; int ui = 0;
    if (!S.next(0, cur)) return;
    f32x4 acc[2][2][4][2];
#pragma unroll
    for (int a = 0; a < 2; ++a)
#pragma unroll
        for (int b = 0; b < 2; ++b)
#pragma unroll
            for (int m = 0; m < 4; ++m)
#pragma unroll
                for (int n = 0; n < 2; ++n) acc[a][b][m][n] = (f32x4){0.f, 0.f, 0.f, 0.f};
    bf16x8 At[4][2], B0[2][2], B1[2][2];
    const char* cA = (const char*)g.A + (size_t)cur.pm * tstep; const char* cB = (const char*)g.Bt + (size_t)cur.pn * tstep;
    S.a_ready(cur);
    if constexpr (SP2) {
        PG8_STAGE(PG8_SB(0, 0), cB, voffB); PG8_STAGE(PG8_SB(0, 1), cB + hstep, voffB); PG8_STAGE(PG8_SA(0, 0), cA, voffA); PG8_STAGE(PG8_SA(0, 1), cA + hstep, voffA);
        if (wr == 1) PG8_BAR;
        PG8_WAIT_V(2); PG8_BAR;
        PG8_STAGE(PG8_SB(1, 0), cB + kstep, voffB); PG8_STAGE(PG8_SA(1, 0), cA + kstep, voffA); PG8_STAGE(PG8_SB(1, 1), cB + hstep + kstep, voffB);
        PG8_WAIT_V(6); PG8_BAR;
    } else {
        PG8_STAGE(PG8_SB(0, 0), cB, voffB); PG8_STAGE(PG8_SA(0, 0), cA, voffA); PG8_STAGE(PG8_SB(0, 1), cB + hstep, voffB); PG8_STAGE(PG8_SA(0, 1), cA + hstep, voffA);
        if (wr == 1) PG8_BAR;
        PG8_WAIT_V(4); PG8_BAR;
        PG8_STAGE(PG8_SB(1, 0), cB + kstep, voffB); PG8_STAGE(PG8_SA(1, 0), cA + kstep, voffA); PG8_STAGE(PG8_SB(1, 1), cB + hstep + kstep, voffB);
        PG8_WAIT_V(6); PG8_BAR;
    }
    for (;;) {
        const bool has_next = S.next(ui + 1, nxt);
        const char* nA = has_next ? (const char*)g.A + (size_t)nxt.pm * tstep : cA; const char* nB = has_next ? (const char*)g.Bt + (size_t)nxt.pn * tstep : cB;
        for (int t = 0; t < nt; t += 2) {
            const bool last = (t == nt - 2);
            const char* a1 = cA + (size_t)(t + 1) * kstep;
            const char* a2 = last ? nA : cA + (size_t)(t + 2) * kstep; const char* b2 = last ? nB : cB + (size_t)(t + 2) * kstep;
            const char* a3 = a2 + kstep; const char* b3 = b2 + kstep;
            if (last && has_next) S.a_ready(nxt);
            if constexpr (SP2) {
            PG8_LDB(B0, 0, 0); PG8_LDB(B1, 0, 1); PG8_SCHED; PG8_LDA(At, 0, 0); PG8_STAGE(PG8_SA(1, 1), a1 + hstep, voffA);
            PG8_WAIT_V(8); PG8_WAIT_L(0); PG8_BAR; PG8_MMA(0, 0, At, B0); PG8_MMA(0, 1, At, B1); PG8_BAR; PG8_SCHED;
            PG8_LDA(At, 0, 1); PG8_STAGE(PG8_SB(0, 0), b2, voffB); PG8_STAGE(PG8_SB(0, 1), b2 + hstep, voffB); PG8_STAGE(PG8_SA(0, 0), a2, voffA);
            PG8_WAIT_V(8); PG8_WAIT_L(0); PG8_BAR; PG8_MMA(1, 0, At, B0); PG8_MMA(1, 1, At, B1); PG8_BAR; PG8_SCHED;
            PG8_LDB(B0, 1, 0); PG8_LDB(B1, 1, 1); PG8_SCHED; PG8_LDA(At, 1, 0); PG8_STAGE(PG8_SA(0, 1), a2 + hstep, voffA);
            PG8_WAIT_V(8); PG8_WAIT_L(0); PG8_BAR; PG8_MMA(0, 0, At, B0); PG8_MMA(0, 1, At, B1); PG8_BAR; PG8_SCHED;
            PG8_LDA(At, 1, 1); PG8_STAGE(PG8_SB(1, 0), b3, voffB); PG8_STAGE(PG8_SB(1, 1), b3 + hstep, voffB); PG8_STAGE(PG8_SA(1, 0), a3, voffA);
            PG8_WAIT_V(8); PG8_WAIT_L(0); PG8_BAR; PG8_MMA(1, 0, At, B0); PG8_MMA(1, 1, At, B1); PG8_BAR; PG8_SCHED;
            } else {
            PG8_LDB(B0, 0, 0); PG8_SCHED; PG8_LDA(At, 0, 0); PG8_STAGE(PG8_SA(1, 1), a1 + hstep, voffA);
            PG8_WAIT_L(8); PG8_BAR; PG8_WAIT_L(0); PG8_MMA(0, 0, At, B0); PG8_BAR; PG8_SCHED;
            PG8_LDB(B1, 0, 1); PG8_STAGE(PG8_SB(0, 0), b2, voffB);
            PG8_BAR; PG8_WAIT_L(0); PG8_MMA(0, 1, At, B1); PG8_BAR;
            PG8_LDA(At, 0, 1); PG8_STAGE(PG8_SA(0, 0), a2, voffA);
            PG8_BAR; PG8_WAIT_L(0); PG8_MMA(1, 0, At, B0); PG8_BAR; PG8_SCHED;
            PG8_STAGE(PG8_SB(0, 1), b2 + hstep, voffB);
            PG8_WAIT_V(6); PG8_BAR; PG8_MMA(1, 1, At, B1); PG8_BAR;
            PG8_LDB(B0, 1, 0); PG8_SCHED; PG8_LDA(At, 1, 0); PG8_STAGE(PG8_SA(0, 1), a2 + hstep, voffA);
            PG8_WAIT_L(8); PG8_BAR; PG8_WAIT_L(0); PG8_MMA(0, 0, At, B0); PG8_BAR; PG8_SCHED;
            PG8_LDB(B1, 1, 1); PG8_STAGE(PG8_SB(1, 0), b3, voffB);
            PG8_BAR; PG8_WAIT_L(0); PG8_MMA(0, 1, At, B1); PG8_BAR;
            PG8_LDA(At, 1, 1); PG8_STAGE(PG8_SA(1, 0), a3, voffA);
            PG8_BAR; PG8_WAIT_L(0); PG8_MMA(1, 0, At, B0); PG8_BAR; PG8_SCHED;
            PG8_STAGE(PG8_SB(1, 1), b3 + hstep, voffB);
            PG8_WAIT_V(6); PG8_BAR; PG8_MMA(1, 1, At, B1); PG8_BAR;
            }
        }
        if constexpr (ALIGN_EPI) { if (wr == 0) PG8_BAR; }
        if constexpr (!Epi::AFTER_DRAIN) { E(acc, cur, wr, wc, fr, fq); S.done(cur); }
        if (!has_next) break;
#pragma unroll
        for (int a = 0; a < 2; ++a)
#pragma unroll
            for (int b = 0; b < 2; ++b)
#pragma unroll
                for (int m = 0; m < 4; ++m)
#pragma unroll
                    for (int n = 0; n < 2; ++n) acc[a][b][m][n] = (f32x4){0.f, 0.f, 0.f, 0.f};
        cur = nxt; cA = nA; cB = nB; ++ui;
        if constexpr (ALIGN_EPI) { if (wr == 1) PG8_BAR; }
    }
    PG8_WAIT_V(0);
    if constexpr (!ALIGN_EPI) { if (wr == 0) PG8_BAR; }
    PG8_BAR;
    if constexpr (Epi::AFTER_DRAIN) { E.fused(acc, cur, wr, wc, fr, fq, lds, wid, lane); S.done(cur); }
#undef PG8_SA
#undef PG8_SB
#undef PG8_STAGE
#undef PG8_LDA
#undef PG8_LDB
#undef PG8_MMA
#undef PG8_WAIT_V
#undef PG8_WAIT_L
#undef PG8_BAR
#undef PG8_SCHED
}
}
#define GAS __attribute__((address_space(1)))
#define LAS __attribute__((address_space(3)))
typedef unsigned short bf16;
typedef unsigned v4u __attribute__((ext_vector_type(4)));
typedef float f32x4 __attribute__((ext_vector_type(4)));
typedef short bf16x8 __attribute__((ext_vector_type(8)));
typedef GAS unsigned gu32;
typedef GAS unsigned long long gu64;
#define RLX_AGENT __ATOMIC_RELAXED, __HIP_MEMORY_SCOPE_AGENT
#define LDS_WAIT() asm volatile("s_waitcnt lgkmcnt(0)" ::: "memory")
#define VM_WAIT() asm volatile("s_waitcnt vmcnt(0)" ::: "memory")
__device__ __forceinline__ unsigned long long rt() { return __builtin_amdgcn_s_memrealtime(); }
__device__ __forceinline__ unsigned f2bf(float f) { unsigned u = __builtin_bit_cast(unsigned, f); return (u + 0x7fffu + ((u >> 16) & 1u)) >> 16; }
__device__ __forceinline__ unsigned pk2(float lo, float hi) { return f2bf(lo) | (f2bf(hi) << 16); }
#define XB_TMO      128
#define XB_XCNT(j)  (256  + 64 * (j))
#define XB_XSUB(j)  (1280 + 64 * (j))
#define XB_XGEN(j)  (2304 + 64 * (j))
#define XB_TOP      3328
#define XB_TOPGEN   3392
#define XCD_BAR_WORDS 3456
#define XB_SPIN_CAP (1u << 18)

__device__ __forceinline__ unsigned xb_ld(unsigned* p)              { return __hip_atomic_load(p, __ATOMIC_RELAXED, __HIP_MEMORY_SCOPE_AGENT); }
__device__ __forceinline__ unsigned xb_add(unsigned* p, unsigned v) { return __hip_atomic_fetch_add(p, v, __ATOMIC_RELAXED, __HIP_MEMORY_SCOPE_AGENT); }
__device__ __forceinline__ unsigned xb_xcc_id() { return (unsigned)__builtin_amdgcn_s_getreg((3 << 11) | 20) & 0xFu; }
#define XB_SPIN(cond, bar) do { unsigned _sp = 0; while (cond) { __builtin_amdgcn_s_sleep(1); \
    if ((++_sp & 255u) == 0u) { if (xb_ld(&(bar)[XB_TMO])) break; if (_sp > XB_SPIN_CAP) { atomicAdd(&(bar)[XB_TMO], 1u); break; } } } } while (0)

struct XcdBarrier {
    unsigned* bar; unsigned x;
    volatile LAS unsigned* st;
};

__device__ __forceinline__ XcdBarrier xcd_barrier_post(unsigned* bar, volatile LAS unsigned* st) {
    XcdBarrier b; b.bar = bar; b.x = xb_xcc_id(); b.st = st;
    if (threadIdx.x == 0) (void)xb_add(&bar[XB_XCNT(b.x)], 1u);
    return b;
}
__device__ __forceinline__ void xcd_barrier_complete(unsigned* bar, unsigned x, unsigned& nloc, unsigned& nx) {
    const unsigned G = gridDim.x * gridDim.y * gridDim.z;
    unsigned sum, cnt, mine, sp = 0u;
    for (;;) {
        sum = 0u; cnt = 0u; mine = 0u;
#pragma unroll
        for (unsigned j = 0; j < 16; ++j) { const unsigned c = xb_ld(&bar[XB_XCNT(j)]); sum += c; cnt += (c > 0u) ? 1u : 0u; mine = (j == x) ? c : mine; }
        if (sum == G) break;
        __builtin_amdgcn_s_sleep(1);
        if ((++sp & 255u) == 0u) { if (xb_ld(&bar[XB_TMO])) break; if (sp > XB_SPIN_CAP) { atomicAdd(&bar[XB_TMO], 1u); break; } }
    }
    nloc = mine > 0u ? mine : 1u; nx = cnt > 0u ? cnt : 1u;
}

__device__ __forceinline__ void xcd_barrier(const XcdBarrier& b) {
    asm volatile("s_waitcnt vmcnt(0)" ::: "memory");
    __syncthreads();
    if (threadIdx.x == 0) {
        unsigned* bar = b.bar;
        __builtin_amdgcn_s_waitcnt(0);
        unsigned nloc = b.st[0], nx = b.st[1];
        if (nloc == 0u) { xcd_barrier_complete(bar, b.x, nloc, nx); b.st[0] = nloc; b.st[1] = nx; }
        const unsigned old = xb_add(&bar[XB_XSUB(b.x)], 1u);
        const unsigned gen = old / nloc;
        if (old + 1u == (gen + 1u) * nloc) {
            __builtin_amdgcn_fence(__ATOMIC_RELEASE, "agent");
            asm volatile("s_waitcnt vmcnt(0)" ::: "memory");
            const unsigned og = xb_add(&bar[XB_TOP], 1u);
            const unsigned tg = og / nx;
            if (og + 1u == (tg + 1u) * nx) xb_add(&bar[XB_TOPGEN], 1u);
            else XB_SPIN(xb_ld(&bar[XB_TOPGEN]) == tg, bar);
            __builtin_amdgcn_fence(__ATOMIC_ACQUIRE, "agent");
            xb_add(&bar[XB_XGEN(b.x)], 1u);
            asm volatile("s_waitcnt vmcnt(0)" ::: "memory");
        } else {
            XB_SPIN(xb_ld(&bar[XB_XGEN(b.x)]) == gen, bar);
            __builtin_amdgcn_fence(__ATOMIC_ACQUIRE, "agent");
            asm volatile("s_waitcnt vmcnt(0)" ::: "memory");
        }
    }
    __syncthreads();
}
constexpr int SEQ = 8192, DM = 4096, NIN = 18432, GW = 2048, SBW = 2048, NH = 16, HD = 128, DFF = 16384, NMODC = 6 * DM;
constexpr float EPS = 1e-6f;
constexpr float QSCALE = 0.12751743f;
constexpr int NWAVES = 8;
#ifndef MK_ONE_LAUNCH
#define MK_ONE_LAUNCH 0
#endif
#ifndef MK_DEBUG
#define MK_DEBUG 0
#endif
constexpr size_t MiB = 1u << 20;
constexpr size_t WS_CTL = 0, CTL_ZERO_BYTES = 1 * MiB;
constexpr size_t WS_MOD = 1 * MiB;
constexpr size_t WS_STAT = 1 * MiB + 128 * 1024;
constexpr size_t WS_WIN = 2 * MiB;
constexpr size_t WS_WPA = 146 * MiB, WS_WPB = 162 * MiB;
constexpr size_t WS_WO = 178 * MiB;
constexpr size_t WS_WF1 = 210 * MiB;
constexpr size_t WS_WF2 = 338 * MiB;
constexpr size_t WS_H = 466 * MiB;
constexpr size_t WS_GZ = 530 * MiB;
constexpr size_t WS_QKV = 594 * MiB;
constexpr size_t WS_SA = 690 * MiB, WS_SB = 754 * MiB;
constexpr size_t WS_GA = 818 * MiB, WS_AT = 850 * MiB;
constexpr size_t WS_MIXIN = 882 * MiB;
constexpr size_t WS_MIX = 946 * MiB;
constexpr size_t WS_ACT = 1010 * MiB;
constexpr size_t WS_FF = 1266 * MiB;
constexpr size_t WS_END = 1330 * MiB;
constexpr int CW_TMO = 0, CW_CODE = 1, CW_BAR = 4096;
constexpr int RING_OFF = 0, RING_BYTES = 131072;
constexpr int LDSCTL_OFF = 139264, MISC_OFF = LDSCTL_OFF + 320;
constexpr int LDS_BYTES = 147456;
typedef unsigned u32x2 __attribute__((ext_vector_type(2)));
struct Frame {
    LAS unsigned char* lds;
    volatile LAS unsigned* MISC;
    gu32* ctl;
    int tid, lane, wave, vcu, G;
    const float *x, *c, *w_ada, *b_ada, *g_pre_mix, *w_in, *g_v, *w_s, *b_s, *w_pa, *w_pb, *w_o, *g_post_mix, *g_pre_mlp, *w_ff1, *w_ff2, *g_post_mlp;
    float* out; float* mod; float* stat;
    bf16 *Win_t, *Wpa_t, *Wpb_t, *Wo_t, *Wf1_t, *Wf2_t;
    bf16 *H, *GZ, *QKV, *SA, *SB, *GA, *AT, *MIXIN, *MIX, *ACT, *FF;
};
__device__ __forceinline__ float wave_sum(float v) {
#pragma unroll
    for (int o = 1; o < 64; o <<= 1) v += __shfl_xor(v, o);
    return v;
}
__device__ __forceinline__ unsigned pkbf(float lo, float hi) { return pg8::cvt_pk_bf16(lo, hi); }
__device__ __forceinline__ float bflo(unsigned u) { return __builtin_bit_cast(float, u << 16); }
__device__ __forceinline__ float bfhi(unsigned u) { return __builtin_bit_cast(float, u & 0xffff0000u); }

__device__ __forceinline__ void p0_gemv(Frame& F) {
    LAS float* sc = (LAS float*)(F.lds + RING_OFF);
    LAS float* red = (LAS float*)(F.lds + RING_OFF + 16384);
    for (int i = F.tid; i < DM; i += NWAVES * 64) { const float cv = F.c[i]; sc[i] = cv / (1.0f + __expf(-cv)); }
    __syncthreads();
    for (int cb = blockIdx.x; cb < NMODC / 96; cb += F.G) {
        if (F.tid < 504) { const int kq = F.tid / 24, cq = F.tid % 24; const float* wp = F.w_ada + (size_t)96 * cb + 4 * cq;
            f32x4 a = {0.f, 0.f, 0.f, 0.f};
#pragma unroll 8
            for (int k = kq; k < DM; k += 21) { const f32x4 w = __builtin_nontemporal_load((const f32x4*)(wp + (size_t)k * NMODC)); a = a + w * sc[k]; }
            *(LAS f32x4*)(red + kq * 96 + 4 * cq) = a; }
        __syncthreads();
        if (F.tid < 96) { float s = 0.f;
#pragma unroll
            for (int q = 0; q < 21; ++q) s += red[q * 96 + F.tid];
            F.mod[96 * cb + F.tid] = s + F.b_ada[96 * cb + F.tid]; }
        __syncthreads();
    }
}
__device__ __forceinline__ void p0_transpose_tile(const float* W, int K, int N, bf16* WT, LAS float* scr, int item, int lane) {
    const int nblk = N / 64, kb = item / nblk, nb = item % nblk, k0 = 64 * kb, n0 = 64 * nb;
    const int n4 = lane & 15, kr = lane >> 4;
    f32x4 v[16];
#pragma unroll
    for (int i = 0; i < 16; ++i) v[i] = __builtin_nontemporal_load((const f32x4*)(W + (size_t)(k0 + 4 * i + kr) * N + n0 + 4 * n4));
#pragma unroll
    for (int i = 0; i < 16; ++i) { const int k = 4 * i + kr; *(LAS f32x4*)(scr + k * 64 + ((4 * n4 + 8 * (k >> 3)) & 63)) = v[i]; }
    asm volatile("s_waitcnt lgkmcnt(0)" ::: "memory");
    const int c = lane >> 3, nn = lane & 7;
#pragma unroll
    for (int it = 0; it < 8; ++it) { const int n = it * 8 + nn; const LAS float* s = scr + (8 * c) * 64 + ((n + 8 * c) & 63);
        v4u o; o.x = pkbf(s[0], s[64]); o.y = pkbf(s[128], s[192]); o.z = pkbf(s[256], s[320]); o.w = pkbf(s[384], s[448]);
        *(GAS v4u*)(WT + (size_t)(n0 + n) * K + k0 + 8 * c) = o; }
    asm volatile("s_waitcnt lgkmcnt(0)" ::: "memory");
}
__device__ __forceinline__ void p0_weights(Frame& F) {
    LAS float* scr = (LAS float*)(F.lds + RING_OFF + F.wave * 16384);
    const int gw = F.vcu * NWAVES + F.wave, NGW = F.G * NWAVES;
    constexpr int I_IN = (DM / 64) * (NIN / 64), I_PA = (GW / 64) * (DM / 64), I_PB = I_PA, I_O = (DM / 64) * (DM / 64), I_F1 = (DM / 64) * (DFF / 64), I_F2 = I_F1;
    constexpr int NITEMS = I_IN + I_PA + I_PB + I_O + I_F1 + I_F2;
    for (int it = gw; it < NITEMS; it += NGW) {
        int r = it;
        if (r < I_IN) { p0_transpose_tile(F.w_in, DM, NIN, F.Win_t, scr, r, F.lane); continue; } r -= I_IN;
        if (r < I_PA) { p0_transpose_tile(F.w_pa, GW, DM, F.Wpa_t, scr, r, F.lane); continue; } r -= I_PA;
        if (r < I_PB) { p0_transpose_tile(F.w_pb, SBW, DM, F.Wpb_t, scr, r, F.lane); continue; } r -= I_PB;
        if (r < I_O) { p0_transpose_tile(F.w_o, DM, DM, F.Wo_t, scr, r, F.lane); continue; } r -= I_O;
        if (r < I_F1) { p0_transpose_tile(F.w_ff1, DM, DFF, F.Wf1_t, scr, r, F.lane); continue; } r -= I_F1;
        p0_transpose_tile(F.w_ff2, DFF, DM, F.Wf2_t, scr, r, F.lane);
    }
}
__device__ __forceinline__ void t0_rows(Frame& F) {
    LAS float* Av = (LAS float*)(F.lds + RING_OFF); LAS float* Bv = Av + DM;
    for (int i = F.tid; i < DM; i += NWAVES * 64) { Av[i] = F.g_pre_mix[i] * (1.0f + F.mod[DM + i]); Bv[i] = F.mod[i]; }
    __syncthreads();
    const int gw = F.vcu * NWAVES + F.wave, NGW = F.G * NWAVES;
    for (int row = gw; row < SEQ; row += NGW) {
        const GAS f32x4* xr = (const GAS f32x4*)(F.x + (size_t)row * DM) + F.lane;
        f32x4 v[16]; float s = 0.f;
#pragma unroll
        for (int j = 0; j < 16; ++j) { v[j] = xr[64 * j]; s += (v[j].x * v[j].x + v[j].y * v[j].y) + (v[j].z * v[j].z + v[j].w * v[j].w); }
        const float inv = 1.0f / sqrtf(wave_sum(s) * (1.0f / DM) + EPS);
        GAS unsigned long long* o8 = (GAS unsigned long long*)(F.H + (size_t)row * DM) + F.lane;
#pragma unroll
        for (int j = 0; j < 16; ++j) { const f32x4 a = *(LAS f32x4*)(Av + 4 * (F.lane + 64 * j)), b = *(LAS f32x4*)(Bv + 4 * (F.lane + 64 * j));
            const f32x4 h = v[j] * inv * a + b;
            o8[64 * j] = (unsigned long long)pkbf(h.x, h.y) | ((unsigned long long)pkbf(h.z, h.w) << 32); if ((j & 3) == 3) asm volatile("" ::: "memory"); }
    }
}
__device__ __forceinline__ void t1_rows(Frame& F) {
    LAS float* G1 = (LAS float*)(F.lds + RING_OFF); LAS float* A2 = G1 + DM; LAS float* B2 = A2 + DM;
    for (int i = F.tid; i < DM; i += NWAVES * 64) { G1[i] = F.mod[2 * DM + i] * F.g_post_mix[i]; A2[i] = F.g_pre_mlp[i] * (1.0f + F.mod[4 * DM + i]); B2[i] = F.mod[3 * DM + i]; }
    __syncthreads();
    const int gw = F.vcu * NWAVES + F.wave, NGW = F.G * NWAVES;
    for (int row = gw; row < SEQ; row += NGW) {
        const GAS u32x2* mr = (const GAS u32x2*)(F.MIX + (size_t)row * DM) + F.lane;
        const GAS f32x4* xr = (const GAS f32x4*)(F.x + (size_t)row * DM) + F.lane;
        f32x4 v[16]; float s = 0.f;
#pragma unroll
        for (int j = 0; j < 16; ++j) { const u32x2 u = mr[64 * j]; v[j] = (f32x4){bflo(u.x), bfhi(u.x), bflo(u.y), bfhi(u.y)}; s += (v[j].x * v[j].x + v[j].y * v[j].y) + (v[j].z * v[j].z + v[j].w * v[j].w); }
        const float inv1 = 1.0f / sqrtf(wave_sum(s) * (1.0f / DM) + EPS);
        GAS f32x4* orow = (GAS f32x4*)(F.out + (size_t)row * DM) + F.lane;
        float s2 = 0.f;
#pragma unroll
        for (int j = 0; j < 16; ++j) { const f32x4 g = *(LAS f32x4*)(G1 + 4 * (F.lane + 64 * j)); const f32x4 xv = xr[64 * j];
            v[j] = xv + g * (v[j] * inv1); orow[64 * j] = v[j]; s2 += (v[j].x * v[j].x + v[j].y * v[j].y) + (v[j].z * v[j].z + v[j].w * v[j].w); if ((j & 3) == 3) asm volatile("" ::: "memory"); }
        const float inv2 = 1.0f / sqrtf(wave_sum(s2) * (1.0f / DM) + EPS);
        GAS unsigned long long* o8 = (GAS unsigned long long*)(F.H + (size_t)row * DM) + F.lane;
#pragma unroll
        for (int j = 0; j < 16; ++j) { const f32x4 a = *(LAS f32x4*)(A2 + 4 * (F.lane + 64 * j)), b = *(LAS f32x4*)(B2 + 4 * (F.lane + 64 * j));
            const f32x4 h = v[j] * inv2 * a + b;
            o8[64 * j] = (unsigned long long)pkbf(h.x, h.y) | ((unsigned long long)pkbf(h.z, h.w) << 32); if ((j & 3) == 3) asm volatile("" ::: "memory"); }
    }
}
__device__ __forceinline__ void t2_rows(Frame& F) {
    LAS float* G2 = (LAS float*)(F.lds + RING_OFF);
    for (int i = F.tid; i < DM; i += NWAVES * 64) G2[i] = F.mod[5 * DM + i] * F.g_post_mlp[i];
    __syncthreads();
    const int gw = F.vcu * NWAVES + F.wave, NGW = F.G * NWAVES;
    for (int row = gw; row < SEQ; row += NGW) {
        const GAS u32x2* fr_ = (const GAS u32x2*)(F.FF + (size_t)row * DM) + F.lane;
        GAS f32x4* orow = (GAS f32x4*)(F.out + (size_t)row * DM) + F.lane;
        f32x4 v[16]; float s = 0.f;
#pragma unroll
        for (int j = 0; j < 16; ++j) { const u32x2 u = fr_[64 * j]; v[j] = (f32x4){bflo(u.x), bfhi(u.x), bflo(u.y), bfhi(u.y)}; s += (v[j].x * v[j].x + v[j].y * v[j].y) + (v[j].z * v[j].z + v[j].w * v[j].w); }
        const float inv = 1.0f / sqrtf(wave_sum(s) * (1.0f / DM) + EPS);
#pragma unroll
        for (int j = 0; j < 16; ++j) { const f32x4 g = *(LAS f32x4*)(G2 + 4 * (F.lane + 64 * j)); const f32x4 xv = orow[64 * j]; orow[64 * j] = xv + g * (v[j] * inv); if ((j & 3) == 3) asm volatile("" ::: "memory"); }
    }
}
__device__ __forceinline__ void gmlp_stats_naive(Frame& F) {
    const int gw = F.vcu * NWAVES + F.wave, NGW = F.G * NWAVES;
    for (int row = gw; row < SEQ; row += NGW) {
        const GAS u32x2* vr = (const GAS u32x2*)(F.GZ + (size_t)row * DM + GW) + F.lane;
        f32x4 v[8]; float s = 0.f;
#pragma unroll
        for (int j = 0; j < 8; ++j) { const u32x2 u = vr[64 * j]; v[j] = (f32x4){bflo(u.x), bfhi(u.x), bflo(u.y), bfhi(u.y)}; s += (v[j].x + v[j].y) + (v[j].z + v[j].w); }
        const float mean = wave_sum(s) * (1.0f / GW); float s2 = 0.f;
#pragma unroll
        for (int j = 0; j < 8; ++j) { const f32x4 d = v[j] - mean; s2 += (d.x * d.x + d.y * d.y) + (d.z * d.z + d.w * d.w); }
        const float rstd = 1.0f / sqrtf(wave_sum(s2) * (1.0f / GW) + EPS);
        if (F.lane == 0) { F.stat[2 * row] = mean; F.stat[2 * row + 1] = rstd; }
    }
}
__device__ __forceinline__ void gmlp_main_naive(Frame& F) {
    const size_t total = (size_t)SEQ * GW, stride = (size_t)F.G * NWAVES * 64;
    for (size_t idx = (size_t)blockIdx.x * NWAVES * 64 + F.tid; idx < total; idx += stride) {
        const int row = (int)(idx / GW), c = (int)(idx % GW), n = row >> 7, t = row & 127, g = c >> 7;
        const int smax = t < 64 ? 64 : 128;
        const float* wr_ = F.w_s + ((size_t)g * 128 + t) * 128;
        const float gv = F.g_v[c]; float y = 0.f;
        for (int s = 0; s < smax; ++s) { const int r = n * 128 + s; const unsigned short hv = F.GZ[(size_t)r * DM + GW + c];
            const float vn = (__builtin_bit_cast(float, (unsigned)hv << 16) - F.stat[2 * r]) * F.stat[2 * r + 1] * gv; y += wr_[s] * vn; }
        y += F.b_s[g * 128 + t];
        const float u = __builtin_bit_cast(float, (unsigned)F.GZ[(size_t)row * DM + c] << 16);
        const unsigned pk = pkbf(u * y, 0.f);
        F.GA[(size_t)row * GW + c] = (bf16)(pk & 0xffffu);
    }
}
__device__ __forceinline__ void attn_naive(Frame& F) {
    const int gw = F.vcu * NWAVES + F.wave, NGW = F.G * NWAVES;
    for (int item = gw; item < SEQ * NH; item += NGW) {
        const int t = item / NH, h = item % NH;
        const bf16* Q = F.QKV + ((size_t)(0 * NH + h) * SEQ) * HD; const bf16* K = F.QKV + ((size_t)(1 * NH + h) * SEQ) * HD; const bf16* V = F.QKV + ((size_t)(2 * NH + h) * SEQ) * HD;
        const unsigned qq = *(const GAS unsigned*)(Q + (size_t)t * HD + 2 * F.lane);
        const float q0 = bflo(qq), q1 = bfhi(qq);
        float o0 = 0.f, o1 = 0.f, R = 1.0f;
        for (int s = t - 1; s >= 0; --s) {
            const unsigned kk = *(const GAS unsigned*)(K + (size_t)s * HD + 2 * F.lane), vv = *(const GAS unsigned*)(V + (size_t)s * HD + 2 * F.lane);
            const float z2 = wave_sum(q0 * bflo(kk) + q1 * bfhi(kk));
            const float e = __builtin_amdgcn_exp2f(fminf(z2, 120.f)), r = __builtin_amdgcn_rcpf(1.0f + e), a = e * r * R;
            R *= r; o0 += a * bflo(vv); o1 += a * bfhi(vv);
        }
        *(GAS unsigned*)(F.AT + (size_t)t * SBW + h * HD + 2 * F.lane) = pkbf(o0, o1);
    }
}
constexpr int N_PHASES = 11;
struct Args { const float* in[17]; float* out; unsigned char* ws; int ph_lo, ph_hi; };
__global__ void __launch_bounds__(NWAVES * 64, 2) fwd(Args args) {
    extern __shared__ __attribute__((aligned(16))) unsigned char lds[];
    Frame F;
    F.lds = (LAS unsigned char*)lds;
    F.MISC = (volatile LAS unsigned*)(F.lds + MISC_OFF);
    F.tid = threadIdx.x; F.lane = F.tid & 63; F.wave = __builtin_amdgcn_readfirstlane(F.tid >> 6);
    F.G = gridDim.x; { const int bx = blockIdx.x; F.vcu = (F.G % 8 == 0) ? (bx % 8) * (F.G / 8) + bx / 8 : bx; }
    unsigned char* ws = args.ws;
    F.ctl = (gu32*)(ws + WS_CTL);
    F.x = args.in[0]; F.c = args.in[1]; F.w_ada = args.in[2]; F.b_ada = args.in[3]; F.g_pre_mix = args.in[4]; F.w_in = args.in[5]; F.g_v = args.in[6]; F.w_s = args.in[7]; F.b_s = args.in[8];
    F.w_pa = args.in[9]; F.w_pb = args.in[10]; F.w_o = args.in[11]; F.g_post_mix = args.in[12]; F.g_pre_mlp = args.in[13]; F.w_ff1 = args.in[14]; F.w_ff2 = args.in[15]; F.g_post_mlp = args.in[16];
    F.out = args.out; F.mod = (float*)(ws + WS_MOD); F.stat = (float*)(ws + WS_STAT);
    F.Win_t = (bf16*)(ws + WS_WIN); F.Wpa_t = (bf16*)(ws + WS_WPA); F.Wpb_t = (bf16*)(ws + WS_WPB); F.Wo_t = (bf16*)(ws + WS_WO); F.Wf1_t = (bf16*)(ws + WS_WF1); F.Wf2_t = (bf16*)(ws + WS_WF2);
    F.H = (bf16*)(ws + WS_H); F.GZ = (bf16*)(ws + WS_GZ); F.QKV = (bf16*)(ws + WS_QKV); F.SA = (bf16*)(ws + WS_SA); F.SB = (bf16*)(ws + WS_SB); F.GA = (bf16*)(ws + WS_GA); F.AT = (bf16*)(ws + WS_AT);
    F.MIXIN = (bf16*)(ws + WS_MIXIN); F.MIX = (bf16*)(ws + WS_MIX); F.ACT = (bf16*)(ws + WS_ACT); F.FF = (bf16*)(ws + WS_FF);
    for (int u = F.tid; u < (LDS_BYTES - LDSCTL_OFF) / 4; u += NWAVES * 64) ((LAS unsigned*)(F.lds + LDSCTL_OFF))[u] = 0u;
    __syncthreads();
    const int lo = args.ph_lo, hi = args.ph_hi;
    XcdBarrier bar; bar.bar = (unsigned*)(F.ctl + CW_BAR); bar.x = 0; bar.st = nullptr;
    if (hi - lo > 1) bar = xcd_barrier_post((unsigned*)(F.ctl + CW_BAR), F.MISC + 8);
#ifndef PH_MASK
#define PH_MASK 0x7ff
#endif
#define IN(k) (((PH_MASK >> (k)) & 1) && lo <= (k) && (k) < hi)
#define BOTH(k) (IN(k) && IN((k) + 1))
#define GRID_BAR() xcd_barrier(bar)
    if (IN(0)) { p0_gemv(F); p0_weights(F); if (BOTH(0)) GRID_BAR(); }
    if (IN(1)) { t0_rows(F); if (BOTH(1)) GRID_BAR(); }
    if (IN(2)) {
        { pg8::Gemm g{F.H, F.Win_t, SEQ, 2 * GW, DM}; pg8::StaticOrder S; S.init(SEQ, 2 * GW, F.G, (int)blockIdx.x);
          pg8::EpiAct<2> E{F.GZ, DM};
          pg8::gemm_phase<pg8::EpiAct<2>, pg8::StaticOrder, true, true>(F.lds + RING_OFF, g, S, E); }
        { pg8::Gemm g{F.H, F.Win_t + (size_t)(2 * GW) * DM, SEQ, 3 * SBW, DM}; pg8::StaticOrder S; S.init(SEQ, 3 * SBW, F.G, (int)blockIdx.x);
          pg8::EpiQKV E{F.QKV, SEQ, QSCALE};
          pg8::gemm_phase<pg8::EpiQKV, pg8::StaticOrder, true, true>(F.lds + RING_OFF, g, S, E); }
        { pg8::Gemm g{F.H, F.Win_t + (size_t)(2 * GW + 3 * SBW) * DM, SEQ, 2 * DM, DM}; pg8::StaticOrder S; S.init(SEQ, 2 * DM, F.G, (int)blockIdx.x);
          pg8::EpiAct<3> E{F.SA, 2 * DM};
          pg8::gemm_phase<pg8::EpiAct<3>, pg8::StaticOrder, true, true>(F.lds + RING_OFF, g, S, E); }
        if (BOTH(2)) GRID_BAR();
    }
    if (IN(3)) { gmlp_stats_naive(F); if (BOTH(3)) GRID_BAR(); }
    if (IN(4)) { gmlp_main_naive(F); attn_naive(F); if (BOTH(4)) GRID_BAR(); }
    if (IN(5)) {
        { pg8::Gemm g{F.GA, F.Wpa_t, SEQ, DM, GW}; pg8::StaticOrder S; S.init(SEQ, DM, F.G, (int)blockIdx.x);
          pg8::EpiGate<true> E{F.SA, 2 * DM, F.MIXIN, DM};
          pg8::gemm_phase<pg8::EpiGate<true>, pg8::StaticOrder, true, true>(F.lds + RING_OFF, g, S, E); }
        { pg8::Gemm g{F.AT, F.Wpb_t, SEQ, DM, SBW}; pg8::StaticOrder S; S.init(SEQ, DM, F.G, (int)blockIdx.x);
          pg8::EpiGate<false> E{F.SA + DM, 2 * DM, F.MIXIN, DM};
          pg8::gemm_phase<pg8::EpiGate<false>, pg8::StaticOrder, true, true>(F.lds + RING_OFF, g, S, E); }
        if (BOTH(5)) GRID_BAR();
    }
    if (IN(6)) {
        pg8::Gemm g{F.MIXIN, F.Wo_t, SEQ, DM, DM}; pg8::StaticOrder S; S.init(SEQ, DM, F.G, (int)blockIdx.x);
        pg8::EpiAct<0> E{F.MIX, DM};
        pg8::gemm_phase<pg8::EpiAct<0>, pg8::StaticOrder, true, true>(F.lds + RING_OFF, g, S, E);
        if (BOTH(6)) GRID_BAR();
    }
    if (IN(7)) { t1_rows(F); if (BOTH(7)) GRID_BAR(); }
    if (IN(8)) {
        pg8::Gemm g{F.H, F.Wf1_t, SEQ, DFF, DM}; pg8::StaticOrder S; S.init(SEQ, DFF, F.G, (int)blockIdx.x);
        pg8::EpiAct<1> E{F.ACT, DFF};
        pg8::gemm_phase<pg8::EpiAct<1>, pg8::StaticOrder, true, true>(F.lds + RING_OFF, g, S, E);
        if (BOTH(8)) GRID_BAR();
    }
    if (IN(9)) {
        pg8::Gemm g{F.ACT, F.Wf2_t, SEQ, DM, DFF}; pg8::StaticOrder S; S.init(SEQ, DM, F.G, (int)blockIdx.x);
        pg8::EpiAct<0> E{F.FF, DM};
        pg8::gemm_phase<pg8::EpiAct<0>, pg8::StaticOrder, true, true>(F.lds + RING_OFF, g, S, E);
        if (BOTH(9)) GRID_BAR();
    }
    if (IN(10)) { t2_rows(F); }
#undef IN
#undef BOTH
#undef GRID_BAR
}

#if MK_DEBUG
constexpr size_t WS_DBG = WS_END;
__device__ __forceinline__ float dbg_bf(const bf16* p, size_t i) { return __builtin_bit_cast(float, (unsigned)p[i] << 16); }
__device__ __forceinline__ void dbg_atomic_max(float* p, float v) { atomicMax((unsigned*)p, __builtin_bit_cast(unsigned, v)); }
__device__ __forceinline__ float dbg_dot(const bf16* arow, const float* W, int K, int N, int col, int lane) {
    float s = 0.f; for (int k = lane; k < K; k += 64) s += dbg_bf(arow, k) * W[(size_t)k * N + col]; return wave_sum(s);
}
__global__ void __launch_bounds__(64) dbg_check(Args args) {
    Frame F; unsigned char* ws = args.ws;
    F.x = args.in[0]; F.c = args.in[1]; F.w_ada = args.in[2]; F.b_ada = args.in[3]; F.g_pre_mix = args.in[4]; F.w_in = args.in[5]; F.g_v = args.in[6]; F.w_s = args.in[7]; F.b_s = args.in[8];
    F.w_pa = args.in[9]; F.w_pb = args.in[10]; F.w_o = args.in[11]; F.g_post_mix = args.in[12]; F.g_pre_mlp = args.in[13]; F.w_ff1 = args.in[14]; F.w_ff2 = args.in[15]; F.g_post_mlp = args.in[16];
    F.out = args.out; F.mod = (float*)(ws + WS_MOD); F.stat = (float*)(ws + WS_STAT);
    F.H = (bf16*)(ws + WS_H); F.GZ = (bf16*)(ws + WS_GZ); F.QKV = (bf16*)(ws + WS_QKV); F.SA = (bf16*)(ws + WS_SA); F.GA = (bf16*)(ws + WS_GA); F.AT = (bf16*)(ws + WS_AT);
    F.MIXIN = (bf16*)(ws + WS_MIXIN); F.MIX = (bf16*)(ws + WS_MIX); F.ACT = (bf16*)(ws + WS_ACT); F.FF = (bf16*)(ws + WS_FF);
    float* E = (float*)(ws + WS_DBG);
    const int lane = threadIdx.x, smp = blockIdx.x, comp = args.ph_lo;
    const unsigned hsh = (unsigned)smp * 2654435761u + 12345u;
    const int row = (int)((hsh >> 8) % SEQ); const unsigned h2 = hsh * 2246822519u + 977u; const int c4 = (int)((h2 >> 7) % DM);
    float fast = 0.f, ref = 0.f, tol = 0.1f;
    if (comp == 1) { const int j = (int)((h2 >> 5) % NMODC); float s = 0.f; for (int k = lane; k < DM; k += 64) { const float cv = F.c[k]; s += cv / (1.f + expf(-cv)) * F.w_ada[(size_t)k * NMODC + j]; }
        ref = wave_sum(s) + F.b_ada[j]; fast = F.mod[j]; tol = 0.02f; }
    else if (comp == 2) {
        float s = 0.f; for (int k = lane; k < DM; k += 64) { const float v = F.x[(size_t)row * DM + k]; s += v * v; }
        const float inv = 1.f / sqrtf(wave_sum(s) / DM + EPS);
        ref = F.x[(size_t)row * DM + c4] * inv * F.g_pre_mix[c4] * (1.f + F.mod[DM + c4]) + F.mod[c4]; fast = dbg_bf(F.H, (size_t)row * DM + c4); }
    else if (comp == 3) { const float d = dbg_dot(F.H + (size_t)row * DM, F.w_in, DM, NIN, c4, lane); ref = 0.5f * d * (1.f + erff(d * 0.70710678f)); fast = dbg_bf(F.GZ, (size_t)row * DM + c4); tol = 0.5f; }
    else if (comp == 4) { const int j = (int)((h2 >> 7) % (3 * SBW)), t = j / SBW, hh = (j % SBW) / HD, d_ = j % HD;
        const float d = dbg_dot(F.H + (size_t)row * DM, F.w_in, DM, NIN, 2 * GW + j, lane); ref = d * (t == 0 ? QSCALE : 1.f); fast = dbg_bf(F.QKV, ((size_t)(t * NH + hh) * SEQ + row) * HD + d_); tol = t == 0 ? 0.06f : 0.5f; }
    else if (comp == 5) { const int j = (int)((h2 >> 7) % (2 * DM)); const float d = dbg_dot(F.H + (size_t)row * DM, F.w_in, DM, NIN, 2 * GW + 3 * SBW + j, lane); ref = 1.f / (1.f + expf(-d)); fast = dbg_bf(F.SA, (size_t)row * 2 * DM + j); tol = 0.2f; }
    else if (comp == 8) { const float da = dbg_dot(F.GA + (size_t)row * GW, F.w_pa, GW, DM, c4, lane), db = dbg_dot(F.AT + (size_t)row * SBW, F.w_pb, SBW, DM, c4, lane);
        ref = dbg_bf(F.SA, (size_t)row * 2 * DM + c4) * da + dbg_bf(F.SA, (size_t)row * 2 * DM + DM + c4) * db; fast = dbg_bf(F.MIXIN, (size_t)row * DM + c4); tol = 0.5f; }
    else if (comp == 9) { ref = dbg_dot(F.MIXIN + (size_t)row * DM, F.w_o, DM, DM, c4, lane); fast = dbg_bf(F.MIX, (size_t)row * DM + c4); tol = 0.5f; }
    else if (comp == 11) { const float d = dbg_dot(F.H + (size_t)row * DM, F.w_ff1, DM, DFF, (int)((h2 >> 7) % DFF), lane); const float r = fmaxf(d, 0.f); ref = r * r; fast = dbg_bf(F.ACT, (size_t)row * DFF + (int)((h2 >> 7) % DFF)); tol = 2.0f; }
    else if (comp == 12) { ref = dbg_dot(F.ACT + (size_t)row * DFF, F.w_ff2, DFF, DM, c4, lane); fast = dbg_bf(F.FF, (size_t)row * DM + c4); tol = 0.5f; }
    else if (comp == 13 || comp == 14) {
        float s = 0.f; for (int k = lane; k < DM; k += 64) { const float v = dbg_bf(F.MIX, (size_t)row * DM + k); s += v * v; }
        const float inv1 = 1.f / sqrtf(wave_sum(s) / DM + EPS);
        float s2 = 0.f, x1c = 0.f; for (int k = lane; k < DM; k += 64) { const float x1 = F.x[(size_t)row * DM + k] + F.mod[2 * DM + k] * F.g_post_mix[k] * dbg_bf(F.MIX, (size_t)row * DM + k) * inv1; s2 += x1 * x1; }
        x1c = F.x[(size_t)row * DM + c4] + F.mod[2 * DM + c4] * F.g_post_mix[c4] * dbg_bf(F.MIX, (size_t)row * DM + c4) * inv1;
        const float inv2 = 1.f / sqrtf(wave_sum(s2) / DM + EPS);
        if (comp == 13) { ref = x1c * inv2 * F.g_pre_mlp[c4] * (1.f + F.mod[4 * DM + c4]) + F.mod[3 * DM + c4]; fast = dbg_bf(F.H, (size_t)row * DM + c4); }
        else { float s3 = 0.f; for (int k = lane; k < DM; k += 64) { const float v = dbg_bf(F.FF, (size_t)row * DM + k); s3 += v * v; }
            const float inv3 = 1.f / sqrtf(wave_sum(s3) / DM + EPS);
            ref = x1c + F.mod[5 * DM + c4] * F.g_post_mlp[c4] * dbg_bf(F.FF, (size_t)row * DM + c4) * inv3; fast = F.out[(size_t)row * DM + c4]; } }
    const float err = fabsf(fast - ref) / (fabsf(ref) + tol);
    if (lane == 0) { dbg_atomic_max(E + comp, (err == err) ? err : 1e9f);
        if (!(err <= 0.3f)) { unsigned* U = (unsigned*)(E + 64) + comp * 8; atomicAdd(U + 0, 1u); atomicMin(U + 1, (unsigned)row ^ 0xffffffffu ^ 0xffffffffu); atomicMax(U + 2, (unsigned)row); } }
}
__global__ void dbg_leak(Args args) {
    const float* E = (const float*)(args.ws + WS_DBG);
    int code = 99;
    for (int c = 1; c < 16; ++c) if (E[c] > 0.03f) { int lvl = (int)(E[c] * 10.f); if (lvl > 9) lvl = 9; if (lvl < 0) lvl = 0; code = c * 10 + lvl; break; }
#ifdef DBG_COUNT_COMP
    code = (int)((const unsigned*)(E + 64))[DBG_COUNT_COMP * 8 + DBG_COUNT_FIELD];
#endif
    args.out[0] = 1000.f * (float)code;
}
#endif
extern "C" void kernel_launch(void* const* d_in, const int* in_sizes, int n_in, void* d_out, int out_size, void* d_ws, size_t ws_size, hipStream_t stream) {
    static int grid = 0;
    if (grid == 0) {
        if (n_in != 17 || out_size != SEQ * DM || ws_size < WS_END) { fprintf(stderr, "kernel_launch: unexpected shapes (n_in %d out %d ws %zu)\n", n_in, out_size, ws_size); grid = -1; return; }
        int dev = 0, cus = 0, per_cu = 0;
        if (hipGetDevice(&dev) != hipSuccess || hipDeviceGetAttribute(&cus, hipDeviceAttributeMultiprocessorCount, dev) != hipSuccess) { grid = -1; return; }
        if (hipFuncSetAttribute((const void*)fwd, hipFuncAttributeMaxDynamicSharedMemorySize, LDS_BYTES) != hipSuccess) { fprintf(stderr, "kernel_launch: hipFuncSetAttribute failed\n"); grid = -1; return; }
        if (hipOccupancyMaxActiveBlocksPerMultiprocessor(&per_cu, (const void*)fwd, NWAVES * 64, LDS_BYTES) != hipSuccess || per_cu < 1)
            fprintf(stderr, "kernel_launch: note: occupancy query reports %d workgroups per CU\n", per_cu);
        (void)hipGetLastError();
        grid = cus;
    }
    if (grid < 0) return;
    (void)hipMemsetAsync((char*)d_ws + WS_CTL, 0, CTL_ZERO_BYTES, stream);
    Args a{};
    for (int i = 0; i < 17; ++i) a.in[i] = (const float*)d_in[i];
    a.out = (float*)d_out; a.ws = (unsigned char*)d_ws;
#if MK_ONE_LAUNCH
    a.ph_lo = 0; a.ph_hi = N_PHASES;
    hipLaunchKernelGGL(fwd, dim3(grid), dim3(NWAVES * 64), LDS_BYTES, stream, a);
#else
#if MK_DEBUG
    (void)hipMemsetAsync((char*)d_ws + WS_DBG, 0, 4096, stream);
#endif
    for (int p = 0; p < N_PHASES; ++p) { a.ph_lo = p; a.ph_hi = p + 1; hipLaunchKernelGGL(fwd, dim3(grid), dim3(NWAVES * 64), LDS_BYTES, stream, a);
#if MK_DEBUG
        static const int chk[N_PHASES][3] = {{1, 0, 0}, {2, 0, 0}, {3, 4, 5}, {0, 0, 0}, {0, 0, 0}, {8, 0, 0}, {9, 0, 0}, {13, 0, 0}, {11, 0, 0}, {12, 0, 0}, {14, 0, 0}};
        for (int q = 0; q < 3; ++q) if (chk[p][q]) { Args b = a; b.ph_lo = chk[p][q]; b.ph_hi = 0; hipLaunchKernelGGL(dbg_check, dim3(2048), dim3(64), 0, stream, b); }
#endif
    }
#if MK_DEBUG
    hipLaunchKernelGGL(dbg_leak, dim3(1), dim3(1), 0, stream, a);
#endif
#endif
}
```

```cpp
#include <hip/hip_runtime.h>
#include <cstdio>
#include <cstdint>
#ifndef PG8_WGM
#define PG8_WGM 8
#endif
namespace pg8 {
#define PG8_LAS __attribute__((address_space(3)))
typedef unsigned short bf16_t;
typedef short bf16x8 __attribute__((ext_vector_type(8)));
typedef float f32x4 __attribute__((ext_vector_type(4)));
typedef unsigned u32x4 __attribute__((ext_vector_type(4)));
constexpr int BM = 256, BK = 64, HALF = 128, HTB = HALF * BK * 2  , STAGE_BYTES = 8 * HTB, NXCD = 8, WGM = PG8_WGM;

__host__ __device__ __forceinline__ int lds_byte(int r, int c) { const int st = (r >> 4) * 2 + (c >> 5), rr = r & 15, cc = c & 31, ob = rr * 64 + cc * 2; return st * 1024 + (ob ^ (((ob >> 9) & 1) << 5)); }
__host__ __device__ __forceinline__ void stage_rc(int b, int& R, int& C) { const int st = b / 1024, sb = b % 1024, swz = sb ^ (((sb >> 9) & 1) << 5); R = (st >> 1) * 16 + swz / 64; C = (st & 1) * 32 + (swz % 64) / 2; }
__host__ __device__ __forceinline__ int perm32(int rho) { const int n = rho >> 4, i = rho & 15; return 8 * (i >> 2) + 4 * n + (i & 3); }

struct Unit { int pm, pn; int k0 = 0, nt = 0, mode = 0; };
struct Gemm { const bf16_t* A; const bf16_t* Bt; int M, N, K; };

struct StaticOrder {
    static constexpr bool SPLIT = false, DUAL = false;
    int nM, nN, nwg, G, c, rep;
    __host__ __device__ void init(int M, int N, int G_, int c_, int rep_ = 1) { nM = M / BM; nN = N / BM; nwg = nM * nN; G = G_; c = c_; rep = rep_; }
    __host__ __device__ bool next(int i, Unit& u) const {
        const long L = (long)i * G + c; if (L >= (long)nwg * rep) return false;
        int wgid = rep > 1 ? (int)(L % nwg) : (int)L; { const int q = nwg / NXCD, r = nwg % NXCD, xcd = wgid % NXCD, off = wgid / NXCD; wgid = (xcd < r ? xcd * (q + 1) : r * (q + 1) + (xcd - r) * q) + off; }
        const int nig = WGM * nN, gid = wgid / nig, fm = gid * WGM, gsz = (nM - fm) < WGM ? (nM - fm) : WGM;
        u.pm = fm + ((wgid % nig) % gsz); u.pn = (wgid % nig) / gsz; return true;
    }
    __device__ __forceinline__ void a_ready(const Unit&) const {}
    __device__ __forceinline__ void done(const Unit&) const {}
};
struct GateOrder : StaticOrder {
    static constexpr bool SPLIT = false, DUAL = false;
    int nNh;
    __host__ __device__ void init(int M, int N, int G_, int c_) { StaticOrder::init(M, N, G_, c_); nNh = N / BM; }
    __host__ __device__ bool next(int i, Unit& u) const { if (!StaticOrder::next(i >> 1, u)) return false; u.pn += (i & 1) * nNh; return true; }
};
struct DualOrder : StaticOrder {
    static constexpr bool SPLIT = false, DUAL = true;
    __host__ __device__ bool next(int i, Unit& u) const { if (!StaticOrder::next(i >> 1, u)) return false; u.mode = i & 1; return true; }
};
struct SplitOrder : StaticOrder {
    static constexpr bool SPLIT = true, DUAL = false;
    int d, R, ntk; float* part;
    __host__ __device__ void init(int M, int N, int G_, int c_, int ntk_, float* part_) { StaticOrder::init(M, N, G_, c_); ntk = ntk_; part = part_; R = nwg / G_;
        d = (nwg % G_ == 0 && ntk_ >= 16) ? (((c_ & 7) * ntk_ / 8) & ~1) : 0; }
    __host__ __device__ bool next(int i, Unit& u) const {
        if (d == 0) { if (!StaticOrder::next(i, u)) return false; u.k0 = 0; u.nt = ntk; u.mode = 0; return true; }
        if (i > R) return false;
        StaticOrder::next(i == R ? 0 : i, u);
        if (i == 0) { u.k0 = d; u.nt = ntk - d; u.mode = 1; } else if (i == R) { u.k0 = 0; u.nt = d; u.mode = 2; } else { u.k0 = 0; u.nt = ntk; u.mode = 0; }
        return true;
    }
};


typedef float f32x2_c __attribute__((ext_vector_type(2))); typedef __bf16 bf16x2_c __attribute__((ext_vector_type(2)));
__device__ __forceinline__ unsigned cvt_pk_bf16(float lo, float hi) { f32x2_c v = {lo, hi}; bf16x2_c b = __builtin_convertvector(v, bf16x2_c); return __builtin_bit_cast(unsigned, b); }
typedef float f32x2 __attribute__((ext_vector_type(2)));
__device__ __forceinline__ f32x2 gelu_pk(f32x2 v) {
    const f32x2 av = __builtin_elementwise_abs(v), d = av * 0.2316418882f + 1.0f;
    f32x2 t; t.x = __builtin_amdgcn_rcpf(d.x); t.y = __builtin_amdgcn_rcpf(d.y);
    f32x2 q = t * 0.5307027145f + (-0.7265760135f); q = q * t + 0.7107068705f; q = q * t + (-0.142248368f); q = q * t + 0.127414796f; q = q * t;
    const f32x2 s = (v * v) * (-0.72134752044f);
    f32x2 e; e.x = __builtin_amdgcn_exp2f(s.x); e.y = __builtin_amdgcn_exp2f(s.y);
    const f32x2 m = v * (q * e), r = v - m;
    f32x2 o; o.x = v.x < 0.f ? m.x : r.x; o.y = v.y < 0.f ? m.y : r.y; return o;
}
__device__ __forceinline__ float sigmoid_f(float x) { return __builtin_amdgcn_rcpf(1.0f + __builtin_amdgcn_exp2f(-1.4426950408889634f * x)); }
__device__ __forceinline__ float bf_lo(unsigned u) { return __builtin_bit_cast(float, u << 16); }
__device__ __forceinline__ float bf_hi(unsigned u) { return __builtin_bit_cast(float, u & 0xffff0000u); }

template <int LAY> __device__ __forceinline__ size_t tile_base(int pm, int pn, int N, int wr, int wc, int fr, int fq) {
    if (LAY == 1) return (((size_t)pm * (N / 64) + pn * 4 + (wc >> 1)) * BM + wr * 64 + fr) * 64 + (wc & 1) * 32 + 8 * fq;
    if (LAY == 2) return (((size_t)pm * (N / 32) + pn * 8 + wc) * BM + wr * 64 + fr) * 32 + 8 * fq;
    return (size_t)(pm * BM + wr * 64 + fr) * N + (size_t)pn * BM + wc * 32 + 8 * fq;
}
template <int LAY> __device__ __forceinline__ size_t tile_rowstep(int N) { return LAY == 1 ? (size_t)64 : LAY == 2 ? (size_t)32 : (size_t)N; }
template <int LAY> __device__ __forceinline__ size_t tile_bjstep() { return LAY == 0 ? (size_t)HALF : (size_t)(2 * BM * 64); }

template <int ACT> __device__ __forceinline__ void epi_store_tile(const f32x4 (&acc)[2][2][4][2], bf16_t* base, size_t ld, size_t bjstride, int row0, int c8, float scale) {
#ifdef EPI_BJ_OUTER
#pragma unroll
    for (int bj = 0; bj < 2; ++bj)
#pragma unroll
    for (int ai = 0; ai < 2; ++ai)
#pragma unroll
        for (int m = 0; m < 4; ++m) { bf16_t* rowp = base + (size_t)(row0 + ai * HALF + m * 16) * ld + c8; {
#else
#pragma unroll
    for (int ai = 0; ai < 2; ++ai)
#pragma unroll
        for (int m = 0; m < 4; ++m) { bf16_t* rowp = base + (size_t)(row0 + ai * HALF + m * 16) * ld + c8;
#pragma unroll
            for (int bj = 0; bj < 2; ++bj) {
#endif
                f32x4 v0 = acc[ai][bj][m][0], v1 = acc[ai][bj][m][1];
                if (ACT == 1) {
#pragma unroll
                    for (int e = 0; e < 4; ++e) { const float a = fmaxf(v0[e], 0.f), b = fmaxf(v1[e], 0.f); v0[e] = a * a; v1[e] = b * b; } }
                if (ACT == 2) { f32x2 a = gelu_pk((f32x2){v0[0], v0[1]}), b = gelu_pk((f32x2){v0[2], v0[3]}), c = gelu_pk((f32x2){v1[0], v1[1]}), d = gelu_pk((f32x2){v1[2], v1[3]});
                    v0 = (f32x4){a.x, a.y, b.x, b.y}; v1 = (f32x4){c.x, c.y, d.x, d.y}; }
                if (ACT == 3) {
#pragma unroll
                    for (int e = 0; e < 4; ++e) { v0[e] = sigmoid_f(v0[e]); v1[e] = sigmoid_f(v1[e]); } }
                if (ACT == 4) { v0 = v0 * scale; v1 = v1 * scale; }
                u32x4 w; w.x = cvt_pk_bf16(v0[0], v0[1]); w.y = cvt_pk_bf16(v0[2], v0[3]); w.z = cvt_pk_bf16(v1[0], v1[1]); w.w = cvt_pk_bf16(v1[2], v1[3]);
                *(u32x4*)(rowp + bj * bjstride) = w;
                } }
}
template <int ACT> __device__ __forceinline__ void epi_store_tile_buf(const f32x4 (&acc)[2][2][4][2], __amdgpu_buffer_rsrc_t rsrc, unsigned voff0, unsigned ld2, unsigned bj2) {
#pragma unroll
    for (int ai = 0; ai < 2; ++ai)
#pragma unroll
        for (int m = 0; m < 4; ++m) {
#pragma unroll
            for (int bj = 0; bj < 2; ++bj) { f32x4 v0 = acc[ai][bj][m][0], v1 = acc[ai][bj][m][1];
                if (ACT == 1) {
#pragma unroll
                    for (int e = 0; e < 4; ++e) { const float a = fmaxf(v0[e], 0.f), b = fmaxf(v1[e], 0.f); v0[e] = a * a; v1[e] = b * b; } }
                if (ACT == 2) { f32x2 a = gelu_pk((f32x2){v0[0], v0[1]}), b = gelu_pk((f32x2){v0[2], v0[3]}), c = gelu_pk((f32x2){v1[0], v1[1]}), d = gelu_pk((f32x2){v1[2], v1[3]});
                    v0 = (f32x4){a.x, a.y, b.x, b.y}; v1 = (f32x4){c.x, c.y, d.x, d.y}; }
                if (ACT == 3) {
#pragma unroll
                    for (int e = 0; e < 4; ++e) { v0[e] = sigmoid_f(v0[e]); v1[e] = sigmoid_f(v1[e]); } }
                u32x4 w; w.x = cvt_pk_bf16(v0[0], v0[1]); w.y = cvt_pk_bf16(v0[2], v0[3]); w.z = cvt_pk_bf16(v1[0], v1[1]); w.w = cvt_pk_bf16(v1[2], v1[3]);
                __builtin_amdgcn_raw_buffer_store_b128(w, rsrc, voff0 + (unsigned)(ai * HALF + m * 16) * ld2 + (unsigned)bj * bj2, 0, 0); } }
}
template <int ACT, int LAY = 0> struct EpiAct {
    static constexpr bool PERM = true, AFTER_DRAIN = false, IDEM = true;
    bf16_t* O; int N; int pn_off;
    __device__ __forceinline__ void operator()(const f32x4 (&acc)[2][2][4][2], const Unit& u, int wr, int wc, int fr, int fq) const {
#ifdef EPI_BUFSTORE
        const __amdgpu_buffer_rsrc_t rsrc = __builtin_amdgcn_make_buffer_rsrc((void*)O, 0, 0x7ffffff0, 0x00020000);
        epi_store_tile_buf<ACT>(acc, rsrc, (unsigned)(tile_base<LAY>(u.pm, u.pn + pn_off, N, wr, wc, fr, fq) * 2), (unsigned)(tile_rowstep<LAY>(N) * 2), (unsigned)(tile_bjstep<LAY>() * 2));
#else
        epi_store_tile<ACT>(acc, O + tile_base<LAY>(u.pm, u.pn + pn_off, N, wr, wc, fr, fq), tile_rowstep<LAY>(N), tile_bjstep<LAY>(), 0, 0, 1.f);
#endif
    }
};
struct EpiQKV {
    static constexpr bool PERM = true, AFTER_DRAIN = false, IDEM = true;
    bf16_t* QKV; int M; float qscale;
    __device__ __forceinline__ void operator()(const f32x4 (&acc)[2][2][4][2], const Unit& u, int wr, int wc, int fr, int fq) const {
        const int t = u.pn >> 3, hp = u.pn & 7;
        epi_store_tile<4>(acc, QKV + (size_t)(t * 16 + 2 * hp) * M * 128, 128, (size_t)M * 128, u.pm * BM + wr * 64 + fr, wc * 32 + 8 * fq, t == 0 ? qscale : 1.f);
    }
};
template <int LAY = 0> struct EpiGeluStats {
    static constexpr bool PERM = true, AFTER_DRAIN = false, IDEM = true;
    bf16_t* O; int ldc; int pn_off; float* part;
    __device__ __forceinline__ void operator()(const f32x4 (&acc)[2][2][4][2], const Unit& u, int wr, int wc, int fr, int fq) const {
        const int row0 = u.pm * BM + wr * 64 + fr;
        bf16_t* base = O + tile_base<LAY>(u.pm, u.pn + pn_off, ldc, wr, wc, fr, fq);
        const size_t trow = tile_rowstep<LAY>(ldc), tbj = tile_bjstep<LAY>();
#pragma unroll
        for (int ai = 0; ai < 2; ++ai)
#pragma unroll
            for (int m = 0; m < 4; ++m) { const int row = row0 + ai * HALF + m * 16; bf16_t* rowp = base + (size_t)(ai * HALF + m * 16) * trow; float s = 0.f, ss = 0.f;
#pragma unroll
                for (int bj = 0; bj < 2; ++bj) { const f32x4 v0 = acc[ai][bj][m][0], v1 = acc[ai][bj][m][1];
                    const f32x2 a = gelu_pk((f32x2){v0[0], v0[1]}), b = gelu_pk((f32x2){v0[2], v0[3]}), c = gelu_pk((f32x2){v1[0], v1[1]}), d = gelu_pk((f32x2){v1[2], v1[3]});
                    s += ((a.x + a.y) + (b.x + b.y)) + ((c.x + c.y) + (d.x + d.y));
                    ss += ((a.x * a.x + a.y * a.y) + (b.x * b.x + b.y * b.y)) + ((c.x * c.x + c.y * c.y) + (d.x * d.x + d.y * d.y));
                    u32x4 w; w.x = cvt_pk_bf16(a.x, a.y); w.y = cvt_pk_bf16(b.x, b.y); w.z = cvt_pk_bf16(c.x, c.y); w.w = cvt_pk_bf16(d.x, d.y);
                    *(u32x4*)(rowp + bj * tbj) = w; }
                s += __shfl_xor(s, 16); ss += __shfl_xor(ss, 16); s += __shfl_xor(s, 32); ss += __shfl_xor(ss, 32);
                if (fq == 0) *(f32x2*)(part + (((size_t)row * 8 + u.pn) * 4 + wc) * 2) = (f32x2){s, ss}; }
    }
};
template <bool FIRST, int TLAY = 0, int GLAY = 0> struct EpiGate {
    static constexpr bool PERM = true, AFTER_DRAIN = false, IDEM = FIRST;
    const bf16_t* G; int ldg; int gpn; bf16_t* T; int ldc;
    __device__ __forceinline__ void operator()(const f32x4 (&acc)[2][2][4][2], const Unit& u, int wr, int wc, int fr, int fq) const {
        const size_t tbase = tile_base<TLAY>(u.pm, u.pn, ldc, wr, wc, fr, fq), trow = tile_rowstep<TLAY>(ldc), tbj = tile_bjstep<TLAY>();
        const size_t gbase = tile_base<GLAY>(u.pm, u.pn + gpn, ldg, wr, wc, fr, fq), grow = tile_rowstep<GLAY>(ldg), gbj = tile_bjstep<GLAY>();
#pragma unroll
        for (int ai = 0; ai < 2; ++ai)
#pragma unroll
            for (int m = 0; m < 4; ++m) { const size_t off = tbase + (size_t)(ai * HALF + m * 16) * trow, goff = gbase + (size_t)(ai * HALF + m * 16) * grow;
#pragma unroll
                for (int bj = 0; bj < 2; ++bj) { const u32x4 g = *(const u32x4*)(G + goff + bj * gbj);
                    const f32x4 a0 = acc[ai][bj][m][0], a1 = acc[ai][bj][m][1];
                    float o[8] = {a0[0] * bf_lo(g.x), a0[1] * bf_hi(g.x), a0[2] * bf_lo(g.y), a0[3] * bf_hi(g.y), a1[0] * bf_lo(g.z), a1[1] * bf_hi(g.z), a1[2] * bf_lo(g.w), a1[3] * bf_hi(g.w)};
                    if (!FIRST) { const u32x4 p = *(const u32x4*)(T + off + bj * tbj);
                        o[0] += bf_lo(p.x); o[1] += bf_hi(p.x); o[2] += bf_lo(p.y); o[3] += bf_hi(p.y); o[4] += bf_lo(p.z); o[5] += bf_hi(p.z); o[6] += bf_lo(p.w); o[7] += bf_hi(p.w); }
                    u32x4 w; w.x = cvt_pk_bf16(o[0], o[1]); w.y = cvt_pk_bf16(o[2], o[3]); w.z = cvt_pk_bf16(o[4], o[5]); w.w = cvt_pk_bf16(o[6], o[7]);
                    *(u32x4*)(T + off + bj * tbj) = w; } }
    }
};
template <int TLAY = 0, int GLAY = 0> struct EpiGateDual {
    static constexpr bool PERM = true, AFTER_DRAIN = false, IDEM = false;
    const bf16_t* G; int ldg; int gpn_a, gpn_b; bf16_t* T; int ldc;
    static __device__ __forceinline__ float safe(float g) { return fmaxf(g, 8.673617379884035e-19f); }
    __device__ __forceinline__ void mid(f32x4 (&acc)[2][2][4][2], const Unit& u, int wr, int wc, int fr, int fq) const {
        const size_t ga0 = tile_base<GLAY>(u.pm, u.pn + gpn_a, ldg, wr, wc, fr, fq), gb0 = tile_base<GLAY>(u.pm, u.pn + gpn_b, ldg, wr, wc, fr, fq), grow = tile_rowstep<GLAY>(ldg), gbj = tile_bjstep<GLAY>();
#pragma unroll
        for (int ai = 0; ai < 2; ++ai)
#pragma unroll
            for (int m = 0; m < 4; ++m) { const size_t ro = (size_t)(ai * HALF + m * 16) * grow;
#pragma unroll
                for (int bj = 0; bj < 2; ++bj) { const u32x4 a = *(const u32x4*)(G + ga0 + ro + bj * gbj), b = *(const u32x4*)(G + gb0 + ro + bj * gbj);
                    f32x4& a0 = acc[ai][bj][m][0]; f32x4& a1 = acc[ai][bj][m][1];
                    a0[0] *= bf_lo(a.x) * __builtin_amdgcn_rcpf(safe(bf_lo(b.x))); a0[1] *= bf_hi(a.x) * __builtin_amdgcn_rcpf(safe(bf_hi(b.x)));
                    a0[2] *= bf_lo(a.y) * __builtin_amdgcn_rcpf(safe(bf_lo(b.y))); a0[3] *= bf_hi(a.y) * __builtin_amdgcn_rcpf(safe(bf_hi(b.y)));
                    a1[0] *= bf_lo(a.z) * __builtin_amdgcn_rcpf(safe(bf_lo(b.z))); a1[1] *= bf_hi(a.z) * __builtin_amdgcn_rcpf(safe(bf_hi(b.z)));
                    a1[2] *= bf_lo(a.w) * __builtin_amdgcn_rcpf(safe(bf_lo(b.w))); a1[3] *= bf_hi(a.w) * __builtin_amdgcn_rcpf(safe(bf_hi(b.w))); } }
    }
    __device__ __forceinline__ void operator()(const f32x4 (&acc)[2][2][4][2], const Unit& u, int wr, int wc, int fr, int fq) const {
        const size_t tbase = tile_base<TLAY>(u.pm, u.pn, ldc, wr, wc, fr, fq), trow = tile_rowstep<TLAY>(ldc), tbj = tile_bjstep<TLAY>();
        const size_t gb0 = tile_base<GLAY>(u.pm, u.pn + gpn_b, ldg, wr, wc, fr, fq), grow = tile_rowstep<GLAY>(ldg), gbj = tile_bjstep<GLAY>();
#pragma unroll
        for (int ai = 0; ai < 2; ++ai)
#pragma unroll
            for (int m = 0; m < 4; ++m) { const size_t off = tbase + (size_t)(ai * HALF + m * 16) * trow, goff = gb0 + (size_t)(ai * HALF + m * 16) * grow;
#pragma unroll
                for (int bj = 0; bj < 2; ++bj) { const u32x4 g = *(const u32x4*)(G + goff + bj * gbj);
                    const f32x4 a0 = acc[ai][bj][m][0], a1 = acc[ai][bj][m][1];
                    u32x4 w; w.x = cvt_pk_bf16(a0[0] * safe(bf_lo(g.x)), a0[1] * safe(bf_hi(g.x))); w.y = cvt_pk_bf16(a0[2] * safe(bf_lo(g.y)), a0[3] * safe(bf_hi(g.y)));
                    w.z = cvt_pk_bf16(a1[0] * safe(bf_lo(g.z)), a1[1] * safe(bf_hi(g.z))); w.w = cvt_pk_bf16(a1[2] * safe(bf_lo(g.w)), a1[3] * safe(bf_hi(g.w)));
                    *(u32x4*)(T + off + bj * tbj) = w; } }
    }
};
template <class Epi, class Sched, bool ALIGN_EPI = false, bool SP2 = false, int ATILED = 0, bool BTILED = false, bool KREV = false, bool EPI_OVERLAP = false>
__device__ __forceinline__ void gemm_phase(PG8_LAS unsigned char* lds, const Gemm g, const Sched& S, const Epi& E, const bf16_t* A2 = nullptr, const bf16_t* Bt2 = nullptr) {
    const int tid = threadIdx.x, wid = __builtin_amdgcn_readfirstlane(tid >> 6), lane = tid & 63, wr = wid >> 2, wc = wid & 3, fr = lane & 15, fq = lane >> 4;
    const int K = g.K, nt_full = K / BK;
    unsigned voffA[2], voffB[2];
#pragma unroll
    for (int i = 0; i < 2; ++i) { int R, C; stage_rc(tid * 16 + i * 8192, R, C); const int Rb = Epi::PERM ? ((R & ~31) + perm32(R & 31)) : R;
        voffA[i] = ATILED == 2 ? (unsigned)(((C >> 5) * BM + R) * 32 + (C & 31)) * 2u : (unsigned)(R * (ATILED ? BK : K) + C) * 2u; voffB[i] = (unsigned)(Rb * (BTILED ? BK : K) + C) * 2u; }
    const size_t kstep = (size_t)(BK * 2);
    const size_t hstep = (size_t)HALF * K * 2;
    const size_t tstep = 2 * hstep;
    const ptrdiff_t kstepA = (KREV ? -1 : 1) * (ptrdiff_t)(ATILED ? (size_t)BM * BK * 2 : kstep); const size_t hstepA = ATILED == 2 ? (size_t)HALF * 32 * 2 : ATILED ? (size_t)HALF * BK * 2 : hstep;
    const ptrdiff_t kstepB = (KREV ? -1 : 1) * (ptrdiff_t)(BTILED ? (size_t)BM * BK * 2 : kstep); const size_t hstepB = BTILED ? (size_t)HALF * BK * 2 : hstep;
    const ptrdiff_t krevA = KREV ? -(ptrdiff_t)(nt_full - 1) * kstepA : 0, krevB = KREV ? -(ptrdiff_t)(nt_full - 1) * kstepB : 0;
    const unsigned ldsw = (unsigned)wid * 1024u;
    const int aoff = lds_byte(wr * 64 + fr, fq * 8), boff = lds_byte(wc * 32 + fr, fq * 8);
#define PG8_SA(b, h) (((b) * 2 + (h)) * HTB)
#define PG8_SB(b, h) ((4 + (b) * 2 + (h)) * HTB)
#ifndef AUX_A
#define AUX_A 0
#endif
#ifndef AUX_B
#define AUX_B 0
#endif
#define PG8_STAGE(bufoff, gbase, voff, aux) do { _Pragma("unroll") for (int _i = 0; _i < 2; ++_i) \
        __builtin_amdgcn_global_load_lds((const unsigned*)((const char*)(gbase) + (voff)[_i]), (PG8_LAS unsigned*)(lds + (bufoff) + ldsw + _i * 8192), 16, 0, aux); } while (0)
#define PG8_LDA(dst, b, h) do { _Pragma("unroll") for (int m = 0; m < 4; ++m) _Pragma("unroll") for (int k = 0; k < 2; ++k) dst[m][k] = *(const PG8_LAS bf16x8*)(lds + PG8_SA(b, h) + aoff + m * 2048 + k * 1024); } while (0)
#define PG8_LDB(dst, b, h) do { _Pragma("unroll") for (int n = 0; n < 2; ++n) _Pragma("unroll") for (int k = 0; k < 2; ++k) dst[n][k] = *(const PG8_LAS bf16x8*)(lds + PG8_SB(b, h) + boff + n * 2048 + k * 1024); } while (0)
#ifdef NO_SETPRIO
#define PG8_PRIO(x)
#else
#define PG8_PRIO(x) __builtin_amdgcn_s_setprio(x)
#endif
#ifndef MMA_PRIO
#define MMA_PRIO 1
#endif
#define PG8_MMA(ai, bj, At, Bt) do { PG8_PRIO(MMA_PRIO); _Pragma("unroll") for (int m = 0; m < 4; ++m) _Pragma("unroll") for (int n = 0; n < 2; ++n) _Pragma("unroll") for (int k = 0; k < 2; ++k) \
        acc[ai][bj][m][n] = __builtin_amdgcn_mfma_f32_16x16x32_bf16(Bt[n][k], At[m][k], acc[ai][bj][m][n], 0, 0, 0); PG8_PRIO(0); } while (0)
#define PG8_WAIT_V(n) asm volatile("s_waitcnt vmcnt(" #n ")" ::: "memory")
#define PG8_WAIT_L(n) asm volatile("s_waitcnt lgkmcnt(" #n ")" ::: "memory")
#define PG8_BAR __builtin_amdgcn_s_barrier()
#define PG8_SCHED __builtin_amdgcn_sched_barrier(0)
    Unit cur, nxt; int ui = 0;
    if (!S.next(0, cur)) return;
    f32x4 acc[2][2][4][2];
#pragma unroll
    for (int a = 0; a < 2; ++a)
#pragma unroll
        for (int b = 0; b < 2; ++b)
#pragma unroll
            for (int m = 0; m < 4; ++m)
#pragma unroll
                for (int n = 0; n < 2; ++n) acc[a][b][m][n] = (f32x4){0.f, 0.f, 0.f, 0.f};
    bf16x8 At[4][2], B0[2][2], B1[2][2];
    int nt = nt_full; if constexpr (Sched::SPLIT) nt = cur.nt;
    const char* cA = (const char*)g.A + (size_t)cur.pm * tstep + krevA; const char* cB = (const char*)g.Bt + (size_t)cur.pn * tstep + krevB;
    if constexpr (Sched::SPLIT) { cA += (ptrdiff_t)cur.k0 * kstepA; cB += (ptrdiff_t)cur.k0 * kstepB; }
    S.a_ready(cur);
    if constexpr (SP2) {
        PG8_STAGE(PG8_SB(0, 0), cB, voffB, AUX_B); PG8_STAGE(PG8_SB(0, 1), cB + hstepB, voffB, AUX_B); PG8_STAGE(PG8_SA(0, 0), cA, voffA, AUX_A); PG8_STAGE(PG8_SA(0, 1), cA + hstepA, voffA, AUX_A);
        if (wr == 1) PG8_BAR;
        PG8_WAIT_V(2); PG8_BAR;
        PG8_STAGE(PG8_SB(1, 0), cB + kstepB, voffB, AUX_B); PG8_STAGE(PG8_SA(1, 0), cA + kstepA, voffA, AUX_A); PG8_STAGE(PG8_SB(1, 1), cB + hstepB + kstepB, voffB, AUX_B);
        PG8_WAIT_V(6); PG8_BAR;
    } else {
        PG8_STAGE(PG8_SB(0, 0), cB, voffB, AUX_B); PG8_STAGE(PG8_SA(0, 0), cA, voffA, AUX_A); PG8_STAGE(PG8_SB(0, 1), cB + hstepB, voffB, AUX_B); PG8_STAGE(PG8_SA(0, 1), cA + hstepA, voffA, AUX_A);
        if (wr == 1) PG8_BAR;
        PG8_WAIT_V(4); PG8_BAR;
        PG8_STAGE(PG8_SB(1, 0), cB + kstepB, voffB, AUX_B); PG8_STAGE(PG8_SA(1, 0), cA + kstepA, voffA, AUX_A); PG8_STAGE(PG8_SB(1, 1), cB + hstepB + kstepB, voffB, AUX_B);
        PG8_WAIT_V(6); PG8_BAR;
    }
    for (;;) {
        const bool has_next = S.next(ui + 1, nxt);
        const char* nA = has_next ? (const char*)g.A + (size_t)nxt.pm * tstep + krevA : cA; const char* nB = has_next ? (const char*)g.Bt + (size_t)nxt.pn * tstep + krevB : cB;
        if constexpr (Sched::DUAL) { if (has_next && nxt.mode) { nA = (const char*)A2 + (size_t)nxt.pm * tstep + krevA; nB = (const char*)Bt2 + (size_t)nxt.pn * tstep + krevB; } }
        if constexpr (Sched::SPLIT) { if (has_next) { nA += (ptrdiff_t)nxt.k0 * kstepA; nB += (ptrdiff_t)nxt.k0 * kstepB; } }
        int t_first = 0;
        if constexpr (SP2 && EPI_OVERLAP) { if (ui > 0) {
            const int t = 0; const bool last = false;

#ifdef KWRAP_PROBE
#define PG8_KT(x) ((x) & 7)
#else
#define PG8_KT(x) (x)
#endif
            const char* a1 = cA + (ptrdiff_t)PG8_KT(t + 1) * kstepA;
            const char* a2 = last ? nA : cA + (ptrdiff_t)PG8_KT(t + 2) * kstepA; const char* b2 = last ? nB : cB + (ptrdiff_t)PG8_KT(t + 2) * kstepB;
            const char* a3 = last ? a2 + kstepA : cA + (ptrdiff_t)PG8_KT(t + 3) * kstepA; const char* b3 = last ? b2 + kstepB : cB + (ptrdiff_t)PG8_KT(t + 3) * kstepB;
            PG8_LDB(B0, 0, 0); PG8_LDB(B1, 0, 1); PG8_SCHED; PG8_LDA(At, 0, 0);
            PG8_WAIT_V(24); PG8_WAIT_L(0); PG8_BAR; PG8_MMA(0, 0, At, B0); PG8_MMA(0, 1, At, B1); PG8_BAR; PG8_SCHED;
            PG8_LDA(At, 0, 1); PG8_STAGE(PG8_SB(0, 0), b2, voffB, AUX_B); PG8_STAGE(PG8_SB(0, 1), b2 + hstepB, voffB, AUX_B); PG8_STAGE(PG8_SA(0, 0), a2, voffA, AUX_A);
            PG8_WAIT_V(24); PG8_WAIT_L(0); PG8_BAR; PG8_MMA(1, 0, At, B0); PG8_MMA(1, 1, At, B1); PG8_BAR; PG8_SCHED;
            PG8_LDB(B0, 1, 0); PG8_LDB(B1, 1, 1); PG8_SCHED; PG8_LDA(At, 1, 0); PG8_STAGE(PG8_SA(0, 1), a2 + hstepA, voffA, AUX_A);
            PG8_WAIT_V(24); PG8_WAIT_L(0); PG8_BAR; PG8_MMA(0, 0, At, B0); PG8_MMA(0, 1, At, B1); PG8_BAR; PG8_SCHED;
            PG8_LDA(At, 1, 1); PG8_STAGE(PG8_SB(1, 0), b3, voffB, AUX_B); PG8_STAGE(PG8_SB(1, 1), b3 + hstepB, voffB, AUX_B); PG8_STAGE(PG8_SA(1, 0), a3, voffA, AUX_A);
            PG8_WAIT_V(8); PG8_WAIT_L(0); PG8_BAR; PG8_MMA(1, 0, At, B0); PG8_MMA(1, 1, At, B1); PG8_BAR; PG8_SCHED;
            t_first = 2; } }
        for (int t = t_first; t < nt; t += 2) {
            const bool last = (t == nt - 2);
#ifdef KWRAP_PROBE
#define PG8_KT(x) ((x) & 7)
#else
#define PG8_KT(x) (x)
#endif
            const char* a1 = cA + (ptrdiff_t)PG8_KT(t + 1) * kstepA;
            const char* a2 = last ? nA : cA + (ptrdiff_t)PG8_KT(t + 2) * kstepA; const char* b2 = last ? nB : cB + (ptrdiff_t)PG8_KT(t + 2) * kstepB;
            const char* a3 = last ? a2 + kstepA : cA + (ptrdiff_t)PG8_KT(t + 3) * kstepA; const char* b3 = last ? b2 + kstepB : cB + (ptrdiff_t)PG8_KT(t + 3) * kstepB;
            if (last && has_next) S.a_ready(nxt);
            if constexpr (SP2) {
            PG8_LDB(B0, 0, 0); PG8_LDB(B1, 0, 1); PG8_SCHED; PG8_LDA(At, 0, 0); PG8_STAGE(PG8_SA(1, 1), a1 + hstepA, voffA, AUX_A);
            PG8_WAIT_V(8); PG8_WAIT_L(0); PG8_BAR; PG8_MMA(0, 0, At, B0); PG8_MMA(0, 1, At, B1); PG8_BAR; PG8_SCHED;
            PG8_LDA(At, 0, 1); PG8_STAGE(PG8_SB(0, 0), b2, voffB, AUX_B); PG8_STAGE(PG8_SB(0, 1), b2 + hstepB, voffB, AUX_B); PG8_STAGE(PG8_SA(0, 0), a2, voffA, AUX_A);
            PG8_WAIT_V(8); PG8_WAIT_L(0); PG8_BAR; PG8_MMA(1, 0, At, B0); PG8_MMA(1, 1, At, B1); PG8_BAR; PG8_SCHED;
            PG8_LDB(B0, 1, 0); PG8_LDB(B1, 1, 1); PG8_SCHED; PG8_LDA(At, 1, 0); PG8_STAGE(PG8_SA(0, 1), a2 + hstepA, voffA, AUX_A);
            PG8_WAIT_V(8); PG8_WAIT_L(0); PG8_BAR; PG8_MMA(0, 0, At, B0); PG8_MMA(0, 1, At, B1); PG8_BAR; PG8_SCHED;
            PG8_LDA(At, 1, 1); PG8_STAGE(PG8_SB(1, 0), b3, voffB, AUX_B); PG8_STAGE(PG8_SB(1, 1), b3 + hstepB, voffB, AUX_B); PG8_STAGE(PG8_SA(1, 0), a3, voffA, AUX_A);
            PG8_WAIT_V(8); PG8_WAIT_L(0); PG8_BAR; PG8_MMA(1, 0, At, B0); PG8_MMA(1, 1, At, B1); PG8_BAR; PG8_SCHED;
            } else {
            PG8_LDB(B0, 0, 0); PG8_SCHED; PG8_LDA(At, 0, 0); PG8_STAGE(PG8_SA(1, 1), a1 + hstepA, voffA, AUX_A);
            PG8_WAIT_L(8); PG8_BAR; PG8_WAIT_L(0); PG8_MMA(0, 0, At, B0); PG8_BAR; PG8_SCHED;
            PG8_LDB(B1, 0, 1); PG8_STAGE(PG8_SB(0, 0), b2, voffB, AUX_B);
            PG8_BAR; PG8_WAIT_L(0); PG8_MMA(0, 1, At, B1); PG8_BAR;
            PG8_LDA(At, 0, 1); PG8_STAGE(PG8_SA(0, 0), a2, voffA, AUX_A);
            PG8_BAR; PG8_WAIT_L(0); PG8_MMA(1, 0, At, B0); PG8_BAR; PG8_SCHED;
            PG8_STAGE(PG8_SB(0, 1), b2 + hstepB, voffB, AUX_B);
            PG8_WAIT_V(6); PG8_BAR; PG8_MMA(1, 1, At, B1); PG8_BAR;
            PG8_LDB(B0, 1, 0); PG8_SCHED; PG8_LDA(At, 1, 0); PG8_STAGE(PG8_SA(0, 1), a2 + hstepA, voffA, AUX_A);
            PG8_WAIT_L(8); PG8_BAR; PG8_WAIT_L(0); PG8_MMA(0, 0, At, B0); PG8_BAR; PG8_SCHED;
            PG8_LDB(B1, 1, 1); PG8_STAGE(PG8_SB(1, 0), b3, voffB, AUX_B);
            PG8_BAR; PG8_WAIT_L(0); PG8_MMA(0, 1, At, B1); PG8_BAR;
            PG8_LDA(At, 1, 1); PG8_STAGE(PG8_SA(1, 0), a3, voffA, AUX_A);
            PG8_BAR; PG8_WAIT_L(0); PG8_MMA(1, 0, At, B0); PG8_BAR; PG8_SCHED;
            PG8_STAGE(PG8_SB(1, 1), b3 + hstepB, voffB, AUX_B);
            PG8_WAIT_V(6); PG8_BAR; PG8_MMA(1, 1, At, B1); PG8_BAR;
            }
        }
        if constexpr (ALIGN_EPI) { if (wr == 0) PG8_BAR; }
        if constexpr (SP2 && EPI_OVERLAP) {
            static_assert(ALIGN_EPI, "EPI_OVERLAP needs the aligned epilogues");
            PG8_STAGE(PG8_SA(1, 1), nA + kstepA + hstepA, voffA, AUX_A); PG8_SCHED; asm volatile("" ::: "memory"); }
        bool part_store_ = false; if constexpr (Sched::SPLIT) part_store_ = (cur.mode == 1);
        if (part_store_) {
            if constexpr (Sched::SPLIT) {
            { f32x4* pp_ = (f32x4*)S.part + tid;
_Pragma("unroll") for (int q = 0; q < 32; ++q) { *pp_ = acc[q >> 4][(q >> 3) & 1][(q >> 1) & 3][q & 1]; pp_ += 512; asm volatile("" : "+v"(pp_)); } } }
        } else
        if constexpr (Sched::DUAL) { if (cur.mode == 0) E.mid(acc, cur, wr, wc, fr, fq); else E(acc, cur, wr, wc, fr, fq); }
        else if constexpr (!Epi::AFTER_DRAIN) { E(acc, cur, wr, wc, fr, fq);
#ifdef EPI_TWICE
            if constexpr (Epi::IDEM) { asm volatile("" ::: "memory"); E(acc, cur, wr, wc, fr, fq); }
#endif
            S.done(cur); }
        if (!has_next) break;
        bool part_load_ = false; if constexpr (Sched::SPLIT) part_load_ = (nxt.mode == 2);
        if (part_load_) { if constexpr (Sched::SPLIT) {
            { const f32x4* pp_ = (const f32x4*)S.part + tid;
_Pragma("unroll") for (int q = 0; q < 32; ++q) { acc[q >> 4][(q >> 3) & 1][(q >> 1) & 3][q & 1] = *pp_; pp_ += 512; asm volatile("" : "+v"(pp_)); } } }
#pragma unroll
            for (int q = 0; q < 32; ++q) asm volatile("" : "+v"(acc[q >> 4][(q >> 3) & 1][(q >> 1) & 3][q & 1]));
        } else if (!(Sched::DUAL && cur.mode == 0)) {
#pragma unroll
        for (int a = 0; a < 2; ++a)
#pragma unroll
            for (int b = 0; b < 2; ++b)
#pragma unroll
                for (int m = 0; m < 4; ++m)
#pragma unroll
                    for (int n = 0; n < 2; ++n) acc[a][b][m][n] = (f32x4){0.f, 0.f, 0.f, 0.f};
        }
        cur = nxt; cA = nA; cB = nB; ++ui; if constexpr (Sched::SPLIT) nt = cur.nt;
        if constexpr (ALIGN_EPI) { if (wr == 1) PG8_BAR; }
    }
    PG8_WAIT_V(0);
    if constexpr (!ALIGN_EPI) { if (wr == 0) PG8_BAR; }
    PG8_BAR;
    if constexpr (Epi::AFTER_DRAIN) { E.fused(acc, cur, wr, wc, fr, fq, lds, wid, lane); S.done(cur); }
#undef PG8_SA
#undef PG8_SB
#undef PG8_STAGE
#undef PG8_LDA
#undef PG8_LDB
#undef PG8_MMA
#undef PG8_WAIT_V
#undef PG8_WAIT_L
#undef PG8_BAR
#undef PG8_SCHED
}
}
#define GAS __attribute__((address_space(1)))
#define LAS __attribute__((address_space(3)))
typedef unsigned short bf16;
typedef unsigned v4u __attribute__((ext_vector_type(4)));
typedef float f32x4 __attribute__((ext_vector_type(4)));
typedef short bf16x8 __attribute__((ext_vector_type(8)));
typedef GAS unsigned gu32;
typedef GAS unsigned long long gu64;
#define RLX_AGENT __ATOMIC_RELAXED, __HIP_MEMORY_SCOPE_AGENT
#define LDS_WAIT() asm volatile("s_waitcnt lgkmcnt(0)" ::: "memory")
#define VM_WAIT() asm volatile("s_waitcnt vmcnt(0)" ::: "memory")
__device__ __forceinline__ unsigned long long rt() { return __builtin_amdgcn_s_memrealtime(); }
__device__ __forceinline__ unsigned f2bf(float f) { unsigned u = __builtin_bit_cast(unsigned, f); return (u + 0x7fffu + ((u >> 16) & 1u)) >> 16; }
__device__ __forceinline__ unsigned pk2(float lo, float hi) { return f2bf(lo) | (f2bf(hi) << 16); }
#define XB_TMO      128
#define XB_XCNT(j)  (256  + 64 * (j))
#define XB_XSUB(j)  (1280 + 64 * (j))
#define XB_XGEN(j)  (2304 + 64 * (j))
#define XB_TOP      3328
#define XB_TOPGEN   3392
#define XCD_BAR_WORDS 3456
#define XB_SPIN_CAP (1u << 18)

__device__ __forceinline__ unsigned xb_ld(unsigned* p)              { return __hip_atomic_load(p, __ATOMIC_RELAXED, __HIP_MEMORY_SCOPE_AGENT); }
__device__ __forceinline__ unsigned xb_add(unsigned* p, unsigned v) { return __hip_atomic_fetch_add(p, v, __ATOMIC_RELAXED, __HIP_MEMORY_SCOPE_AGENT); }
__device__ __forceinline__ unsigned xb_xcc_id() { return (unsigned)__builtin_amdgcn_s_getreg((3 << 11) | 20) & 0xFu; }
#define XB_SPIN(cond, bar) do { unsigned _sp = 0; while (cond) { __builtin_amdgcn_s_sleep(1); \
    if ((++_sp & 255u) == 0u) { if (xb_ld(&(bar)[XB_TMO])) break; if (_sp > XB_SPIN_CAP) { atomicAdd(&(bar)[XB_TMO], 1u); break; } } } } while (0)

struct XcdBarrier {
    unsigned* bar; unsigned x;
    volatile LAS unsigned* st;
};

__device__ __forceinline__ XcdBarrier xcd_barrier_post(unsigned* bar, volatile LAS unsigned* st) {
    XcdBarrier b; b.bar = bar; b.x = xb_xcc_id(); b.st = st;
    if (threadIdx.x == 0) (void)xb_add(&bar[XB_XCNT(b.x)], 1u);
    return b;
}
__device__ __forceinline__ void xcd_barrier_complete(unsigned* bar, unsigned x, unsigned& nloc, unsigned& nx) {
    const unsigned G = gridDim.x * gridDim.y * gridDim.z;
    unsigned sum, cnt, mine, sp = 0u;
    for (;;) {
        sum = 0u; cnt = 0u; mine = 0u;
#pragma unroll
        for (unsigned j = 0; j < 16; ++j) { const unsigned c = xb_ld(&bar[XB_XCNT(j)]); sum += c; cnt += (c > 0u) ? 1u : 0u; mine = (j == x) ? c : mine; }
        if (sum == G) break;
        __builtin_amdgcn_s_sleep(1);
        if ((++sp & 255u) == 0u) { if (xb_ld(&bar[XB_TMO])) break; if (sp > XB_SPIN_CAP) { atomicAdd(&bar[XB_TMO], 1u); break; } }
    }
    nloc = mine > 0u ? mine : 1u; nx = cnt > 0u ? cnt : 1u;
}

__device__ __forceinline__ void xcd_barrier(const XcdBarrier& b) {
    asm volatile("s_waitcnt vmcnt(0)" ::: "memory");
    __syncthreads();
    if (threadIdx.x == 0) {
        unsigned* bar = b.bar;
        __builtin_amdgcn_s_waitcnt(0);
        unsigned nloc = b.st[0], nx = b.st[1];
        if (nloc == 0u) { xcd_barrier_complete(bar, b.x, nloc, nx); b.st[0] = nloc; b.st[1] = nx; }
        const unsigned old = xb_add(&bar[XB_XSUB(b.x)], 1u);
        const unsigned gen = old / nloc;
        if (old + 1u == (gen + 1u) * nloc) {
            __builtin_amdgcn_fence(__ATOMIC_RELEASE, "agent");
            asm volatile("s_waitcnt vmcnt(0)" ::: "memory");
            const unsigned og = xb_add(&bar[XB_TOP], 1u);
            const unsigned tg = og / nx;
            if (og + 1u == (tg + 1u) * nx) xb_add(&bar[XB_TOPGEN], 1u);
            else XB_SPIN(xb_ld(&bar[XB_TOPGEN]) == tg, bar);
            __builtin_amdgcn_fence(__ATOMIC_ACQUIRE, "agent");
            xb_add(&bar[XB_XGEN(b.x)], 1u);
            asm volatile("s_waitcnt vmcnt(0)" ::: "memory");
        } else {
            XB_SPIN(xb_ld(&bar[XB_XGEN(b.x)]) == gen, bar);
            __builtin_amdgcn_fence(__ATOMIC_ACQUIRE, "agent");
            asm volatile("s_waitcnt vmcnt(0)" ::: "memory");
        }
    }
    __syncthreads();
}
constexpr int SEQ = 8192, DM = 4096, NIN = 18432, GW = 2048, SBW = 2048, NH = 16, HD = 128, DFF = 16384, NMODC = 6 * DM;
constexpr float EPS = 1e-6f;
constexpr float QSCALE = 0.12751743f;
constexpr int NWAVES = 8;
#ifndef MK_ONE_LAUNCH
#define MK_ONE_LAUNCH 1
#endif
#ifndef MK_CLK
#define MK_CLK 0
#endif
#ifndef MK_STAMP
#define MK_STAMP 0
#endif
#ifndef MK_DEBUG
#define MK_DEBUG 0
#endif
constexpr size_t MiB = 1u << 20;
constexpr size_t WS_CTL = 0, CTL_ZERO_BYTES = 64 * 1024;
constexpr size_t WS_MOD = 1 * MiB;
constexpr size_t WS_STAT = 1 * MiB + 128 * 1024;
constexpr size_t WS_WIN = 2 * MiB;
constexpr size_t WS_WPA = 146 * MiB, WS_WPB = 162 * MiB;
constexpr size_t WS_WO = 178 * MiB;
constexpr size_t WS_WF1 = 210 * MiB;
constexpr size_t WS_WF2 = 338 * MiB;
constexpr size_t WS_H = 466 * MiB;
constexpr size_t WS_GZ = 530 * MiB;
constexpr size_t WS_QKV = 594 * MiB;
constexpr size_t WS_SA = 690 * MiB, WS_SB = 754 * MiB;
constexpr size_t WS_GA = 818 * MiB, WS_AT = 850 * MiB;
constexpr size_t WS_MIXIN = 882 * MiB;
constexpr size_t WS_MIX = 946 * MiB;
constexpr size_t WS_ACT = 1010 * MiB;
constexpr size_t WS_FF = 1266 * MiB;
constexpr size_t WS_PART = 1330 * MiB;
constexpr size_t WS_SPLIT = 1332 * MiB;
constexpr size_t WS_END = 1396 * MiB;
constexpr int CW_TMO = 0, CW_CODE = 1, CW_BAR = 4096;
constexpr int RING_OFF = 0, RING_BYTES = 131072;
constexpr int LDSCTL_OFF = 139264, MISC_OFF = LDSCTL_OFF + 320;
constexpr int LDS_BYTES = 147456;
typedef unsigned u32x2 __attribute__((ext_vector_type(2)));
typedef unsigned u32x4v __attribute__((ext_vector_type(4)));
struct Frame {
    LAS unsigned char* lds;
    volatile LAS unsigned* MISC;
    gu32* ctl;
    int tid, lane, wave, vcu, G;
    const float *x, *c, *w_ada, *b_ada, *g_pre_mix, *w_in, *g_v, *w_s, *b_s, *w_pa, *w_pb, *w_o, *g_post_mix, *g_pre_mlp, *w_ff1, *w_ff2, *g_post_mlp;
    float* out; unsigned char* ws;
    __device__ __forceinline__ float* mod() const { return (float*)(ws + WS_MOD); }
    __device__ __forceinline__ float* stat() const { return (float*)(ws + WS_STAT); }
    __device__ __forceinline__ float* part() const { return (float*)(ws + WS_PART); }
    __device__ __forceinline__ bf16* Win_t() const { return (bf16*)(ws + WS_WIN); }
    __device__ __forceinline__ bf16* Wpa_t() const { return (bf16*)(ws + WS_WPA); }
    __device__ __forceinline__ bf16* Wpb_t() const { return (bf16*)(ws + WS_WPB); }
    __device__ __forceinline__ bf16* Wo_t() const { return (bf16*)(ws + WS_WO); }
    __device__ __forceinline__ bf16* Wf1_t() const { return (bf16*)(ws + WS_WF1); }
    __device__ __forceinline__ bf16* Wf2_t() const { return (bf16*)(ws + WS_WF2); }
    __device__ __forceinline__ bf16* H() const { return (bf16*)(ws + WS_H); }
    __device__ __forceinline__ bf16* GZ() const { return (bf16*)(ws + WS_GZ); }
    __device__ __forceinline__ bf16* QKV() const { return (bf16*)(ws + WS_QKV); }
    __device__ __forceinline__ bf16* SA() const { return (bf16*)(ws + WS_SA); }
    __device__ __forceinline__ bf16* SB() const { return (bf16*)(ws + WS_SB); }
    __device__ __forceinline__ bf16* GA() const { return (bf16*)(ws + WS_GA); }
    __device__ __forceinline__ bf16* AT() const { return (bf16*)(ws + WS_AT); }
    __device__ __forceinline__ bf16* MIXIN() const { return (bf16*)(ws + WS_MIXIN); }
    __device__ __forceinline__ bf16* MIX() const { return (bf16*)(ws + WS_MIX); }
    __device__ __forceinline__ bf16* ACT() const { return (bf16*)(ws + WS_ACT); }
    __device__ __forceinline__ bf16* FF() const { return (bf16*)(ws + WS_FF); }
};
__device__ __forceinline__ float wave_sum(float v) {
#pragma unroll
    for (int o = 1; o < 64; o <<= 1) v += __shfl_xor(v, o);
    return v;
}
__device__ __forceinline__ unsigned pkbf(float lo, float hi) { return pg8::cvt_pk_bf16(lo, hi); }
__device__ __forceinline__ float bflo(unsigned u) { return __builtin_bit_cast(float, u << 16); }
__device__ __forceinline__ float bfhi(unsigned u) { return __builtin_bit_cast(float, u & 0xffff0000u); }

#ifndef W_TILED
#define W_TILED 1
#endif
#ifndef OUT_TILED
#define OUT_TILED 2
#endif
#ifndef AB_TILED
#define AB_TILED 1
#endif
template <int LAY> __device__ __forceinline__ size_t a_off(int row, int col, int N) {
    if (LAY == 1) return ((((size_t)(row >> 8) * (N >> 6) + (col >> 6)) << 8) + (row & 255)) * 64 + (col & 63);
    if (LAY == 2) return ((((size_t)(row >> 8) * (N >> 5) + (col >> 5)) << 8) + (row & 255)) * 32 + (col & 31);
    return (size_t)row * N + col; }
template <int LAY> __device__ __forceinline__ constexpr size_t a_rowstep(int N) { return LAY == 1 ? (size_t)64 : LAY == 2 ? (size_t)32 : (size_t)N; }
template <int COL0, int NCOLS> __device__ __forceinline__ void p0_gemv(Frame& F) {
    constexpr int NB = 256, CPB = NCOLS / NB, Q = CPB / 4, KL = (NWAVES * 64) / Q;
    static_assert(NCOLS % (4 * NB) == 0 && (NWAVES * 64) % Q == 0 && (KL * CPB + DM) * 4 <= RING_BYTES, "gemv geometry");
    LAS float* sc = (LAS float*)(F.lds + RING_OFF);
    LAS float* red = (LAS float*)(F.lds + RING_OFF + 16384);
    for (int i = F.tid; i < DM; i += NWAVES * 64) { const float cv = F.c[i]; sc[i] = cv / (1.0f + __expf(-cv)); }
    __syncthreads();
    for (int cb = blockIdx.x; cb < NB; cb += F.G) {
        { const int kq = F.tid / Q, cq = F.tid % Q; const float* wp = F.w_ada + (size_t)COL0 + (size_t)CPB * cb + 4 * cq;
            f32x4 a = {0.f, 0.f, 0.f, 0.f};
#pragma unroll 8
            for (int k = kq; k < DM; k += KL) { const f32x4 w = __builtin_nontemporal_load((const f32x4*)(wp + (size_t)k * NMODC)); a = a + w * sc[k]; }
            *(LAS f32x4*)(red + kq * CPB + 4 * cq) = a; }
        __syncthreads();
        if (F.tid < CPB) { float s = 0.f;
#pragma unroll 8
            for (int q = 0; q < KL; ++q) s += red[q * CPB + F.tid];
            F.mod()[COL0 + CPB * cb + F.tid] = s + F.b_ada[COL0 + CPB * cb + F.tid]; }
        __syncthreads();
    }
}
__device__ __forceinline__ void p0_tile_load(f32x4 (&v)[16], const float* W, int N, int item, int lane) {
    const int nblk = N / 64, kb = item / nblk, nb = item % nblk; const float* src = W + (size_t)(64 * kb + (lane >> 4)) * N + 64 * nb + 4 * (lane & 15);
#pragma unroll
    for (int i = 0; i < 16; ++i) v[i] = __builtin_nontemporal_load((const f32x4*)(src + (size_t)(4 * i) * N));
}
__device__ __forceinline__ void p0_tile_store(const f32x4 (&v)[16], int K, int N, bf16* WT, LAS float* scr, int item, int lane) {
    const int nblk = N / 64, kb = item / nblk, nb = item % nblk, k0 = 64 * kb, n0 = 64 * nb;
    const int n4 = lane & 15, kr = lane >> 4;
#pragma unroll
    for (int i = 0; i < 16; ++i) { const int k = 4 * i + kr; *(LAS f32x4*)(scr + k * 64 + ((4 * n4 + 8 * (k >> 3)) & 63)) = v[i]; }
    asm volatile("s_waitcnt lgkmcnt(0)" ::: "memory");
    const int c = lane >> 3, nn = lane & 7;
#pragma unroll
    for (int it = 0; it < 8; ++it) { const int n = it * 8 + nn; const LAS float* s = scr + (8 * c) * 64 + ((n + 8 * c) & 63);
        v4u o; o.x = pkbf(s[0], s[64]); o.y = pkbf(s[128], s[192]); o.z = pkbf(s[256], s[320]); o.w = pkbf(s[384], s[448]);
        *(GAS v4u*)(WT + a_off<W_TILED>(n0 + n, k0 + 8 * c, K)) = o; }
    asm volatile("s_waitcnt lgkmcnt(0)" ::: "memory");
}
__device__ __forceinline__ void p0_convert(const float* W, int K, int N, bf16* WT, LAS float* scr, int first, int stride, int lane) {
    const int nitems = (K / 64) * (N / 64);
    if (first >= nitems) return;
    f32x4 va[16], vb[16];
    p0_tile_load(va, W, N, first, lane);
    for (int it = first;;) {
        const bool n1 = it + stride < nitems; if (n1) p0_tile_load(vb, W, N, it + stride, lane);
        p0_tile_store(va, K, N, WT, scr, it, lane);
        if (!n1) break; it += stride;
        const bool n2 = it + stride < nitems; if (n2) p0_tile_load(va, W, N, it + stride, lane);
        p0_tile_store(vb, K, N, WT, scr, it, lane);
        if (!n2) break; it += stride;
    }
}
template <int WHICH> __device__ __forceinline__ void p0_weights(Frame& F) {
    LAS float* scr = (LAS float*)(F.lds + RING_OFF + F.wave * 16384);
    const int gw = F.vcu * NWAVES + F.wave, NGW = F.G * NWAVES;
    if (WHICH & 1) p0_convert(F.w_in, DM, NIN, F.Win_t(), scr, gw, NGW, F.lane);
    if (WHICH & 2) p0_convert(F.w_pa, GW, DM, F.Wpa_t(), scr, gw, NGW, F.lane);
    if (WHICH & 4) p0_convert(F.w_pb, SBW, DM, F.Wpb_t(), scr, gw, NGW, F.lane);
    if (WHICH & 8) p0_convert(F.w_o, DM, DM, F.Wo_t(), scr, gw, NGW, F.lane);
    if (WHICH & 16) p0_convert(F.w_ff1, DM, DFF, F.Wf1_t(), scr, gw, NGW, F.lane);
    if (WHICH & 32) p0_convert(F.w_ff2, DFF, DM, F.Wf2_t(), scr, gw, NGW, F.lane);
}
#ifndef H_TILED
#define H_TILED 1
#endif
#if H_TILED == 2
constexpr int H_JSTEP = 4 * 256 * 64 * 2 / 8;
__device__ __forceinline__ GAS unsigned long long* h_row_ptr(bf16* H, int row, int lane) {
    return (GAS unsigned long long*)(H + (((size_t)(row >> 8) * 128 + (lane >> 3)) * 256 + (row & 255)) * 32) + (lane & 7); }
#elif H_TILED == 1
constexpr int H_JSTEP = 4 * 256 * 64 * 2 / 8;
__device__ __forceinline__ GAS unsigned long long* h_row_ptr(bf16* H, int row, int lane) {
    return (GAS unsigned long long*)(H + (((size_t)(row >> 8) * 64 + (lane >> 4)) * 256 + (row & 255)) * 64) + (lane & 15); }
#else
constexpr int H_JSTEP = 64;
__device__ __forceinline__ GAS unsigned long long* h_row_ptr(bf16* H, int row, int lane) { return (GAS unsigned long long*)(H + (size_t)row * DM) + lane; }
#endif
#if OUT_TILED == 2
constexpr int O_JSTEP = 4 * 256 * 64 * 2 / 8;
__device__ __forceinline__ const GAS u32x2* o_row_ptr(const bf16* O, int row, int lane) {
    return (const GAS u32x2*)(O + (((size_t)(row >> 8) * 128 + (lane >> 3)) * 256 + (row & 255)) * 32) + (lane & 7); }
#elif OUT_TILED == 1
constexpr int O_JSTEP = 4 * 256 * 64 * 2 / 8;
__device__ __forceinline__ const GAS u32x2* o_row_ptr(const bf16* O, int row, int lane) {
    return (const GAS u32x2*)(O + (((size_t)(row >> 8) * 64 + (lane >> 4)) * 256 + (row & 255)) * 64) + (lane & 15); }
#else
constexpr int O_JSTEP = 64;
__device__ __forceinline__ const GAS u32x2* o_row_ptr(const bf16* O, int row, int lane) { return (const GAS u32x2*)(O + (size_t)row * DM) + lane; }
#endif
#ifndef X1_NT
#define X1_NT 0
#endif
#ifndef X1_RECOMP
#define X1_RECOMP 0
#endif
#ifndef T_STAGGER
#define T_STAGGER 40
#endif
__device__ __forceinline__ void t0_rows(Frame& F) {
    LAS float* Av = (LAS float*)(F.lds + RING_OFF); LAS float* Bv = Av + DM;
    for (int i = F.tid; i < DM; i += NWAVES * 64) { Av[i] = F.g_pre_mix[i] * (1.0f + F.mod()[DM + i]); Bv[i] = F.mod()[i]; }
    __syncthreads();
    const int gw = F.vcu * NWAVES + F.wave, NGW = F.G * NWAVES;
    if (T_STAGGER && F.wave >= 4) __builtin_amdgcn_s_sleep(T_STAGGER);
    for (int row = gw; row < SEQ; row += NGW) {
        const GAS f32x4* xr = (const GAS f32x4*)(F.x + (size_t)row * DM) + F.lane;
        f32x4 v[16]; float s = 0.f;
#pragma unroll
        for (int j = 0; j < 16; ++j) { v[j] = xr[64 * j]; s += (v[j].x * v[j].x + v[j].y * v[j].y) + (v[j].z * v[j].z + v[j].w * v[j].w); }
        const float inv = 1.0f / sqrtf(wave_sum(s) * (1.0f / DM) + EPS);
        GAS unsigned long long* o8 = h_row_ptr(F.H(), row, F.lane);
#pragma unroll
        for (int j = 0; j < 16; ++j) { const f32x4 a = *(LAS f32x4*)(Av + 4 * (F.lane + 64 * j)), b = *(LAS f32x4*)(Bv + 4 * (F.lane + 64 * j));
            const f32x4 h = v[j] * inv * a + b;
            o8[H_JSTEP * j] = (unsigned long long)pkbf(h.x, h.y) | ((unsigned long long)pkbf(h.z, h.w) << 32); if ((j & 3) == 3) asm volatile("" ::: "memory"); }
    }
}
__device__ __forceinline__ void t1_rows(Frame& F) {
    LAS float* G1 = (LAS float*)(F.lds + RING_OFF); LAS float* A2 = G1 + DM; LAS float* B2 = A2 + DM;
    for (int i = F.tid; i < DM; i += NWAVES * 64) { G1[i] = F.mod()[2 * DM + i] * F.g_post_mix[i]; A2[i] = F.g_pre_mlp[i] * (1.0f + F.mod()[4 * DM + i]); B2[i] = F.mod()[3 * DM + i]; }
    __syncthreads();
    const int gw = F.vcu * NWAVES + F.wave, NGW = F.G * NWAVES;
    if (T_STAGGER && F.wave >= 4) __builtin_amdgcn_s_sleep(T_STAGGER);
#define T_STEP(ptr, n) do { (ptr) += (n); asm volatile("" : "+v"(ptr)); } while (0)
    for (int row = gw; row < SEQ; row += NGW) {
        const GAS u32x2* mr = o_row_ptr(F.MIX(), row, F.lane);
        const GAS f32x4* xr = (const GAS f32x4*)(F.x + (size_t)row * DM) + F.lane;
        u32x2 mu[16]; f32x4 v[16];
#pragma unroll
        for (int j = 0; j < 16; ++j) { mu[j] = *mr; T_STEP(mr, O_JSTEP); }
#pragma unroll
        for (int j = 0; j < 16; ++j) { v[j] = *xr; T_STEP(xr, 64); }
        float s = 0.f;
#pragma unroll
        for (int j = 0; j < 16; ++j) { const float a = bflo(mu[j].x), b = bfhi(mu[j].x), c = bflo(mu[j].y), d = bfhi(mu[j].y); s += (a * a + b * b) + (c * c + d * d); }
        const float inv1 = 1.0f / sqrtf(wave_sum(s) * (1.0f / DM) + EPS);
        GAS f32x4* orow = (GAS f32x4*)(F.out + (size_t)row * DM) + F.lane;
        float s2 = 0.f;
#pragma unroll
        for (int j = 0; j < 16; ++j) { const f32x4 g = *(LAS f32x4*)(G1 + 4 * (F.lane + 64 * j)); const f32x4 m = (f32x4){bflo(mu[j].x), bfhi(mu[j].x), bflo(mu[j].y), bfhi(mu[j].y)};
            v[j] = v[j] + g * (m * inv1); if (!X1_RECOMP) { *orow = v[j]; T_STEP(orow, 64); } s2 += (v[j].x * v[j].x + v[j].y * v[j].y) + (v[j].z * v[j].z + v[j].w * v[j].w); if ((j & 3) == 3) asm volatile("" ::: "memory"); }
        const float inv2 = 1.0f / sqrtf(wave_sum(s2) * (1.0f / DM) + EPS);
        GAS unsigned long long* o8 = h_row_ptr(F.H(), row, F.lane);
#pragma unroll
        for (int j = 0; j < 16; ++j) { const f32x4 a = *(LAS f32x4*)(A2 + 4 * (F.lane + 64 * j)), b = *(LAS f32x4*)(B2 + 4 * (F.lane + 64 * j));
            const f32x4 h = v[j] * inv2 * a + b;
            *o8 = (unsigned long long)pkbf(h.x, h.y) | ((unsigned long long)pkbf(h.z, h.w) << 32); T_STEP(o8, H_JSTEP); if ((j & 3) == 3) asm volatile("" ::: "memory"); }
    }
}
#if X1_RECOMP
__device__ __forceinline__ void t2_rows(Frame& F) {
    LAS float* G2 = (LAS float*)(F.lds + RING_OFF); LAS float* G1 = G2 + DM;
    for (int i = F.tid; i < DM; i += NWAVES * 64) { G2[i] = F.mod()[5 * DM + i] * F.g_post_mlp[i]; G1[i] = F.mod()[2 * DM + i] * F.g_post_mix[i]; }
    __syncthreads();
    const int gw = F.vcu * NWAVES + F.wave, NGW = F.G * NWAVES;
    if (T_STAGGER && F.wave >= 4) __builtin_amdgcn_s_sleep(T_STAGGER);
    for (int row = gw; row < SEQ; row += NGW) {
        const GAS u32x2* fr_ = o_row_ptr(F.FF(), row, F.lane); const GAS u32x2* mr = o_row_ptr(F.MIX(), row, F.lane);
        const GAS f32x4* xr = (const GAS f32x4*)(F.x + (size_t)row * DM) + F.lane;
        GAS f32x4* orow = (GAS f32x4*)(F.out + (size_t)row * DM) + F.lane;
        u32x2 fu[16], mu[16];
#pragma unroll
        for (int j = 0; j < 16; ++j) { mu[j] = *mr; T_STEP(mr, O_JSTEP); }
#pragma unroll
        for (int j = 0; j < 16; ++j) { fu[j] = *fr_; T_STEP(fr_, O_JSTEP); }
        float s1 = 0.f, s3 = 0.f;
#pragma unroll
        for (int j = 0; j < 16; ++j) { const float a = bflo(mu[j].x), b = bfhi(mu[j].x), c = bflo(mu[j].y), d = bfhi(mu[j].y); s1 += (a * a + b * b) + (c * c + d * d); }
#pragma unroll
        for (int j = 0; j < 16; ++j) { const float a = bflo(fu[j].x), b = bfhi(fu[j].x), c = bflo(fu[j].y), d = bfhi(fu[j].y); s3 += (a * a + b * b) + (c * c + d * d); }
        const float inv1 = 1.0f / sqrtf(wave_sum(s1) * (1.0f / DM) + EPS), inv3 = 1.0f / sqrtf(wave_sum(s3) * (1.0f / DM) + EPS);
#define T2_CHUNK(c) do { f32x4 xc[4]; _Pragma("unroll") for (int j = 0; j < 4; ++j) { xc[j] = *xr; T_STEP(xr, 64); } \
            _Pragma("unroll") for (int j = 0; j < 4; ++j) { const int jj = 4 * (c) + j; \
                const f32x4 g1 = *(LAS f32x4*)(G1 + 4 * (F.lane + 64 * jj)), g2 = *(LAS f32x4*)(G2 + 4 * (F.lane + 64 * jj)); \
                const f32x4 m = (f32x4){bflo(mu[jj].x), bfhi(mu[jj].x), bflo(mu[jj].y), bfhi(mu[jj].y)}, f = (f32x4){bflo(fu[jj].x), bfhi(fu[jj].x), bflo(fu[jj].y), bfhi(fu[jj].y)}; \
                const f32x4 x1 = xc[j] + g1 * (m * inv1); *orow = x1 + g2 * (f * inv3); T_STEP(orow, 64); } \
            asm volatile("" ::: "memory"); } while (0)
        asm volatile("" ::: "memory");
        T2_CHUNK(0); T2_CHUNK(1); T2_CHUNK(2); T2_CHUNK(3);
#undef T2_CHUNK
    }
}
#else
__device__ __forceinline__ void t2_rows(Frame& F) {
    LAS float* G2 = (LAS float*)(F.lds + RING_OFF);
    for (int i = F.tid; i < DM; i += NWAVES * 64) G2[i] = F.mod()[5 * DM + i] * F.g_post_mlp[i];
    __syncthreads();
    const int gw = F.vcu * NWAVES + F.wave, NGW = F.G * NWAVES;
    if (T_STAGGER && F.wave >= 4) __builtin_amdgcn_s_sleep(T_STAGGER);
    for (int row = gw; row < SEQ; row += NGW) {
        const GAS u32x2* fr_ = o_row_ptr(F.FF(), row, F.lane);
        GAS f32x4* orow = (GAS f32x4*)(F.out + (size_t)row * DM) + F.lane;
        u32x2 fu[16]; f32x4 v[16];
#pragma unroll
        for (int j = 0; j < 16; ++j) fu[j] = fr_[O_JSTEP * j];
#pragma unroll
        for (int j = 0; j < 16; ++j) v[j] = orow[64 * j];
        float s = 0.f;
#pragma unroll
        for (int j = 0; j < 16; ++j) { const float a = bflo(fu[j].x), b = bfhi(fu[j].x), c = bflo(fu[j].y), d = bfhi(fu[j].y); s += (a * a + b * b) + (c * c + d * d); }
        const float inv = 1.0f / sqrtf(wave_sum(s) * (1.0f / DM) + EPS);
#pragma unroll
        for (int j = 0; j < 16; ++j) { const f32x4 g = *(LAS f32x4*)(G2 + 4 * (F.lane + 64 * j)); const f32x4 m = (f32x4){bflo(fu[j].x), bfhi(fu[j].x), bflo(fu[j].y), bfhi(fu[j].y)};
            orow[64 * j] = v[j] + g * (m * inv); if ((j & 3) == 3) asm volatile("" ::: "memory"); }
    }
}
#endif
__device__ __forceinline__ void gmlp_stats_naive(Frame& F) {
    const int gw = F.vcu * NWAVES + F.wave, NGW = F.G * NWAVES;
    if (T_STAGGER && F.wave >= 4) __builtin_amdgcn_s_sleep(T_STAGGER);
    for (int row = gw; row < SEQ; row += NGW) {
        const GAS u32x2* vr = (const GAS u32x2*)(F.GZ() + (size_t)row * DM + GW) + F.lane;
        f32x4 v[8]; float s = 0.f;
#pragma unroll
        for (int j = 0; j < 8; ++j) { const u32x2 u = vr[64 * j]; v[j] = (f32x4){bflo(u.x), bfhi(u.x), bflo(u.y), bfhi(u.y)}; s += (v[j].x + v[j].y) + (v[j].z + v[j].w); }
        const float mean = wave_sum(s) * (1.0f / GW); float s2 = 0.f;
#pragma unroll
        for (int j = 0; j < 8; ++j) { const f32x4 d = v[j] - mean; s2 += (d.x * d.x + d.y * d.y) + (d.z * d.z + d.w * d.w); }
        const float rstd = 1.0f / sqrtf(wave_sum(s2) * (1.0f / GW) + EPS);
        if (F.lane == 0) { F.stat()[2 * row] = mean; F.stat()[2 * row + 1] = rstd; }
    }
}
__device__ __forceinline__ void gmlp_main_naive(Frame& F) {
    const size_t total = (size_t)SEQ * GW, stride = (size_t)F.G * NWAVES * 64;
    for (size_t idx = (size_t)blockIdx.x * NWAVES * 64 + F.tid; idx < total; idx += stride) {
        const int row = (int)(idx / GW), c = (int)(idx % GW), n = row >> 7, t = row & 127, g = c >> 7;
        const int smax = t < 64 ? 64 : 128;
        const float* wr_ = F.w_s + ((size_t)g * 128 + t) * 128;
        const float gv = F.g_v[c]; float y = 0.f;
        for (int s = 0; s < smax; ++s) { const int r = n * 128 + s; const unsigned short hv = F.GZ()[(size_t)r * DM + GW + c];
            const float vn = (__builtin_bit_cast(float, (unsigned)hv << 16) - __hip_atomic_load(F.stat() + 2 * r, __ATOMIC_RELAXED, __HIP_MEMORY_SCOPE_AGENT)) * __hip_atomic_load(F.stat() + 2 * r + 1, __ATOMIC_RELAXED, __HIP_MEMORY_SCOPE_AGENT) * gv; y += wr_[s] * vn; }
        y += F.b_s[g * 128 + t];
        const float u = __builtin_bit_cast(float, (unsigned)F.GZ()[(size_t)row * DM + c] << 16);
        const unsigned pk = pkbf(u * y, 0.f);
        F.GA()[(size_t)row * GW + c] = (bf16)(pk & 0xffffu);
    }
}
__device__ __forceinline__ void attn_naive(Frame& F) {
    const int gw = F.vcu * NWAVES + F.wave, NGW = F.G * NWAVES;
    for (int item = gw; item < SEQ * NH; item += NGW) {
        const int t = item / NH, h = item % NH;
        const bf16* Q = F.QKV() + ((size_t)(0 * NH + h) * SEQ) * HD; const bf16* K = F.QKV() + ((size_t)(1 * NH + h) * SEQ) * HD; const bf16* V = F.QKV() + ((size_t)(2 * NH + h) * SEQ) * HD;
        const unsigned qq = *(const GAS unsigned*)(Q + (size_t)t * HD + 2 * F.lane);
        const float q0 = bflo(qq), q1 = bfhi(qq);
        float o0 = 0.f, o1 = 0.f, R = 1.0f;
        for (int s = t - 1; s >= 0; --s) {
            const unsigned kk = *(const GAS unsigned*)(K + (size_t)s * HD + 2 * F.lane), vv = *(const GAS unsigned*)(V + (size_t)s * HD + 2 * F.lane);
            const float z2 = wave_sum(q0 * bflo(kk) + q1 * bfhi(kk));
            const float e = __builtin_amdgcn_exp2f(fminf(z2, 120.f)), r = __builtin_amdgcn_rcpf(1.0f + e), a = e * r * R;
            R *= r; o0 += a * bflo(vv); o1 += a * bfhi(vv);
        }
        *(GAS unsigned*)(F.AT() + (size_t)t * SBW + h * HD + 2 * F.lane) = pkbf(o0, o1);
    }
}
namespace sba {
typedef short bf16x8 __attribute__((ext_vector_type(8)));
typedef short s16x4 __attribute__((ext_vector_type(4)));
typedef float f32x16 __attribute__((ext_vector_type(16)));
typedef unsigned u32x4 __attribute__((ext_vector_type(4)));
constexpr int D = 128, KVBLK = 64, QBLK = 32, QB = 256;
constexpr int SHM_V = KVBLK * D * 2, SHM_K = KVBLK * D * 2;
constexpr int LDS_FLAGS = 2 * SHM_V + 2 * SHM_K;
constexpr int LDS_NEED = LDS_FLAGS + 128;
#define KSWZ(row, colB) ((row) * 256 + ((colB) ^ (((row) & 7) << 4)))
#define SBAR() __builtin_amdgcn_sched_barrier(0)
__device__ __forceinline__ int v_st(int k, int c) { const int kk = (k & ~0xC) | ((k & 4) << 1) | ((k & 8) >> 1); return ((kk >> 3) * 4 + (c >> 5)) * 512 + ((kk & 7) * 32 + (c & 31)) * 2; }
__device__ __forceinline__ int v_rd_base(int lane) { return ((lane & 3) << 3) | (((lane >> 2) & 3) << 6) | (((lane >> 4) & 1) << 5) | (((lane >> 5) & 1) << 8); }
constexpr int v_rd_off(int d0, int ks, int half) { return d0 * 512 + ks * 4096 + half * 2048; }
__device__ __forceinline__ int crow(int r, int hi) { return (r & 3) + 8 * (r >> 2) + 4 * hi; }
__device__ __forceinline__ unsigned cvtpk(float lo, float hi) { return pg8::cvt_pk_bf16(lo, hi); }

template <int KB>
__device__ __forceinline__ void qkt(f32x16& p0, f32x16& p1, const LAS char* K_lds, int r32, int hi, const bf16x8* qr) {
    p0 = f32x16{}; p1 = f32x16{};
    const LAS char* kb[4];
#pragma unroll
    for (int dd = 0; dd < 4; ++dd) kb[dd] = K_lds + KB * SHM_K + KSWZ(r32, (dd * 16 + hi * 8) * 2);
#pragma unroll
    for (int d0 = 0; d0 < 8; ++d0) { const LAS char* a = kb[d0 & 3] + (d0 >> 2) * 128;
        bf16x8 b0 = *reinterpret_cast<const LAS bf16x8*>(a);
        bf16x8 b1 = *reinterpret_cast<const LAS bf16x8*>(a + 32 * 256);
        p0 = __builtin_amdgcn_mfma_f32_32x32x16_bf16(b0, qr[d0], p0, 0, 0, 0);
        p1 = __builtin_amdgcn_mfma_f32_32x32x16_bf16(b1, qr[d0], p1, 0, 0, 0); }
}
template <int VB>
__device__ __forceinline__ void pv_tile(f32x16* o, int vb0, bf16x8 pa0, bf16x8 pa1, bf16x8 pa2, bf16x8 pa3) {
#define TRRD(dst, off) asm volatile("ds_read_b64_tr_b16 %0, %1 offset:%2" : "=&v"(dst) : "v"(vb0), "i"(off) : "memory")
#define PV_D0(d0) do { s16x4 l0, l1, l2, l3, h0, h1, h2, h3; constexpr int b_ = VB * SHM_V + v_rd_off(d0, 0, 0); \
        TRRD(l0, b_); TRRD(h0, b_ + 2048); TRRD(l1, b_ + 4096); TRRD(h1, b_ + 6144); TRRD(l2, b_ + 8192); TRRD(h2, b_ + 10240); TRRD(l3, b_ + 12288); TRRD(h3, b_ + 14336); \
        asm volatile("s_waitcnt lgkmcnt(0)" ::: "memory"); SBAR(); \
        o[d0] = __builtin_amdgcn_mfma_f32_32x32x16_bf16(pa0, (bf16x8){l0[0], l0[1], l0[2], l0[3], h0[0], h0[1], h0[2], h0[3]}, o[d0], 0, 0, 0); \
        o[d0] = __builtin_amdgcn_mfma_f32_32x32x16_bf16(pa1, (bf16x8){l1[0], l1[1], l1[2], l1[3], h1[0], h1[1], h1[2], h1[3]}, o[d0], 0, 0, 0); \
        o[d0] = __builtin_amdgcn_mfma_f32_32x32x16_bf16(pa2, (bf16x8){l2[0], l2[1], l2[2], l2[3], h2[0], h2[1], h2[2], h2[3]}, o[d0], 0, 0, 0); \
        o[d0] = __builtin_amdgcn_mfma_f32_32x32x16_bf16(pa3, (bf16x8){l3[0], l3[1], l3[2], l3[3], h3[0], h3[1], h3[2], h3[3]}, o[d0], 0, 0, 0); } while (0)
    PV_D0(0); PV_D0(1); PV_D0(2); PV_D0(3);
#undef PV_D0
#undef TRRD
}
__device__ __forceinline__ void sb_half(f32x16& p, float& R, int hi, bf16x8& paA, bf16x8& paB) {
    f32x16 c;
#pragma unroll
    for (int r = 0; r < 16; ++r) { const float e = __builtin_amdgcn_exp2f(fminf(p[r], 120.f)); c[r] = __builtin_amdgcn_rcpf(1.0f + e); p[r] = e * c[r]; }
    float TE[4], TO[4];
#pragma unroll
    for (int i = 0; i < 4; ++i) { const float T = (c[4 * i] * c[4 * i + 1]) * (c[4 * i + 2] * c[4 * i + 3]);
        auto rr = __builtin_amdgcn_permlane32_swap(__float_as_uint(T), __float_as_uint(T), false, false); TE[i] = __uint_as_float(rr[0]); TO[i] = __uint_as_float(rr[1]); }
    float X[4]; float x = R;
#pragma unroll
    for (int i = 3; i >= 0; --i) { const float xo = x; x *= TO[i]; const float xe = x; x *= TE[i]; X[i] = hi ? xo : xe; }
    R = x;
#pragma unroll
    for (int i = 0; i < 4; ++i) { const float f3 = X[i], f2 = f3 * c[4 * i + 3], f1 = f2 * c[4 * i + 2], f0 = f1 * c[4 * i + 1];
        p[4 * i + 3] *= f3; p[4 * i + 2] *= f2; p[4 * i + 1] *= f1; p[4 * i] *= f0; }
#define PK4(P, B_, OUT) do { unsigned a0 = cvtpk(P[B_+0], P[B_+1]), a1 = cvtpk(P[B_+2], P[B_+3]); \
        unsigned b0 = cvtpk(P[B_+4], P[B_+5]), b1 = cvtpk(P[B_+6], P[B_+7]); \
        auto r0 = __builtin_amdgcn_permlane32_swap(a0, b0, false, false); auto r1 = __builtin_amdgcn_permlane32_swap(a1, b1, false, false); \
        u32x4 w = {r0[0], r1[0], r0[1], r1[1]}; OUT = __builtin_bit_cast(bf16x8, w); } while (0)
    PK4(p, 0, paA); PK4(p, 8, paB);
#undef PK4
}
__device__ __forceinline__ void mask_tile(f32x16& p0, f32x16& p1, int dq) {
    const float NEG = -__builtin_inff();
#pragma unroll
    for (int r = 0; r < 16; ++r) { const int c = (r & 3) + 8 * (r >> 2);
        if (dq - c <= 0) p0[r] = NEG;
        if (dq - c - 32 <= 0) p1[r] = NEG; }
}
template <bool SKIP>
__device__ __forceinline__ void attn_unit(const bf16* Qh, const bf16* Kh, const bf16* Vh, bf16* Oh, int ocol0, int opitch, int P0, LAS char* lds) {
    const int tid = threadIdx.x, wid = __builtin_amdgcn_readfirstlane(tid >> 6), lane = tid & 63, r32 = lane & 31, hi = lane >> 5;
    const int NT = P0 / KVBLK + 4;
    const int qlo = P0 + wid * QBLK, qm = qlo + r32 - 4 * hi;
    LAS char* V_lds = lds; LAS char* K_lds = lds + 2 * SHM_V;
    volatile LAS unsigned* flags = (volatile LAS unsigned*)(lds + LDS_FLAGS);
    const int sr = tid >> 4, sc = (tid & 15) * 8, vst0 = v_st(sr, sc), vst1 = v_st(32 + sr, sc), kws = KSWZ(sr, sc * 2);
    const int vb0 = (int)(uintptr_t)V_lds + v_rd_base(lane);
    bf16x8 qr[8];
#pragma unroll
    for (int d0 = 0; d0 < 8; ++d0) qr[d0] = *(const GAS bf16x8*)(Qh + (size_t)(qlo + r32) * D + d0 * 16 + hi * 8);
    f32x16 o[4] = {}; float R = 1.0f;
    bf16x8 st_v0, st_v1, st_k0, st_k1;
#define KBASE(t) ((NT - 1 - (t)) * KVBLK)
#define SLOAD(t) do { const size_t k0_ = (size_t)KBASE(t); st_v0 = *(const GAS bf16x8*)(Vh + (k0_ + sr) * D + sc); st_v1 = *(const GAS bf16x8*)(Vh + (k0_ + 32 + sr) * D + sc); \
                      st_k0 = *(const GAS bf16x8*)(Kh + (k0_ + sr) * D + sc); st_k1 = *(const GAS bf16x8*)(Kh + (k0_ + 32 + sr) * D + sc); } while (0)
#define SWRITE(bf) do { *(LAS bf16x8*)(V_lds + (bf) * SHM_V + vst0) = st_v0; *(LAS bf16x8*)(V_lds + (bf) * SHM_V + vst1) = st_v1; \
                        *(LAS bf16x8*)(K_lds + (bf) * SHM_K + kws) = st_k0; *(LAS bf16x8*)(K_lds + (bf) * SHM_K + kws + 32 * 256) = st_k1; } while (0)
#define TILE(t, BF) do { const int kb_ = KBASE(t); bool act_ = kb_ < qlo + QBLK - 1; if (SKIP) act_ = act_ && !__all(R == 0.0f); \
        if (act_) { f32x16 p0, p1; bf16x8 pa0, pa1, pa2, pa3; \
            qkt<BF>(p0, p1, K_lds, r32, hi, qr); \
            if (kb_ + KVBLK - 1 >= qlo) mask_tile(p0, p1, qm - kb_); \
            sb_half(p1, R, hi, pa2, pa3); sb_half(p0, R, hi, pa0, pa1); \
            pv_tile<BF>(o, vb0, pa0, pa1, pa2, pa3); } } while (0)
    SLOAD(0); asm volatile("s_waitcnt vmcnt(0)" ::: "memory"); SWRITE(0);
    if (SKIP) { if (tid < 16) flags[tid] = 0u; }
    __syncthreads();
    int t = 0;
    for (;;) {
        if (t + 1 < NT) SLOAD(t + 1);
        TILE(t, 0);
        if (SKIP) { if (lane == 0) flags[wid] = (__all(R == 0.0f) && KBASE(t) <= qlo) ? 1u : 0u; }
        if (t + 1 < NT) { asm volatile("s_waitcnt vmcnt(0)" ::: "memory"); SWRITE(1); }
        __syncthreads();
        ++t; if (t >= NT) break;
        if (SKIP) { unsigned all_ = 1u; for (int w = 0; w < 8; ++w) all_ &= flags[w]; if (all_) break; }
        if (t + 1 < NT) SLOAD(t + 1);
        TILE(t, 1);
        if (SKIP) { if (lane == 0) flags[8 + wid] = (__all(R == 0.0f) && KBASE(t) <= qlo) ? 1u : 0u; }
        if (t + 1 < NT) { asm volatile("s_waitcnt vmcnt(0)" ::: "memory"); SWRITE(0); }
        __syncthreads();
        ++t; if (t >= NT) break;
        if (SKIP) { unsigned all_ = 1u; for (int w = 0; w < 8; ++w) all_ &= flags[8 + w]; if (all_) break; }
    }
    bf16* odst = Oh + a_off<AB_TILED>(qlo + 4 * hi, ocol0 + r32, opitch);
#pragma unroll
    for (int r = 0; r < 16; ++r) { const int dt = (r & 3) + 8 * (r >> 2);
#pragma unroll
        for (int d0 = 0; d0 < 4; ++d0) { const float v = o[d0][r]; const float vn = __shfl_xor(v, 1);
            const size_t coff = AB_TILED == 2 ? (size_t)d0 * (256 * 32) : AB_TILED == 1 ? (size_t)(d0 >> 1) * (256 * 64) + (d0 & 1) * 32 : (size_t)d0 * 32;
            if ((r32 & 1) == 0) *(GAS unsigned*)(odst + (size_t)dt * a_rowstep<AB_TILED>(opitch) + coff) = cvtpk(v, vn); } }
    __syncthreads();
#undef KBASE
#undef SLOAD
#undef SWRITE
#undef TILE
}
#undef KSWZ
#undef SBAR
}
#ifndef ATT_SKIP
#define ATT_SKIP 1
#endif
__device__ __forceinline__ void attn_phase(Frame& F) {
    for (int p = F.vcu; p < NH * 16; p += F.G) {
        const int h = p >> 4, pi = p & 15;
        const bf16* Qh = F.QKV() + ((size_t)(0 * NH + h) * SEQ) * HD; const bf16* Kh = F.QKV() + ((size_t)(1 * NH + h) * SEQ) * HD; const bf16* Vh = F.QKV() + ((size_t)(2 * NH + h) * SEQ) * HD;
        sba::attn_unit<ATT_SKIP != 0>(Qh, Kh, Vh, F.AT(), h * HD, SBW, (31 - pi) * 256, (LAS char*)(F.lds + RING_OFF));
        sba::attn_unit<ATT_SKIP != 0>(Qh, Kh, Vh, F.AT(), h * HD, SBW, pi * 256, (LAS char*)(F.lds + RING_OFF));
    }
}
namespace gm {
typedef short bf16x8 __attribute__((ext_vector_type(8)));
typedef short s16x4 __attribute__((ext_vector_type(4)));
typedef float f32x16 __attribute__((ext_vector_type(16)));
constexpr int LDS_TILES = 0, LDS_STAT = 2 * sba::SHM_V;
__device__ __forceinline__ void gmlp_unit(Frame& F, int n, int q4, LAS char* lds) {
    const int tid = F.tid, wid = F.wave, lane = F.lane, r32 = lane & 31, hi = lane >> 5;
    const int row0 = n * 128;
    LAS float* st = (LAS float*)(lds + LDS_STAT);
    { const int row = tid >> 2, qtr = tid & 3; const GAS f32x4* pp = (const GAS f32x4*)(F.part() + ((size_t)(row0 + row) * 32 + qtr * 8) * 2);
      float s = 0.f, ss = 0.f;
#pragma unroll
      for (int j = 0; j < 4; ++j) { const f32x4 v = pp[j]; s += v.x + v.z; ss += v.y + v.w; }
      s += __shfl_xor(s, 1); ss += __shfl_xor(ss, 1); s += __shfl_xor(s, 2); ss += __shfl_xor(ss, 2);
      const float mean = s * (1.0f / GW), var = fmaxf(ss * (1.0f / GW) - mean * mean, 0.f);
      if (qtr == 0) { st[row] = mean; st[128 + row] = 1.0f / sqrtf(var + EPS); } }
    __syncthreads();
    const int tb = wid >> 1, nks = tb < 2 ? 4 : 8;
    const int vb = (int)(uintptr_t)(lds + LDS_TILES) + sba::v_rd_base(lane);
    const int cc = (tid & 15) * 8;
    const size_t zstep = (size_t)32 * a_rowstep<OUT_TILED>(DM);
    u32x4v raw[4];
    { const bf16* zsrc = F.GZ() + a_off<OUT_TILED>(row0 + (tid >> 4), GW + (4 * q4) * 128 + cc, DM);
#pragma unroll
      for (int it = 0; it < 4; ++it) raw[it] = *(const GAS u32x4v*)(zsrc + it * zstep); }
    for (int gi = 0; gi < 4; ++gi) { const int g = 4 * q4 + gi;
        const f32x4 g0 = *(const GAS f32x4*)(F.g_v + g * 128 + cc), g1 = *(const GAS f32x4*)(F.g_v + g * 128 + cc + 4);
        f32x4 wa[8], wb[8];
        { const float* wrow = F.w_s + ((size_t)g * 128 + 32 * tb + r32) * 128 + 8 * hi;
#pragma unroll
          for (int ks = 0; ks < 8; ++ks) { if (ks < nks) { wa[ks] = *(const GAS f32x4*)(wrow + 16 * ks); wb[ks] = *(const GAS f32x4*)(wrow + 16 * ks + 4); } else { wa[ks] = f32x4{}; wb[ks] = f32x4{}; } } }
        const int tbase = 32 * tb + 4 * hi;
        unsigned short uv[2][16]; float bs[16];
#pragma unroll
        for (int r = 0; r < 16; ++r) bs[r] = F.b_s[g * 128 + tbase + (r & 3) + 8 * (r >> 2)];
#pragma unroll
        for (int dd = 0; dd < 2; ++dd) { const bf16* usrc = F.GZ() + a_off<OUT_TILED>(row0 + tbase, g * 128 + (2 * (wid & 1) + dd) * 32 + r32, DM);
#pragma unroll
            for (int r = 0; r < 16; ++r) uv[dd][r] = usrc[(size_t)((r & 3) + 8 * (r >> 2)) * a_rowstep<OUT_TILED>(DM)]; }
#pragma unroll
        for (int it = 0; it < 4; ++it) { const int s = (it * 512 + tid) >> 4; const u32x4v rw = raw[it];
            const float mu = st[s], rs = st[128 + s];
            u32x4v w; w.x = pkbf((bflo(rw.x) - mu) * rs * g0.x, (bfhi(rw.x) - mu) * rs * g0.y); w.y = pkbf((bflo(rw.y) - mu) * rs * g0.z, (bfhi(rw.y) - mu) * rs * g0.w);
            w.z = pkbf((bflo(rw.z) - mu) * rs * g1.x, (bfhi(rw.z) - mu) * rs * g1.y); w.w = pkbf((bflo(rw.w) - mu) * rs * g1.z, (bfhi(rw.w) - mu) * rs * g1.w);
            *(LAS u32x4v*)(lds + LDS_TILES + (s >> 6) * sba::SHM_V + sba::v_st(s & 63, cc)) = w; }
        if (gi < 3) { const bf16* zsrc = F.GZ() + a_off<OUT_TILED>(row0 + (tid >> 4), GW + (g + 1) * 128 + cc, DM);
#pragma unroll
            for (int it = 0; it < 4; ++it) raw[it] = *(const GAS u32x4v*)(zsrc + it * zstep); }
        __syncthreads();
        bf16x8 afr[8];
#pragma unroll
        for (int ks = 0; ks < 8; ++ks) { u32x4v w = {pkbf(wa[ks].x, wa[ks].y), pkbf(wa[ks].z, wa[ks].w), pkbf(wb[ks].x, wb[ks].y), pkbf(wb[ks].z, wb[ks].w)}; afr[ks] = __builtin_bit_cast(bf16x8, w); }
#pragma unroll
        for (int dd = 0; dd < 2; ++dd) { const int d0 = 2 * (wid & 1) + dd; const int vbd = vb + d0 * 512;
            f32x16 acc = {};
#define GTR(dst, off) asm volatile("ds_read_b64_tr_b16 %0, %1 offset:%2" : "=&v"(dst) : "v"(vbd), "i"(off) : "memory")
#define GSTEP(ks) do { if ((ks) < nks) { s16x4 l, h; GTR(l, ((ks) >> 2) * sba::SHM_V + ((ks) & 3) * 4096); GTR(h, ((ks) >> 2) * sba::SHM_V + ((ks) & 3) * 4096 + 2048); \
                asm volatile("s_waitcnt lgkmcnt(0)" ::: "memory"); __builtin_amdgcn_sched_barrier(0); \
                acc = __builtin_amdgcn_mfma_f32_32x32x16_bf16(afr[ks], (bf16x8){l[0], l[1], l[2], l[3], h[0], h[1], h[2], h[3]}, acc, 0, 0, 0); } } while (0)
            GSTEP(0); GSTEP(1); GSTEP(2); GSTEP(3); GSTEP(4); GSTEP(5); GSTEP(6); GSTEP(7);
#undef GSTEP
#undef GTR
            bf16* odst = F.GA() + a_off<AB_TILED>(row0 + tbase, g * 128 + d0 * 32 + r32, GW);
#pragma unroll
            for (int r = 0; r < 16; ++r) { const int dt = (r & 3) + 8 * (r >> 2);
                const float y = acc[r] + bs[r];
                const float u = __builtin_bit_cast(float, (unsigned)uv[dd][r] << 16);
                const float v = u * y, vn = __shfl_xor(v, 1);
                if ((r32 & 1) == 0) *(GAS unsigned*)(odst + (size_t)dt * a_rowstep<AB_TILED>(GW)) = pkbf(v, vn); } }
        __syncthreads();
    }
}
__device__ __forceinline__ void gmlp_phase(Frame& F) {
    for (int u = F.vcu; u < (SEQ / 128) * 4; u += F.G) gmlp_unit(F, u >> 2, u & 3, (LAS char*)(F.lds + RING_OFF));
}
}
constexpr int N_PHASES = 11;
struct Args { const float* in[17]; float* out; unsigned char* ws; int ph_lo, ph_hi; };
__global__ void __launch_bounds__(NWAVES * 64, 2) fwd(Args args) {
    extern __shared__ __attribute__((aligned(16))) unsigned char lds[];
    Frame F;
    F.lds = (LAS unsigned char*)lds;
    F.MISC = (volatile LAS unsigned*)(F.lds + MISC_OFF);
    F.tid = threadIdx.x; F.lane = F.tid & 63; F.wave = __builtin_amdgcn_readfirstlane(F.tid >> 6);
    F.G = gridDim.x; { const int bx = blockIdx.x; F.vcu = (F.G % 8 == 0) ? (bx % 8) * (F.G / 8) + bx / 8 : bx; }
    unsigned char* ws = args.ws;
    F.ctl = (gu32*)(ws + WS_CTL);
    F.x = args.in[0]; F.c = args.in[1]; F.w_ada = args.in[2]; F.b_ada = args.in[3]; F.g_pre_mix = args.in[4]; F.w_in = args.in[5]; F.g_v = args.in[6]; F.w_s = args.in[7]; F.b_s = args.in[8];
    F.w_pa = args.in[9]; F.w_pb = args.in[10]; F.w_o = args.in[11]; F.g_post_mix = args.in[12]; F.g_pre_mlp = args.in[13]; F.w_ff1 = args.in[14]; F.w_ff2 = args.in[15]; F.g_post_mlp = args.in[16];
    F.out = args.out; F.ws = ws;
    for (int u = F.tid; u < (LDS_BYTES - LDSCTL_OFF) / 4; u += NWAVES * 64) ((LAS unsigned*)(F.lds + LDSCTL_OFF))[u] = 0u;
    __syncthreads();
    const int lo = args.ph_lo, hi = args.ph_hi;
    XcdBarrier bar; bar.bar = (unsigned*)(F.ctl + CW_BAR); bar.x = 0; bar.st = nullptr;
    if (hi - lo > 1) bar = xcd_barrier_post((unsigned*)(F.ctl + CW_BAR), F.MISC + 8);
#if OUT_TILED
#define EPI_T(a) pg8::EpiAct<a, OUT_TILED>
#define EPI_T0 , 0
#else
#define EPI_T(a) pg8::EpiAct<a, 0>
#define EPI_T0 , 0
#endif
#ifndef W_T1
#define W_T1 16
#endif
#ifndef W_T0
#define W_T0 1
#endif
#ifndef GEMV_LATE
#define GEMV_LATE 0
#endif
#ifndef W_FIRST
#define W_FIRST 0
#endif
#ifndef W_P4
#define W_P4 6
#endif
#ifndef W_P8
#define W_P8 32
#endif
#ifndef W_P5
#define W_P5 8
#endif
#ifndef W_P6
#define W_P6 0
#endif
#define W_P0 (63 & ~(W_T1) & ~(W_T0) & ~(W_P4) & ~(W_P8) & ~(W_P5) & ~(W_P6))
#ifndef FFN_MSPLIT
#define FFN_MSPLIT 0
#endif
#ifndef GATES_IN_P5
#define GATES_IN_P5 1
#endif
#ifndef GEMM_EPIOV
#define GEMM_EPIOV 0
#endif
#ifndef FF2_KREV
#define FF2_KREV 0
#endif
#ifndef GEMM_SPLIT
#define GEMM_SPLIT 0
#endif
#if GEMM_SPLIT
#define SPLIT_ORDER pg8::SplitOrder
#define SPLIT_INIT(S, M_, N_, G_, c_, ntk_) S.init(M_, N_, G_, c_, ntk_, (float*)(ws + WS_SPLIT) + (size_t)blockIdx.x * 65536)
#else
#define SPLIT_ORDER pg8::StaticOrder
#define SPLIT_INIT(S, M_, N_, G_, c_, ntk_) S.init(M_, N_, G_, c_)
#endif
#ifndef W_TILED
#define W_TILED 1
#endif
#ifndef MIXIN_TILED
#define MIXIN_TILED 2
#endif
#ifndef ACT_TILED
#define ACT_TILED 2
#endif
#ifndef GEMM_ALIGN
#define GEMM_ALIGN true
#endif
#ifndef GEMM_SP2
#define GEMM_SP2 true
#endif
#ifndef REP_G
#define REP_G 0
#endif
#if REP_G
#define GREP(i) , ((((REP_G) >> (i)) & 1) ? 2 : 1)
#else
#define GREP(i)
#endif
#ifndef REP_MASK
#define REP_MASK 0
#endif
#if REP_MASK
#define REPFOR(p) for (int rep_ = 0; rep_ < (((REP_MASK >> (p)) & 1) ? 2 : 1); ++rep_)
#else
#define REPFOR(p)
#endif
#ifndef PH_MASK
#define PH_MASK 0x7ff
#endif
#define IN(k) (((PH_MASK >> (k)) & 1) && lo <= (k) && (k) < hi)
#define BOTH(k) (IN(k) && IN((k) + 1))
#ifdef BAR_TWICE
#define GRID_BAR() do { xcd_barrier(bar); xcd_barrier(bar); } while (0)
#else
#define GRID_BAR() xcd_barrier(bar)
#endif
#ifndef P5_FUSED
#define P5_FUSED 1
#endif
#ifndef W_STAG
#define W_STAG 0
#endif
#ifndef TEAM_SEL
#define TEAM_SEL ((int)blockIdx.x >> 3)
#endif
#define TEAM_B(k) ((((W_STAG) >> (k)) & 1) && ((TEAM_SEL) & 1))
#ifndef SKEW_SHIFT
#define SKEW_SHIFT 1
#endif
#ifndef SKEW_TICKS
#define SKEW_TICKS 0
#endif
#define XCD_SKEW() do { if (SKEW_TICKS) { const unsigned long long t0_ = __builtin_amdgcn_s_memrealtime(), w_ = (unsigned long long)((blockIdx.x & 7) >> SKEW_SHIFT) * SKEW_TICKS; \
        while (__builtin_amdgcn_s_memrealtime() - t0_ < w_) __builtin_amdgcn_s_sleep(2); } } while (0)
#if MK_STAMP
    unsigned long long* const ts_ = (unsigned long long*)(ws + WS_END + 8192);
#define STAMP(k) do { if (blockIdx.x == 0 && F.tid == 0) ts_[k] = __builtin_amdgcn_s_memrealtime(); } while (0)
#else
#define STAMP(k) do { } while (0)
#endif
    STAMP(0);
    REPFOR(0)
    if (IN(0)) {
#if GEMV_LATE
        p0_gemv<0, 2 * DM>(F);
#else
        p0_gemv<0, 2 * DM>(F); p0_gemv<2 * DM, 4 * DM>(F);
#endif
#ifdef WCONV_REP
        p0_weights<W_P0>(F);
#endif
        p0_weights<W_P0>(F); if (BOTH(0)) GRID_BAR(); }
    STAMP(1);
    REPFOR(1)
    if (IN(1)) {
#ifdef T0_REP
        _Pragma("unroll 1") for (int rep1 = 0; rep1 < T0_REP; ++rep1) { t0_rows(F); __syncthreads(); }
#endif
        if (W_T0 && W_FIRST) { p0_weights<W_T0>(F); __syncthreads(); } t0_rows(F); if (GEMV_LATE) { __syncthreads(); p0_gemv<2 * DM, 4 * DM>(F); } if (W_T0 && !W_FIRST) { __syncthreads(); p0_weights<W_T0>(F); } if (BOTH(1)) GRID_BAR(); }
    STAMP(2);
    REPFOR(2)
    if (IN(2)) { XCD_SKEW();
#if !GATES_IN_P5
        { pg8::Gemm g{F.H(), F.Win_t() + (size_t)(2 * GW + 3 * SBW) * DM, SEQ, 2 * DM, DM}; SPLIT_ORDER S; SPLIT_INIT(S, SEQ, 2 * DM, F.G, (int)blockIdx.x, DM / 64);
          EPI_T(3) E{F.SA(), 2 * DM EPI_T0};
          pg8::gemm_phase<EPI_T(3), SPLIT_ORDER, GEMM_ALIGN, GEMM_SP2, H_TILED, W_TILED != 0, false, false>(F.lds + RING_OFF, g, S, E); }
#endif
        { pg8::Gemm g{F.H(), F.Win_t() + (size_t)(2 * GW) * DM, SEQ, 3 * SBW, DM}; SPLIT_ORDER S; SPLIT_INIT(S, SEQ, 3 * SBW, F.G, (int)blockIdx.x, DM / 64);
          pg8::EpiQKV E{F.QKV(), SEQ, QSCALE};
          pg8::gemm_phase<pg8::EpiQKV, SPLIT_ORDER, GEMM_ALIGN, GEMM_SP2, H_TILED, W_TILED != 0, false, false>(F.lds + RING_OFF, g, S, E); }
        { pg8::Gemm g{F.H(), F.Win_t(), SEQ, GW, DM}; pg8::StaticOrder S; S.init(SEQ, GW, F.G, (int)blockIdx.x GREP(0));
          EPI_T(2) E{F.GZ(), DM EPI_T0};
          pg8::gemm_phase<EPI_T(2), pg8::StaticOrder, GEMM_ALIGN, GEMM_SP2, H_TILED, W_TILED != 0, false, false>(F.lds + RING_OFF, g, S, E); }
        { pg8::Gemm g{F.H(), F.Win_t() + (size_t)GW * DM, SEQ, GW, DM}; pg8::StaticOrder S; S.init(SEQ, GW, F.G, (int)blockIdx.x GREP(1));
          pg8::EpiGeluStats<OUT_TILED> E{F.GZ(), DM, GW / 256, F.part()};
          pg8::gemm_phase<pg8::EpiGeluStats<OUT_TILED>, pg8::StaticOrder, GEMM_ALIGN, GEMM_SP2, H_TILED, W_TILED != 0, false, false>(F.lds + RING_OFF, g, S, E); }
        if (BOTH(2)) GRID_BAR();
    }
#ifndef GMLP_FAST
#define GMLP_FAST 1
#endif
    STAMP(3);
    REPFOR(3)
    if (IN(3)) { if (!GMLP_FAST) { gmlp_stats_naive(F); if (BOTH(3)) GRID_BAR(); } }
#ifndef ATT_FAST
#define ATT_FAST 1
#endif
    STAMP(4);
    REPFOR(4)
    if (IN(4)) {
#ifdef P4_REP
        _Pragma("unroll 1") for (int rep4 = 0; rep4 < P4_REP; ++rep4) { if (P4_REP_WHAT & 1) gm::gmlp_phase(F); if (P4_REP_WHAT & 2) attn_phase(F); __syncthreads(); }
#endif
        if (W_P4 && TEAM_B(4)) { p0_weights<W_P4>(F); __syncthreads(); }
        if (GMLP_FAST) gm::gmlp_phase(F); else gmlp_main_naive(F); if (ATT_FAST) attn_phase(F); else attn_naive(F); if (W_P4 && !TEAM_B(4)) { __syncthreads(); p0_weights<W_P4>(F); } if (BOTH(4)) GRID_BAR(); }
    STAMP(5);
    REPFOR(5)
    if (IN(5)) { XCD_SKEW();
        if (W_P5 && TEAM_B(5)) { p0_weights<W_P5>(F); __syncthreads(); }
#if GATES_IN_P5
        { pg8::Gemm g{F.H(), F.Win_t() + (size_t)(2 * GW + 3 * SBW) * DM, SEQ, 2 * DM, DM}; pg8::GateOrder S; S.init(SEQ, DM, F.G, (int)blockIdx.x);
          EPI_T(3) E{F.SA(), 2 * DM EPI_T0};
          pg8::gemm_phase<EPI_T(3), pg8::GateOrder, GEMM_ALIGN, GEMM_SP2, H_TILED, W_TILED != 0, false, false>(F.lds + RING_OFF, g, S, E); }
#endif
#if P5_FUSED
        { pg8::Gemm g{F.GA(), F.Wpa_t(), SEQ, DM, GW}; pg8::DualOrder S; S.init(SEQ, DM, F.G, (int)blockIdx.x);
          pg8::EpiGateDual<MIXIN_TILED, OUT_TILED> E{F.SA(), 2 * DM, 0, DM / 256, F.MIXIN(), DM};
          pg8::gemm_phase<pg8::EpiGateDual<MIXIN_TILED, OUT_TILED>, pg8::DualOrder, GEMM_ALIGN, GEMM_SP2, AB_TILED, W_TILED != 0, false, false>(F.lds + RING_OFF, g, S, E, F.AT(), F.Wpb_t()); }
#else
        { pg8::Gemm g{F.GA(), F.Wpa_t(), SEQ, DM, GW}; pg8::StaticOrder S; S.init(SEQ, DM, F.G, (int)blockIdx.x GREP(4));
          pg8::EpiGate<true, MIXIN_TILED, OUT_TILED> E{F.SA(), 2 * DM, 0, F.MIXIN(), DM};
          pg8::gemm_phase<pg8::EpiGate<true, MIXIN_TILED, OUT_TILED>, pg8::StaticOrder, GEMM_ALIGN, GEMM_SP2, AB_TILED, W_TILED != 0, false, false>(F.lds + RING_OFF, g, S, E); }
        { pg8::Gemm g{F.AT(), F.Wpb_t(), SEQ, DM, SBW}; pg8::StaticOrder S; S.init(SEQ, DM, F.G, (int)blockIdx.x GREP(5));
          pg8::EpiGate<false, MIXIN_TILED, OUT_TILED> E{F.SA(), 2 * DM, DM / 256, F.MIXIN(), DM};
          pg8::gemm_phase<pg8::EpiGate<false, MIXIN_TILED, OUT_TILED>, pg8::StaticOrder, GEMM_ALIGN, GEMM_SP2, AB_TILED, W_TILED != 0, false, false>(F.lds + RING_OFF, g, S, E); }
#endif
        if (W_P5 && !TEAM_B(5)) { p0_weights<W_P5>(F); }
        if (BOTH(5)) GRID_BAR();
    }
    STAMP(6);
    REPFOR(6)
    if (IN(6)) { XCD_SKEW();
        if (W_P6 && TEAM_B(6)) { p0_weights<W_P6>(F); __syncthreads(); }
        pg8::Gemm g{F.MIXIN(), F.Wo_t(), SEQ, DM, DM}; pg8::StaticOrder S; S.init(SEQ, DM, F.G, (int)blockIdx.x GREP(6));
        EPI_T(0) E{F.MIX(), DM EPI_T0};
        pg8::gemm_phase<EPI_T(0), pg8::StaticOrder, GEMM_ALIGN, GEMM_SP2, MIXIN_TILED, W_TILED != 0, false, false>(F.lds + RING_OFF, g, S, E);
        if (W_P6 && !TEAM_B(6)) { p0_weights<W_P6>(F); }
        if (BOTH(6)) GRID_BAR();
    }
    STAMP(7);
    REPFOR(7)
    if (IN(7)) {
#ifdef T1_REP
        _Pragma("unroll 1") for (int rep7 = 0; rep7 < T1_REP; ++rep7) { t1_rows(F); __syncthreads(); }
#endif
        if (W_T1 && W_FIRST) { p0_weights<W_T1>(F); __syncthreads(); } t1_rows(F); if (W_T1 && !W_FIRST) { __syncthreads(); p0_weights<W_T1>(F); } if (BOTH(7)) GRID_BAR(); }
    STAMP(8);
    REPFOR(8)
#if FFN_MSPLIT
    if (IN(8) && IN(9)) {
        _Pragma("unroll") for (int mh = 0; mh < 2; ++mh) { const size_t r0 = (size_t)mh * (SEQ / 2);
            { pg8::Gemm g{F.H() + r0 * DM, F.Wf1_t(), SEQ / 2, DFF, DM}; pg8::StaticOrder S; S.init(SEQ / 2, DFF, F.G, (int)blockIdx.x);
              pg8::EpiActTiled<1> E{F.ACT() + r0 * DFF, DFF, 0};
              pg8::gemm_phase<pg8::EpiAct<1, ACT_TILED>, pg8::StaticOrder, GEMM_ALIGN, GEMM_SP2, H_TILED, W_TILED != 0, false, GEMM_EPIOV != 0>(F.lds + RING_OFF, g, S, E); }
            GRID_BAR();
            { pg8::Gemm g{F.ACT() + r0 * DFF, F.Wf2_t(), SEQ / 2, DM, DFF}; pg8::StaticOrder S; S.init(SEQ / 2, DM, F.G, (int)blockIdx.x);
              EPI_T(0) E{F.FF() + r0 * DM, DM EPI_T0};
              pg8::gemm_phase<EPI_T(0), pg8::StaticOrder, GEMM_ALIGN, GEMM_SP2, ACT_TILED, W_TILED != 0, false, false>(F.lds + RING_OFF, g, S, E); }
            GRID_BAR(); }
    }
#else
    if (IN(8)) { XCD_SKEW();
        if (W_P8 && TEAM_B(8)) { p0_weights<W_P8>(F); __syncthreads(); }
        pg8::Gemm g{F.H(), F.Wf1_t(), SEQ, DFF, DM}; SPLIT_ORDER S; SPLIT_INIT(S, SEQ, DFF, F.G, (int)blockIdx.x, DM / 64);
        #if ACT_TILED
        pg8::EpiAct<1, ACT_TILED> E{F.ACT(), DFF, 0};
        pg8::gemm_phase<pg8::EpiAct<1, ACT_TILED>, SPLIT_ORDER, GEMM_ALIGN, GEMM_SP2, H_TILED, W_TILED != 0, false, GEMM_EPIOV != 0>(F.lds + RING_OFF, g, S, E);
#else
        pg8::EpiAct<1, 0> E{F.ACT(), DFF, 0};
        pg8::gemm_phase<pg8::EpiAct<1, 0>, SPLIT_ORDER, GEMM_ALIGN, GEMM_SP2, H_TILED, W_TILED != 0, false, GEMM_EPIOV != 0>(F.lds + RING_OFF, g, S, E);
#endif
#ifdef W8_REP
        p0_weights<W_P8>(F); __syncthreads();
#endif
        if (W_P8 && !TEAM_B(8)) { p0_weights<W_P8>(F); }
        if (BOTH(8)) GRID_BAR();
    }
    STAMP(9);
    REPFOR(9)
#if MK_CLK
    unsigned long long clk_c0 = 0, clk_r0 = 0;
    if (blockIdx.x == 0 && F.tid == 0) { clk_c0 = __builtin_amdgcn_s_memtime(); clk_r0 = __builtin_amdgcn_s_memrealtime(); }
#endif
    if (IN(9)) { XCD_SKEW();
#ifdef HALF_CU_P9
        pg8::Gemm g{F.ACT(), F.Wf2_t(), SEQ, DM, DFF}; pg8::StaticOrder S; S.init(SEQ, DM, (blockIdx.x & 8) ? 1 : F.G / 2, (blockIdx.x & 8) ? 1000000 : (int)((blockIdx.x & 7) | ((blockIdx.x >> 4) << 3)));
#else
        pg8::Gemm g{F.ACT(), F.Wf2_t(), SEQ, DM, DFF}; pg8::StaticOrder S; S.init(SEQ, DM, F.G, (int)blockIdx.x GREP(8));
#endif
        EPI_T(0) E{F.FF(), DM EPI_T0};
        pg8::gemm_phase<EPI_T(0), pg8::StaticOrder, GEMM_ALIGN, GEMM_SP2, ACT_TILED, W_TILED != 0, FF2_KREV != 0, false>(F.lds + RING_OFF, g, S, E);
        if (BOTH(9)) GRID_BAR();
    }
#endif
    STAMP(10);
    REPFOR(10)
#if MK_CLK
    if (blockIdx.x == 0 && F.tid == 0) { const unsigned long long c1 = __builtin_amdgcn_s_memtime(), r1 = __builtin_amdgcn_s_memrealtime();
        ((unsigned long long*)(ws + WS_END + 8192))[0] = c1 - clk_c0; ((unsigned long long*)(ws + WS_END + 8192))[1] = r1 - clk_r0; }
#endif
    if (IN(10)) { t2_rows(F); }
    STAMP(11);
#undef IN
#undef BOTH
#undef GRID_BAR
}

extern "C" void kernel_launch(void* const* d_in, const int* in_sizes, int n_in, void* d_out, int out_size, void* d_ws, size_t ws_size, hipStream_t stream) {
    static int grid = 0;
    if (grid == 0) {
        if (n_in != 17 || out_size != SEQ * DM || ws_size < WS_END) { fprintf(stderr, "kernel_launch: unexpected shapes (n_in %d out %d ws %zu)\n", n_in, out_size, ws_size); grid = -1; return; }
        int dev = 0, cus = 0, per_cu = 0;
        if (hipGetDevice(&dev) != hipSuccess || hipDeviceGetAttribute(&cus, hipDeviceAttributeMultiprocessorCount, dev) != hipSuccess) { grid = -1; return; }
        if (hipFuncSetAttribute((const void*)fwd, hipFuncAttributeMaxDynamicSharedMemorySize, LDS_BYTES) != hipSuccess) { fprintf(stderr, "kernel_launch: hipFuncSetAttribute failed\n"); grid = -1; return; }
        if (hipOccupancyMaxActiveBlocksPerMultiprocessor(&per_cu, (const void*)fwd, NWAVES * 64, LDS_BYTES) != hipSuccess || per_cu < 1)
            fprintf(stderr, "kernel_launch: note: occupancy query reports %d workgroups per CU\n", per_cu);
        (void)hipGetLastError();
        grid = cus;
    }
    if (grid < 0) return;
    (void)hipMemsetAsync((char*)d_ws + WS_CTL, 0, CTL_ZERO_BYTES, stream);
    Args a{};
    for (int i = 0; i < 17; ++i) a.in[i] = (const float*)d_in[i];
    a.out = (float*)d_out; a.ws = (unsigned char*)d_ws;
#if MK_ONE_LAUNCH
    a.ph_lo = 0; a.ph_hi = N_PHASES;
    hipLaunchKernelGGL(fwd, dim3(grid), dim3(NWAVES * 64), LDS_BYTES, stream, a);
#if MK_CLK
    hipLaunchKernelGGL(clk_leak, dim3(1), dim3(1), 0, stream, a);
#endif
#if MK_STAMP
    hipLaunchKernelGGL(stamp_leak, dim3(SEQ * DM / 256), dim3(256), 0, stream, a);
#endif
#else
#if MK_DEBUG
    (void)hipMemsetAsync((char*)d_ws + WS_DBG, 0, 4096, stream);
#endif
    for (int p = 0; p < N_PHASES; ++p) { a.ph_lo = p; a.ph_hi = p + 1; hipLaunchKernelGGL(fwd, dim3(grid), dim3(NWAVES * 64), LDS_BYTES, stream, a);
#if MK_DEBUG
        static const int chk[N_PHASES][3] = {{1, 0, 0}, {2, 0, 0}, {3, 4, 5}, {0, 0, 0}, {0, 0, 0}, {8, 0, 0}, {9, 0, 0}, {13, 0, 0}, {11, 0, 0}, {12, 0, 0}, {14, 0, 0}};
        for (int q = 0; q < 3; ++q) if (chk[p][q]) { Args b = a; b.ph_lo = chk[p][q]; b.ph_hi = 0; hipLaunchKernelGGL(dbg_check, dim3(2048), dim3(64), 0, stream, b); }
#endif
    }
#if MK_DEBUG
    hipLaunchKernelGGL(dbg_leak, dim3(1), dim3(1), 0, stream, a);
#endif
#endif
}
```

```cpp
#include <hip/hip_runtime.h>
#include <cstdio>
#include <cstdint>
#define WIN_SPLIT 1
#ifndef PG8_WGM
#define PG8_WGM 8
#endif
namespace pg8 {
#define PG8_LAS __attribute__((address_space(3)))
typedef unsigned short bf16_t;
typedef short bf16x8 __attribute__((ext_vector_type(8)));
typedef float f32x4 __attribute__((ext_vector_type(4)));
typedef unsigned u32x4 __attribute__((ext_vector_type(4)));
constexpr int BM = 256, BK = 64, HALF = 128, HTB = HALF * BK * 2  , STAGE_BYTES = 8 * HTB, NXCD = 8, WGM = PG8_WGM;

__host__ __device__ __forceinline__ int lds_byte(int r, int c) { const int st = (r >> 4) * 2 + (c >> 5), rr = r & 15, cc = c & 31, ob = rr * 64 + cc * 2; return st * 1024 + (ob ^ (((ob >> 9) & 1) << 5)); }
__host__ __device__ __forceinline__ void stage_rc(int b, int& R, int& C) { const int st = b / 1024, sb = b % 1024, swz = sb ^ (((sb >> 9) & 1) << 5); R = (st >> 1) * 16 + swz / 64; C = (st & 1) * 32 + (swz % 64) / 2; }
__host__ __device__ __forceinline__ int perm32(int rho) { const int n = rho >> 4, i = rho & 15; return 8 * (i >> 2) + 4 * n + (i & 3); }

struct Unit { int pm, pn; int k0 = 0, nt = 0, mode = 0; };
struct Gemm { const bf16_t* A; const bf16_t* Bt; int M, N, K; };

struct StaticOrder {
    static constexpr bool SPLIT = false, DUAL = false;
    int nM, nN, nwg, G, c, rep;
    __host__ __device__ void init(int M, int N, int G_, int c_, int rep_ = 1) { nM = M / BM; nN = N / BM; nwg = nM * nN; G = G_; c = c_; rep = rep_; }
    __host__ __device__ bool next(int i, Unit& u) const {
        const long L = (long)i * G + c; if (L >= (long)nwg * rep) return false;
        int wgid = rep > 1 ? (int)(L % nwg) : (int)L; { const int q = nwg / NXCD, r = nwg % NXCD, xcd = wgid % NXCD, off = wgid / NXCD; wgid = (xcd < r ? xcd * (q + 1) : r * (q + 1) + (xcd - r) * q) + off; }
        const int nig = WGM * nN, gid = wgid / nig, fm = gid * WGM, gsz = (nM - fm) < WGM ? (nM - fm) : WGM;
        u.pm = fm + ((wgid % nig) % gsz); u.pn = (wgid % nig) / gsz; return true;
    }
    __device__ __forceinline__ void a_ready(const Unit&) const {}
    __device__ __forceinline__ void done(const Unit&) const {}
};
struct GateOrder : StaticOrder {
    static constexpr bool SPLIT = false, DUAL = false;
    int nNh;
    __host__ __device__ void init(int M, int N, int G_, int c_) { StaticOrder::init(M, N, G_, c_); nNh = N / BM; }
    __host__ __device__ bool next(int i, Unit& u) const { if (!StaticOrder::next(i >> 1, u)) return false; u.pn += (i & 1) * nNh; return true; }
};
struct DualOrder : StaticOrder {
    static constexpr bool SPLIT = false, DUAL = true;
    __host__ __device__ bool next(int i, Unit& u) const { if (!StaticOrder::next(i >> 1, u)) return false; u.mode = i & 1; return true; }
};
struct SplitOrder : StaticOrder {
    static constexpr bool SPLIT = true, DUAL = false;
    int d, R, ntk; float* part;
    __host__ __device__ void init(int M, int N, int G_, int c_, int ntk_, float* part_) { StaticOrder::init(M, N, G_, c_); ntk = ntk_; part = part_; R = nwg / G_;
        d = (nwg % G_ == 0 && ntk_ >= 16) ? (((c_ & 7) * ntk_ / 8) & ~1) : 0; }
    __host__ __device__ bool next(int i, Unit& u) const {
        if (d == 0) { if (!StaticOrder::next(i, u)) return false; u.k0 = 0; u.nt = ntk; u.mode = 0; return true; }
        if (i > R) return false;
        StaticOrder::next(i == R ? 0 : i, u);
        if (i == 0) { u.k0 = d; u.nt = ntk - d; u.mode = 1; } else if (i == R) { u.k0 = 0; u.nt = d; u.mode = 2; } else { u.k0 = 0; u.nt = ntk; u.mode = 0; }
        return true;
    }
};


typedef float f32x2_c __attribute__((ext_vector_type(2))); typedef __bf16 bf16x2_c __attribute__((ext_vector_type(2)));
__device__ __forceinline__ unsigned cvt_pk_bf16(float lo, float hi) { f32x2_c v = {lo, hi}; bf16x2_c b = __builtin_convertvector(v, bf16x2_c); return __builtin_bit_cast(unsigned, b); }
typedef float f32x2 __attribute__((ext_vector_type(2)));
__device__ __forceinline__ f32x2 gelu_pk(f32x2 v) {
    const f32x2 av = __builtin_elementwise_abs(v), d = av * 0.2316418882f + 1.0f;
    f32x2 t; t.x = __builtin_amdgcn_rcpf(d.x); t.y = __builtin_amdgcn_rcpf(d.y);
    f32x2 q = t * 0.5307027145f + (-0.7265760135f); q = q * t + 0.7107068705f; q = q * t + (-0.142248368f); q = q * t + 0.127414796f; q = q * t;
    const f32x2 s = (v * v) * (-0.72134752044f);
    f32x2 e; e.x = __builtin_amdgcn_exp2f(s.x); e.y = __builtin_amdgcn_exp2f(s.y);
    const f32x2 m = v * (q * e), r = v - m;
    f32x2 o; o.x = v.x < 0.f ? m.x : r.x; o.y = v.y < 0.f ? m.y : r.y; return o;
}
__device__ __forceinline__ float sigmoid_f(float x) { return __builtin_amdgcn_rcpf(1.0f + __builtin_amdgcn_exp2f(-1.4426950408889634f * x)); }
__device__ __forceinline__ float bf_lo(unsigned u) { return __builtin_bit_cast(float, u << 16); }
__device__ __forceinline__ float bf_hi(unsigned u) { return __builtin_bit_cast(float, u & 0xffff0000u); }

template <int LAY> __device__ __forceinline__ size_t tile_base(int pm, int pn, int N, int wr, int wc, int fr, int fq) {
    if (LAY == 1) return (((size_t)pm * (N / 64) + pn * 4 + (wc >> 1)) * BM + wr * 64 + fr) * 64 + (wc & 1) * 32 + 8 * fq;
    if (LAY == 2) return (((size_t)pm * (N / 32) + pn * 8 + wc) * BM + wr * 64 + fr) * 32 + 8 * fq;
    return (size_t)(pm * BM + wr * 64 + fr) * N + (size_t)pn * BM + wc * 32 + 8 * fq;
}
template <int LAY> __device__ __forceinline__ size_t tile_rowstep(int N) { return LAY == 1 ? (size_t)64 : LAY == 2 ? (size_t)32 : (size_t)N; }
template <int LAY> __device__ __forceinline__ size_t tile_bjstep() { return LAY == 0 ? (size_t)HALF : (size_t)(2 * BM * 64); }

template <int ACT> __device__ __forceinline__ void epi_store_tile(const f32x4 (&acc)[2][2][4][2], bf16_t* base, size_t ld, size_t bjstride, int row0, int c8, float scale) {
#ifdef EPI_BJ_OUTER
#pragma unroll
    for (int bj = 0; bj < 2; ++bj)
#pragma unroll
    for (int ai = 0; ai < 2; ++ai)
#pragma unroll
        for (int m = 0; m < 4; ++m) { bf16_t* rowp = base + (size_t)(row0 + ai * HALF + m * 16) * ld + c8; {
#else
#pragma unroll
    for (int ai = 0; ai < 2; ++ai)
#pragma unroll
        for (int m = 0; m < 4; ++m) { bf16_t* rowp = base + (size_t)(row0 + ai * HALF + m * 16) * ld + c8;
#pragma unroll
            for (int bj = 0; bj < 2; ++bj) {
#endif
                f32x4 v0 = acc[ai][bj][m][0], v1 = acc[ai][bj][m][1];
                if (ACT == 1) {
#pragma unroll
                    for (int e = 0; e < 4; ++e) { const float a = fmaxf(v0[e], 0.f), b = fmaxf(v1[e], 0.f); v0[e] = a * a; v1[e] = b * b; } }
                if (ACT == 2) { f32x2 a = gelu_pk((f32x2){v0[0], v0[1]}), b = gelu_pk((f32x2){v0[2], v0[3]}), c = gelu_pk((f32x2){v1[0], v1[1]}), d = gelu_pk((f32x2){v1[2], v1[3]});
                    v0 = (f32x4){a.x, a.y, b.x, b.y}; v1 = (f32x4){c.x, c.y, d.x, d.y}; }
                if (ACT == 3) {
#pragma unroll
                    for (int e = 0; e < 4; ++e) { v0[e] = sigmoid_f(v0[e]); v1[e] = sigmoid_f(v1[e]); } }
                if (ACT == 4) { v0 = v0 * scale; v1 = v1 * scale; }
                u32x4 w; w.x = cvt_pk_bf16(v0[0], v0[1]); w.y = cvt_pk_bf16(v0[2], v0[3]); w.z = cvt_pk_bf16(v1[0], v1[1]); w.w = cvt_pk_bf16(v1[2], v1[3]);
                *(u32x4*)(rowp + bj * bjstride) = w;
                } }
}
template <int ACT> __device__ __forceinline__ void epi_store_tile_buf(const f32x4 (&acc)[2][2][4][2], __amdgpu_buffer_rsrc_t rsrc, unsigned voff0, unsigned ld2, unsigned bj2) {
#pragma unroll
    for (int ai = 0; ai < 2; ++ai)
#pragma unroll
        for (int m = 0; m < 4; ++m) {
#pragma unroll
            for (int bj = 0; bj < 2; ++bj) { f32x4 v0 = acc[ai][bj][m][0], v1 = acc[ai][bj][m][1];
                if (ACT == 1) {
#pragma unroll
                    for (int e = 0; e < 4; ++e) { const float a = fmaxf(v0[e], 0.f), b = fmaxf(v1[e], 0.f); v0[e] = a * a; v1[e] = b * b; } }
                if (ACT == 2) { f32x2 a = gelu_pk((f32x2){v0[0], v0[1]}), b = gelu_pk((f32x2){v0[2], v0[3]}), c = gelu_pk((f32x2){v1[0], v1[1]}), d = gelu_pk((f32x2){v1[2], v1[3]});
                    v0 = (f32x4){a.x, a.y, b.x, b.y}; v1 = (f32x4){c.x, c.y, d.x, d.y}; }
                if (ACT == 3) {
#pragma unroll
                    for (int e = 0; e < 4; ++e) { v0[e] = sigmoid_f(v0[e]); v1[e] = sigmoid_f(v1[e]); } }
                u32x4 w; w.x = cvt_pk_bf16(v0[0], v0[1]); w.y = cvt_pk_bf16(v0[2], v0[3]); w.z = cvt_pk_bf16(v1[0], v1[1]); w.w = cvt_pk_bf16(v1[2], v1[3]);
                __builtin_amdgcn_raw_buffer_store_b128(w, rsrc, voff0 + (unsigned)(ai * HALF + m * 16) * ld2 + (unsigned)bj * bj2, 0, 0); } }
}
template <int ACT, int LAY = 0> struct EpiAct {
    static constexpr bool PERM = true, AFTER_DRAIN = false, IDEM = true;
    bf16_t* O; int N; int pn_off;
    __device__ __forceinline__ void operator()(const f32x4 (&acc)[2][2][4][2], const Unit& u, int wr, int wc, int fr, int fq) const {
#ifdef EPI_BUFSTORE
        const __amdgpu_buffer_rsrc_t rsrc = __builtin_amdgcn_make_buffer_rsrc((void*)O, 0, 0x7ffffff0, 0x00020000);
        epi_store_tile_buf<ACT>(acc, rsrc, (unsigned)(tile_base<LAY>(u.pm, u.pn + pn_off, N, wr, wc, fr, fq) * 2), (unsigned)(tile_rowstep<LAY>(N) * 2), (unsigned)(tile_bjstep<LAY>() * 2));
#else
        epi_store_tile<ACT>(acc, O + tile_base<LAY>(u.pm, u.pn + pn_off, N, wr, wc, fr, fq), tile_rowstep<LAY>(N), tile_bjstep<LAY>(), 0, 0, 1.f);
#endif
    }
};
struct EpiQKV {
    static constexpr bool PERM = true, AFTER_DRAIN = false, IDEM = true;
    bf16_t* QKV; int M; float qscale;
    __device__ __forceinline__ void operator()(const f32x4 (&acc)[2][2][4][2], const Unit& u, int wr, int wc, int fr, int fq) const {
        const int t = u.pn >> 3, hp = u.pn & 7;
        epi_store_tile<4>(acc, QKV + (size_t)(t * 16 + 2 * hp) * M * 128, 128, (size_t)M * 128, u.pm * BM + wr * 64 + fr, wc * 32 + 8 * fq, t == 0 ? qscale : 1.f);
    }
};
template <int LAY = 0> struct EpiGeluStats {
    static constexpr bool PERM = true, AFTER_DRAIN = false, IDEM = true;
    bf16_t* O; int ldc; int pn_off; float* part;
    __device__ __forceinline__ void operator()(const f32x4 (&acc)[2][2][4][2], const Unit& u, int wr, int wc, int fr, int fq) const {
        const int row0 = u.pm * BM + wr * 64 + fr;
        bf16_t* base = O + tile_base<LAY>(u.pm, u.pn + pn_off, ldc, wr, wc, fr, fq);
        const size_t trow = tile_rowstep<LAY>(ldc), tbj = tile_bjstep<LAY>();
#pragma unroll
        for (int ai = 0; ai < 2; ++ai)
#pragma unroll
            for (int m = 0; m < 4; ++m) { const int row = row0 + ai * HALF + m * 16; bf16_t* rowp = base + (size_t)(ai * HALF + m * 16) * trow; float s = 0.f, ss = 0.f;
#pragma unroll
                for (int bj = 0; bj < 2; ++bj) { const f32x4 v0 = acc[ai][bj][m][0], v1 = acc[ai][bj][m][1];
                    const f32x2 a = gelu_pk((f32x2){v0[0], v0[1]}), b = gelu_pk((f32x2){v0[2], v0[3]}), c = gelu_pk((f32x2){v1[0], v1[1]}), d = gelu_pk((f32x2){v1[2], v1[3]});
                    s += ((a.x + a.y) + (b.x + b.y)) + ((c.x + c.y) + (d.x + d.y));
                    ss += ((a.x * a.x + a.y * a.y) + (b.x * b.x + b.y * b.y)) + ((c.x * c.x + c.y * c.y) + (d.x * d.x + d.y * d.y));
                    u32x4 w; w.x = cvt_pk_bf16(a.x, a.y); w.y = cvt_pk_bf16(b.x, b.y); w.z = cvt_pk_bf16(c.x, c.y); w.w = cvt_pk_bf16(d.x, d.y);
                    *(u32x4*)(rowp + bj * tbj) = w; }
                s += __shfl_xor(s, 16); ss += __shfl_xor(ss, 16); s += __shfl_xor(s, 32); ss += __shfl_xor(ss, 32);
                if (fq == 0) *(f32x2*)(part + (((size_t)row * 8 + u.pn) * 4 + wc) * 2) = (f32x2){s, ss}; }
    }
};
template <bool FIRST, int TLAY = 0, int GLAY = 0> struct EpiGate {
    static constexpr bool PERM = true, AFTER_DRAIN = false, IDEM = FIRST;
    const bf16_t* G; int ldg; int gpn; bf16_t* T; int ldc;
    __device__ __forceinline__ void operator()(const f32x4 (&acc)[2][2][4][2], const Unit& u, int wr, int wc, int fr, int fq) const {
        const size_t tbase = tile_base<TLAY>(u.pm, u.pn, ldc, wr, wc, fr, fq), trow = tile_rowstep<TLAY>(ldc), tbj = tile_bjstep<TLAY>();
        const size_t gbase = tile_base<GLAY>(u.pm, u.pn + gpn, ldg, wr, wc, fr, fq), grow = tile_rowstep<GLAY>(ldg), gbj = tile_bjstep<GLAY>();
#pragma unroll
        for (int ai = 0; ai < 2; ++ai)
#pragma unroll
            for (int m = 0; m < 4; ++m) { const size_t off = tbase + (size_t)(ai * HALF + m * 16) * trow, goff = gbase + (size_t)(ai * HALF + m * 16) * grow;
#pragma unroll
                for (int bj = 0; bj < 2; ++bj) { const u32x4 g = *(const u32x4*)(G + goff + bj * gbj);
                    const f32x4 a0 = acc[ai][bj][m][0], a1 = acc[ai][bj][m][1];
                    float o[8] = {a0[0] * bf_lo(g.x), a0[1] * bf_hi(g.x), a0[2] * bf_lo(g.y), a0[3] * bf_hi(g.y), a1[0] * bf_lo(g.z), a1[1] * bf_hi(g.z), a1[2] * bf_lo(g.w), a1[3] * bf_hi(g.w)};
                    if (!FIRST) { const u32x4 p = *(const u32x4*)(T + off + bj * tbj);
                        o[0] += bf_lo(p.x); o[1] += bf_hi(p.x); o[2] += bf_lo(p.y); o[3] += bf_hi(p.y); o[4] += bf_lo(p.z); o[5] += bf_hi(p.z); o[6] += bf_lo(p.w); o[7] += bf_hi(p.w); }
                    u32x4 w; w.x = cvt_pk_bf16(o[0], o[1]); w.y = cvt_pk_bf16(o[2], o[3]); w.z = cvt_pk_bf16(o[4], o[5]); w.w = cvt_pk_bf16(o[6], o[7]);
                    *(u32x4*)(T + off + bj * tbj) = w; } }
    }
};
template <int TLAY = 0, int GLAY = 0> struct EpiGateDual {
    static constexpr bool PERM = true, AFTER_DRAIN = false, IDEM = false;
    const bf16_t* G; int ldg; int gpn_a, gpn_b; bf16_t* T; int ldc;
    static __device__ __forceinline__ float safe(float g) { return fmaxf(g, 8.673617379884035e-19f); }
    __device__ __forceinline__ void mid(f32x4 (&acc)[2][2][4][2], const Unit& u, int wr, int wc, int fr, int fq) const {
        const size_t ga0 = tile_base<GLAY>(u.pm, u.pn + gpn_a, ldg, wr, wc, fr, fq), gb0 = tile_base<GLAY>(u.pm, u.pn + gpn_b, ldg, wr, wc, fr, fq), grow = tile_rowstep<GLAY>(ldg), gbj = tile_bjstep<GLAY>();
#pragma unroll
        for (int ai = 0; ai < 2; ++ai)
#pragma unroll
            for (int m = 0; m < 4; ++m) { const size_t ro = (size_t)(ai * HALF + m * 16) * grow;
#pragma unroll
                for (int bj = 0; bj < 2; ++bj) { const u32x4 a = *(const u32x4*)(G + ga0 + ro + bj * gbj), b = *(const u32x4*)(G + gb0 + ro + bj * gbj);
                    f32x4& a0 = acc[ai][bj][m][0]; f32x4& a1 = acc[ai][bj][m][1];
                    a0[0] *= bf_lo(a.x) * __builtin_amdgcn_rcpf(safe(bf_lo(b.x))); a0[1] *= bf_hi(a.x) * __builtin_amdgcn_rcpf(safe(bf_hi(b.x)));
                    a0[2] *= bf_lo(a.y) * __builtin_amdgcn_rcpf(safe(bf_lo(b.y))); a0[3] *= bf_hi(a.y) * __builtin_amdgcn_rcpf(safe(bf_hi(b.y)));
                    a1[0] *= bf_lo(a.z) * __builtin_amdgcn_rcpf(safe(bf_lo(b.z))); a1[1] *= bf_hi(a.z) * __builtin_amdgcn_rcpf(safe(bf_hi(b.z)));
                    a1[2] *= bf_lo(a.w) * __builtin_amdgcn_rcpf(safe(bf_lo(b.w))); a1[3] *= bf_hi(a.w) * __builtin_amdgcn_rcpf(safe(bf_hi(b.w))); } }
    }
    __device__ __forceinline__ void operator()(const f32x4 (&acc)[2][2][4][2], const Unit& u, int wr, int wc, int fr, int fq) const {
        const size_t tbase = tile_base<TLAY>(u.pm, u.pn, ldc, wr, wc, fr, fq), trow = tile_rowstep<TLAY>(ldc), tbj = tile_bjstep<TLAY>();
        const size_t gb0 = tile_base<GLAY>(u.pm, u.pn + gpn_b, ldg, wr, wc, fr, fq), grow = tile_rowstep<GLAY>(ldg), gbj = tile_bjstep<GLAY>();
#pragma unroll
        for (int ai = 0; ai < 2; ++ai)
#pragma unroll
            for (int m = 0; m < 4; ++m) { const size_t off = tbase + (size_t)(ai * HALF + m * 16) * trow, goff = gb0 + (size_t)(ai * HALF + m * 16) * grow;
#pragma unroll
                for (int bj = 0; bj < 2; ++bj) { const u32x4 g = *(const u32x4*)(G + goff + bj * gbj);
                    const f32x4 a0 = acc[ai][bj][m][0], a1 = acc[ai][bj][m][1];
                    u32x4 w; w.x = cvt_pk_bf16(a0[0] * safe(bf_lo(g.x)), a0[1] * safe(bf_hi(g.x))); w.y = cvt_pk_bf16(a0[2] * safe(bf_lo(g.y)), a0[3] * safe(bf_hi(g.y)));
                    w.z = cvt_pk_bf16(a1[0] * safe(bf_lo(g.z)), a1[1] * safe(bf_hi(g.z))); w.w = cvt_pk_bf16(a1[2] * safe(bf_lo(g.w)), a1[3] * safe(bf_hi(g.w)));
                    *(u32x4*)(T + off + bj * tbj) = w; } }
    }
};
template <class Epi, class Sched, bool ALIGN_EPI = false, bool SP2 = false, int ATILED = 0, bool BTILED = false, bool KREV = false, bool EPI_OVERLAP = false>
__device__ __forceinline__ void gemm_phase(PG8_LAS unsigned char* lds, const Gemm g, const Sched& S, const Epi& E, const bf16_t* A2 = nullptr, const bf16_t* Bt2 = nullptr) {
    const int tid = threadIdx.x, wid = __builtin_amdgcn_readfirstlane(tid >> 6), lane = tid & 63, wr = wid >> 2, wc = wid & 3, fr = lane & 15, fq = lane >> 4;
    const int K = g.K, nt_full = K / BK;
    unsigned voffA[2], voffB[2];
#pragma unroll
    for (int i = 0; i < 2; ++i) { int R, C; stage_rc(tid * 16 + i * 8192, R, C); const int Rb = Epi::PERM ? ((R & ~31) + perm32(R & 31)) : R;
        voffA[i] = ATILED == 2 ? (unsigned)(((C >> 5) * BM + R) * 32 + (C & 31)) * 2u : (unsigned)(R * (ATILED ? BK : K) + C) * 2u; voffB[i] = (unsigned)(Rb * (BTILED ? BK : K) + C) * 2u; }
    const size_t kstep = (size_t)(BK * 2);
    const size_t hstep = (size_t)HALF * K * 2;
    const size_t tstep = 2 * hstep;
    const ptrdiff_t kstepA = (KREV ? -1 : 1) * (ptrdiff_t)(ATILED ? (size_t)BM * BK * 2 : kstep); const size_t hstepA = ATILED == 2 ? (size_t)HALF * 32 * 2 : ATILED ? (size_t)HALF * BK * 2 : hstep;
    const ptrdiff_t kstepB = (KREV ? -1 : 1) * (ptrdiff_t)(BTILED ? (size_t)BM * BK * 2 : kstep); const size_t hstepB = BTILED ? (size_t)HALF * BK * 2 : hstep;
    const ptrdiff_t krevA = KREV ? -(ptrdiff_t)(nt_full - 1) * kstepA : 0, krevB = KREV ? -(ptrdiff_t)(nt_full - 1) * kstepB : 0;
    const unsigned ldsw = (unsigned)wid * 1024u;
    const int aoff = lds_byte(wr * 64 + fr, fq * 8), boff = lds_byte(wc * 32 + fr, fq * 8);
#define PG8_SA(b, h) (((b) * 2 + (h)) * HTB)
#define PG8_SB(b, h) ((4 + (b) * 2 + (h)) * HTB)
#ifndef AUX_A
#define AUX_A 0
#endif
#ifndef AUX_B
#define AUX_B 0
#endif
#define PG8_STAGE(bufoff, gbase, voff, aux) do { _Pragma("unroll") for (int _i = 0; _i < 2; ++_i) \
        __builtin_amdgcn_global_load_lds((const unsigned*)((const char*)(gbase) + (voff)[_i]), (PG8_LAS unsigned*)(lds + (bufoff) + ldsw + _i * 8192), 16, 0, aux); } while (0)
#define PG8_LDA(dst, b, h) do { _Pragma("unroll") for (int m = 0; m < 4; ++m) _Pragma("unroll") for (int k = 0; k < 2; ++k) dst[m][k] = *(const PG8_LAS bf16x8*)(lds + PG8_SA(b, h) + aoff + m * 2048 + k * 1024); } while (0)
#define PG8_LDB(dst, b, h) do { _Pragma("unroll") for (int n = 0; n < 2; ++n) _Pragma("unroll") for (int k = 0; k < 2; ++k) dst[n][k] = *(const PG8_LAS bf16x8*)(lds + PG8_SB(b, h) + boff + n * 2048 + k * 1024); } while (0)
#ifdef NO_SETPRIO
#define PG8_PRIO(x)
#else
#define PG8_PRIO(x) __builtin_amdgcn_s_setprio(x)
#endif
#ifndef MMA_PRIO
#define MMA_PRIO 1
#endif
#ifndef BASE_PRIO
#define BASE_PRIO 0
#endif
#define PG8_MMA(ai, bj, At, Bt) do { PG8_PRIO(MMA_PRIO); _Pragma("unroll") for (int m = 0; m < 4; ++m) _Pragma("unroll") for (int n = 0; n < 2; ++n) _Pragma("unroll") for (int k = 0; k < 2; ++k) \
        acc[ai][bj][m][n] = __builtin_amdgcn_mfma_f32_16x16x32_bf16(Bt[n][k], At[m][k], acc[ai][bj][m][n], 0, 0, 0); PG8_PRIO(BASE_PRIO); } while (0)
#ifndef MMA_HOIST
#define MMA_HOIST 0
#endif
#define PG8_MMA_R(ai, bj, At, Bt, m0, m1) do { PG8_PRIO(MMA_PRIO); _Pragma("unroll") for (int m = (m0); m < (m1); ++m) _Pragma("unroll") for (int n = 0; n < 2; ++n) _Pragma("unroll") for (int k = 0; k < 2; ++k) \
        acc[ai][bj][m][n] = __builtin_amdgcn_mfma_f32_16x16x32_bf16(Bt[n][k], At[m][k], acc[ai][bj][m][n], 0, 0, 0); PG8_PRIO(BASE_PRIO); } while (0)
#define PG8_WAIT_V(n) asm volatile("s_waitcnt vmcnt(" #n ")" ::: "memory")
#define PG8_WAIT_L(n) asm volatile("s_waitcnt lgkmcnt(" #n ")" ::: "memory")
#define PG8_BAR __builtin_amdgcn_s_barrier()
#define PG8_SCHED __builtin_amdgcn_sched_barrier(0)
    Unit cur, nxt; int ui = 0;
    if (!S.next(0, cur)) return;
    f32x4 acc[2][2][4][2];
#pragma unroll
    for (int a = 0; a < 2; ++a)
#pragma unroll
        for (int b = 0; b < 2; ++b)
#pragma unroll
            for (int m = 0; m < 4; ++m)
#pragma unroll
                for (int n = 0; n < 2; ++n) acc[a][b][m][n] = (f32x4){0.f, 0.f, 0.f, 0.f};
    bf16x8 At[4][2], B0[2][2], B1[2][2];
    int nt = nt_full; if constexpr (Sched::SPLIT) nt = cur.nt;
    const char* cA = (const char*)g.A + (size_t)cur.pm * tstep + krevA; const char* cB = (const char*)g.Bt + (size_t)cur.pn * tstep + krevB;
    if constexpr (Sched::SPLIT) { cA += (ptrdiff_t)cur.k0 * kstepA; cB += (ptrdiff_t)cur.k0 * kstepB; }
    S.a_ready(cur);
    if constexpr (SP2) {
        PG8_STAGE(PG8_SB(0, 0), cB, voffB, AUX_B); PG8_STAGE(PG8_SB(0, 1), cB + hstepB, voffB, AUX_B); PG8_STAGE(PG8_SA(0, 0), cA, voffA, AUX_A); PG8_STAGE(PG8_SA(0, 1), cA + hstepA, voffA, AUX_A);
        if (wr == 1) PG8_BAR;
        PG8_WAIT_V(2); PG8_BAR;
        PG8_STAGE(PG8_SB(1, 0), cB + kstepB, voffB, AUX_B); PG8_STAGE(PG8_SA(1, 0), cA + kstepA, voffA, AUX_A); PG8_STAGE(PG8_SB(1, 1), cB + hstepB + kstepB, voffB, AUX_B);
        PG8_WAIT_V(6); PG8_BAR;
    } else {
        PG8_STAGE(PG8_SB(0, 0), cB, voffB, AUX_B); PG8_STAGE(PG8_SA(0, 0), cA, voffA, AUX_A); PG8_STAGE(PG8_SB(0, 1), cB + hstepB, voffB, AUX_B); PG8_STAGE(PG8_SA(0, 1), cA + hstepA, voffA, AUX_A);
        if (wr == 1) PG8_BAR;
        PG8_WAIT_V(4); PG8_BAR;
        PG8_STAGE(PG8_SB(1, 0), cB + kstepB, voffB, AUX_B); PG8_STAGE(PG8_SA(1, 0), cA + kstepA, voffA, AUX_A); PG8_STAGE(PG8_SB(1, 1), cB + hstepB + kstepB, voffB, AUX_B);
        PG8_WAIT_V(6); PG8_BAR;
    }
    for (;;) {
        const bool has_next = S.next(ui + 1, nxt);
        const char* nA = has_next ? (const char*)g.A + (size_t)nxt.pm * tstep + krevA : cA; const char* nB = has_next ? (const char*)g.Bt + (size_t)nxt.pn * tstep + krevB : cB;
        if constexpr (Sched::DUAL) { if (has_next && nxt.mode) { nA = (const char*)A2 + (size_t)nxt.pm * tstep + krevA; nB = (const char*)Bt2 + (size_t)nxt.pn * tstep + krevB; } }
        if constexpr (Sched::SPLIT) { if (has_next) { nA += (ptrdiff_t)nxt.k0 * kstepA; nB += (ptrdiff_t)nxt.k0 * kstepB; } }
        int t_first = 0;
        if constexpr (SP2 && EPI_OVERLAP) { if (ui > 0) {
            const int t = 0; const bool last = false;

#ifdef KWRAP_PROBE
#define PG8_KT(x) ((x) & 7)
#else
#define PG8_KT(x) (x)
#endif
            const char* a1 = cA + (ptrdiff_t)PG8_KT(t + 1) * kstepA;
            const char* a2 = last ? nA : cA + (ptrdiff_t)PG8_KT(t + 2) * kstepA; const char* b2 = last ? nB : cB + (ptrdiff_t)PG8_KT(t + 2) * kstepB;
            const char* a3 = last ? a2 + kstepA : cA + (ptrdiff_t)PG8_KT(t + 3) * kstepA; const char* b3 = last ? b2 + kstepB : cB + (ptrdiff_t)PG8_KT(t + 3) * kstepB;
            PG8_LDB(B0, 0, 0); PG8_LDB(B1, 0, 1); PG8_SCHED; PG8_LDA(At, 0, 0);
            PG8_WAIT_V(24); PG8_WAIT_L(0); PG8_BAR; PG8_MMA(0, 0, At, B0); PG8_MMA(0, 1, At, B1); PG8_BAR; PG8_SCHED;
            PG8_LDA(At, 0, 1); PG8_STAGE(PG8_SB(0, 0), b2, voffB, AUX_B); PG8_STAGE(PG8_SB(0, 1), b2 + hstepB, voffB, AUX_B); PG8_STAGE(PG8_SA(0, 0), a2, voffA, AUX_A);
            PG8_WAIT_V(24); PG8_WAIT_L(0); PG8_BAR; PG8_MMA(1, 0, At, B0); PG8_MMA(1, 1, At, B1); PG8_BAR; PG8_SCHED;
            PG8_LDB(B0, 1, 0); PG8_LDB(B1, 1, 1); PG8_SCHED; PG8_LDA(At, 1, 0); PG8_STAGE(PG8_SA(0, 1), a2 + hstepA, voffA, AUX_A);
            PG8_WAIT_V(24); PG8_WAIT_L(0); PG8_BAR; PG8_MMA(0, 0, At, B0); PG8_MMA(0, 1, At, B1); PG8_BAR; PG8_SCHED;
            PG8_LDA(At, 1, 1); PG8_STAGE(PG8_SB(1, 0), b3, voffB, AUX_B); PG8_STAGE(PG8_SB(1, 1), b3 + hstepB, voffB, AUX_B); PG8_STAGE(PG8_SA(1, 0), a3, voffA, AUX_A);
            PG8_WAIT_V(8); PG8_WAIT_L(0); PG8_BAR; PG8_MMA(1, 0, At, B0); PG8_MMA(1, 1, At, B1); PG8_BAR; PG8_SCHED;
            t_first = 2; } }
        for (int t = t_first; t < nt; t += 2) {
            const bool last = (t == nt - 2);
#ifdef KWRAP_PROBE
#define PG8_KT(x) ((x) & 7)
#else
#define PG8_KT(x) (x)
#endif
            const char* a1 = cA + (ptrdiff_t)PG8_KT(t + 1) * kstepA;
            const char* a2 = last ? nA : cA + (ptrdiff_t)PG8_KT(t + 2) * kstepA; const char* b2 = last ? nB : cB + (ptrdiff_t)PG8_KT(t + 2) * kstepB;
            const char* a3 = last ? a2 + kstepA : cA + (ptrdiff_t)PG8_KT(t + 3) * kstepA; const char* b3 = last ? b2 + kstepB : cB + (ptrdiff_t)PG8_KT(t + 3) * kstepB;
            if (last && has_next) S.a_ready(nxt);
            if constexpr (SP2) {
            PG8_LDB(B0, 0, 0); PG8_LDB(B1, 0, 1); PG8_SCHED; PG8_LDA(At, 0, 0); PG8_STAGE(PG8_SA(1, 1), a1 + hstepA, voffA, AUX_A);
            PG8_WAIT_V(8); PG8_WAIT_L(0); PG8_BAR; PG8_MMA(0, 0, At, B0); PG8_MMA(0, 1, At, B1); PG8_BAR; PG8_SCHED;
            PG8_LDA(At, 0, 1); PG8_STAGE(PG8_SB(0, 0), b2, voffB, AUX_B); PG8_STAGE(PG8_SB(0, 1), b2 + hstepB, voffB, AUX_B); PG8_STAGE(PG8_SA(0, 0), a2, voffA, AUX_A);
            PG8_WAIT_V(8); PG8_WAIT_L(0); PG8_BAR; PG8_MMA(1, 0, At, B0); PG8_MMA(1, 1, At, B1); PG8_BAR; PG8_SCHED;
            PG8_LDB(B0, 1, 0); PG8_LDB(B1, 1, 1); PG8_SCHED; PG8_LDA(At, 1, 0); PG8_STAGE(PG8_SA(0, 1), a2 + hstepA, voffA, AUX_A);
            PG8_WAIT_V(8); PG8_WAIT_L(0); PG8_BAR; PG8_MMA(0, 0, At, B0); PG8_MMA(0, 1, At, B1); PG8_BAR; PG8_SCHED;
            PG8_LDA(At, 1, 1); PG8_STAGE(PG8_SB(1, 0), b3, voffB, AUX_B); PG8_STAGE(PG8_SB(1, 1), b3 + hstepB, voffB, AUX_B); PG8_STAGE(PG8_SA(1, 0), a3, voffA, AUX_A);
            PG8_WAIT_V(8); PG8_WAIT_L(0); PG8_BAR; PG8_MMA(1, 0, At, B0); PG8_MMA(1, 1, At, B1); PG8_BAR; PG8_SCHED;
            } else {
            PG8_LDB(B0, 0, 0); PG8_SCHED; PG8_LDA(At, 0, 0); PG8_STAGE(PG8_SA(1, 1), a1 + hstepA, voffA, AUX_A);
            PG8_WAIT_L(8); PG8_BAR; PG8_WAIT_L(0); PG8_MMA(0, 0, At, B0); PG8_BAR; PG8_SCHED;
            PG8_LDB(B1, 0, 1); PG8_STAGE(PG8_SB(0, 0), b2, voffB, AUX_B);
            PG8_BAR; PG8_WAIT_L(0); PG8_MMA(0, 1, At, B1); PG8_BAR;
            PG8_LDA(At, 0, 1); PG8_STAGE(PG8_SA(0, 0), a2, voffA, AUX_A);
            PG8_BAR; PG8_WAIT_L(0); PG8_MMA(1, 0, At, B0); PG8_BAR; PG8_SCHED;
            PG8_STAGE(PG8_SB(0, 1), b2 + hstepB, voffB, AUX_B);
            PG8_WAIT_V(6); PG8_BAR; PG8_MMA(1, 1, At, B1); PG8_BAR;
            PG8_LDB(B0, 1, 0); PG8_SCHED; PG8_LDA(At, 1, 0); PG8_STAGE(PG8_SA(0, 1), a2 + hstepA, voffA, AUX_A);
            PG8_WAIT_L(8); PG8_BAR; PG8_WAIT_L(0); PG8_MMA(0, 0, At, B0); PG8_BAR; PG8_SCHED;
            PG8_LDB(B1, 1, 1); PG8_STAGE(PG8_SB(1, 0), b3, voffB, AUX_B);
            PG8_BAR; PG8_WAIT_L(0); PG8_MMA(0, 1, At, B1); PG8_BAR;
            PG8_LDA(At, 1, 1); PG8_STAGE(PG8_SA(1, 0), a3, voffA, AUX_A);
            PG8_BAR; PG8_WAIT_L(0); PG8_MMA(1, 0, At, B0); PG8_BAR; PG8_SCHED;
            PG8_STAGE(PG8_SB(1, 1), b3 + hstepB, voffB, AUX_B);
            PG8_WAIT_V(6); PG8_BAR; PG8_MMA(1, 1, At, B1); PG8_BAR;
            }
        }
        if constexpr (ALIGN_EPI) { if (wr == 0) PG8_BAR; }
        if constexpr (SP2 && EPI_OVERLAP) {
            static_assert(ALIGN_EPI, "EPI_OVERLAP needs the aligned epilogues");
            PG8_STAGE(PG8_SA(1, 1), nA + kstepA + hstepA, voffA, AUX_A); PG8_SCHED; asm volatile("" ::: "memory"); }
        bool part_store_ = false; if constexpr (Sched::SPLIT) part_store_ = (cur.mode == 1);
        if (part_store_) {
            if constexpr (Sched::SPLIT) {
            { f32x4* pp_ = (f32x4*)S.part + tid;
_Pragma("unroll") for (int q = 0; q < 32; ++q) { *pp_ = acc[q >> 4][(q >> 3) & 1][(q >> 1) & 3][q & 1]; pp_ += 512; asm volatile("" : "+v"(pp_)); } } }
        } else
        if constexpr (Sched::DUAL) { if (cur.mode == 0) E.mid(acc, cur, wr, wc, fr, fq); else E(acc, cur, wr, wc, fr, fq); }
        else if constexpr (!Epi::AFTER_DRAIN) { E(acc, cur, wr, wc, fr, fq);
#ifdef EPI_TWICE
            if constexpr (Epi::IDEM) { asm volatile("" ::: "memory"); E(acc, cur, wr, wc, fr, fq); }
#endif
            S.done(cur); }
        if (!has_next) break;
        bool part_load_ = false; if constexpr (Sched::SPLIT) part_load_ = (nxt.mode == 2);
        if (part_load_) { if constexpr (Sched::SPLIT) {
            { const f32x4* pp_ = (const f32x4*)S.part + tid;
_Pragma("unroll") for (int q = 0; q < 32; ++q) { acc[q >> 4][(q >> 3) & 1][(q >> 1) & 3][q & 1] = *pp_; pp_ += 512; asm volatile("" : "+v"(pp_)); } } }
#pragma unroll
            for (int q = 0; q < 32; ++q) asm volatile("" : "+v"(acc[q >> 4][(q >> 3) & 1][(q >> 1) & 3][q & 1]));
        } else if (!(Sched::DUAL && cur.mode == 0)) {
#pragma unroll
        for (int a = 0; a < 2; ++a)
#pragma unroll
            for (int b = 0; b < 2; ++b)
#pragma unroll
                for (int m = 0; m < 4; ++m)
#pragma unroll
                    for (int n = 0; n < 2; ++n) acc[a][b][m][n] = (f32x4){0.f, 0.f, 0.f, 0.f};
        }
        cur = nxt; cA = nA; cB = nB; ++ui; if constexpr (Sched::SPLIT) nt = cur.nt;
        if constexpr (ALIGN_EPI) { if (wr == 1) PG8_BAR; }
    }
    PG8_WAIT_V(0);
    if constexpr (!ALIGN_EPI) { if (wr == 0) PG8_BAR; }
    PG8_BAR;
    if constexpr (Epi::AFTER_DRAIN) { E.fused(acc, cur, wr, wc, fr, fq, lds, wid, lane); S.done(cur); }
#undef PG8_SA
#undef PG8_SB
#undef PG8_STAGE
#undef PG8_LDA
#undef PG8_LDB
#undef PG8_MMA
#undef PG8_WAIT_V
#undef PG8_WAIT_L
#undef PG8_BAR
#undef PG8_SCHED
}
}
#define GAS __attribute__((address_space(1)))
#define LAS __attribute__((address_space(3)))
typedef unsigned short bf16;
typedef unsigned v4u __attribute__((ext_vector_type(4)));
typedef float f32x4 __attribute__((ext_vector_type(4)));
typedef short bf16x8 __attribute__((ext_vector_type(8)));
typedef GAS unsigned gu32;
typedef GAS unsigned long long gu64;
#define RLX_AGENT __ATOMIC_RELAXED, __HIP_MEMORY_SCOPE_AGENT
#define LDS_WAIT() asm volatile("s_waitcnt lgkmcnt(0)" ::: "memory")
#define VM_WAIT() asm volatile("s_waitcnt vmcnt(0)" ::: "memory")
__device__ __forceinline__ unsigned long long rt() { return __builtin_amdgcn_s_memrealtime(); }
__device__ __forceinline__ unsigned f2bf(float f) { unsigned u = __builtin_bit_cast(unsigned, f); return (u + 0x7fffu + ((u >> 16) & 1u)) >> 16; }
__device__ __forceinline__ unsigned pk2(float lo, float hi) { return f2bf(lo) | (f2bf(hi) << 16); }
#define XB_TMO      128
#define XB_XCNT(j)  (256  + 64 * (j))
#define XB_XSUB(j)  (1280 + 64 * (j))
#define XB_XGEN(j)  (2304 + 64 * (j))
#define XB_TOP      3328
#define XB_TOPGEN   3392
#define XCD_BAR_WORDS 3456
#define XB_SPIN_CAP (1u << 18)

__device__ __forceinline__ unsigned xb_ld(unsigned* p)              { return __hip_atomic_load(p, __ATOMIC_RELAXED, __HIP_MEMORY_SCOPE_AGENT); }
__device__ __forceinline__ unsigned xb_add(unsigned* p, unsigned v) { return __hip_atomic_fetch_add(p, v, __ATOMIC_RELAXED, __HIP_MEMORY_SCOPE_AGENT); }
__device__ __forceinline__ unsigned xb_xcc_id() { return (unsigned)__builtin_amdgcn_s_getreg((3 << 11) | 20) & 0xFu; }
#define XB_SPIN(cond, bar) do { unsigned _sp = 0; while (cond) { __builtin_amdgcn_s_sleep(1); \
    if ((++_sp & 255u) == 0u) { if (xb_ld(&(bar)[XB_TMO])) break; if (_sp > XB_SPIN_CAP) { atomicAdd(&(bar)[XB_TMO], 1u); break; } } } } while (0)

struct XcdBarrier {
    unsigned* bar; unsigned x;
    volatile LAS unsigned* st;
};

__device__ __forceinline__ XcdBarrier xcd_barrier_post(unsigned* bar, volatile LAS unsigned* st) {
    XcdBarrier b; b.bar = bar; b.x = xb_xcc_id(); b.st = st;
    if (threadIdx.x == 0) (void)xb_add(&bar[XB_XCNT(b.x)], 1u);
    return b;
}
__device__ __forceinline__ void xcd_barrier_complete(unsigned* bar, unsigned x, unsigned& nloc, unsigned& nx) {
    const unsigned G = gridDim.x * gridDim.y * gridDim.z;
    unsigned sum, cnt, mine, sp = 0u;
    for (;;) {
        sum = 0u; cnt = 0u; mine = 0u;
#pragma unroll
        for (unsigned j = 0; j < 16; ++j) { const unsigned c = xb_ld(&bar[XB_XCNT(j)]); sum += c; cnt += (c > 0u) ? 1u : 0u; mine = (j == x) ? c : mine; }
        if (sum == G) break;
        __builtin_amdgcn_s_sleep(1);
        if ((++sp & 255u) == 0u) { if (xb_ld(&bar[XB_TMO])) break; if (sp > XB_SPIN_CAP) { atomicAdd(&bar[XB_TMO], 1u); break; } }
    }
    nloc = mine > 0u ? mine : 1u; nx = cnt > 0u ? cnt : 1u;
}

__device__ __forceinline__ void xcd_barrier(const XcdBarrier& b) {
    asm volatile("s_waitcnt vmcnt(0)" ::: "memory");
    __syncthreads();
    if (threadIdx.x == 0) {
        unsigned* bar = b.bar;
        __builtin_amdgcn_s_waitcnt(0);
        unsigned nloc = b.st[0], nx = b.st[1];
        if (nloc == 0u) { xcd_barrier_complete(bar, b.x, nloc, nx); b.st[0] = nloc; b.st[1] = nx; }
        const unsigned old = xb_add(&bar[XB_XSUB(b.x)], 1u);
        const unsigned gen = old / nloc;
        if (old + 1u == (gen + 1u) * nloc) {
            __builtin_amdgcn_fence(__ATOMIC_RELEASE, "agent");
            asm volatile("s_waitcnt vmcnt(0)" ::: "memory");
            const unsigned og = xb_add(&bar[XB_TOP], 1u);
            const unsigned tg = og / nx;
            if (og + 1u == (tg + 1u) * nx) xb_add(&bar[XB_TOPGEN], 1u);
            else XB_SPIN(xb_ld(&bar[XB_TOPGEN]) == tg, bar);
            __builtin_amdgcn_fence(__ATOMIC_ACQUIRE, "agent");
            xb_add(&bar[XB_XGEN(b.x)], 1u);
            asm volatile("s_waitcnt vmcnt(0)" ::: "memory");
        } else {
            XB_SPIN(xb_ld(&bar[XB_XGEN(b.x)]) == gen, bar);
            __builtin_amdgcn_fence(__ATOMIC_ACQUIRE, "agent");
            asm volatile("s_waitcnt vmcnt(0)" ::: "memory");
        }
    }
    __syncthreads();
}
constexpr int SEQ = 8192, DM = 4096, NIN = 18432, GW = 2048, SBW = 2048, NH = 16, HD = 128, DFF = 16384, NMODC = 6 * DM;
constexpr float EPS = 1e-6f;
constexpr float QSCALE = 0.12751743f;
constexpr int NWAVES = 8;
#ifndef MK_ONE_LAUNCH
#define MK_ONE_LAUNCH 1
#endif
#ifndef MK_CLK
#define MK_CLK 0
#endif
#ifndef MK_STAMP
#define MK_STAMP 0
#endif
#ifndef MK_DEBUG
#define MK_DEBUG 0
#endif
constexpr size_t MiB = 1u << 20;
constexpr size_t WS_CTL = 0, CTL_ZERO_BYTES = 64 * 1024;
constexpr size_t WS_MOD = 1 * MiB;
constexpr size_t WS_STAT = 1 * MiB + 128 * 1024;
constexpr size_t WS_WIN = 2 * MiB;
constexpr size_t WS_WPA = 146 * MiB, WS_WPB = 162 * MiB;
constexpr size_t WS_WO = 178 * MiB;
constexpr size_t WS_WF1 = 210 * MiB;
constexpr size_t WS_WF2 = 338 * MiB;
constexpr size_t WS_H = 466 * MiB;
constexpr size_t WS_GZ = 530 * MiB;
constexpr size_t WS_QKV = 594 * MiB;
constexpr size_t WS_SA = 690 * MiB, WS_SB = 754 * MiB;
constexpr size_t WS_GA = 818 * MiB, WS_AT = 850 * MiB;
constexpr size_t WS_MIXIN = 882 * MiB;
constexpr size_t WS_MIX = 946 * MiB;
constexpr size_t WS_ACT = 1010 * MiB;
constexpr size_t WS_FF = 1266 * MiB;
constexpr size_t WS_PART = 1330 * MiB;
constexpr size_t WS_SPLIT = 1332 * MiB;
constexpr size_t WS_END = 1396 * MiB;
constexpr int CW_TMO = 0, CW_CODE = 1, CW_BAR = 4096;
constexpr int RING_OFF = 0, RING_BYTES = 131072;
constexpr int LDSCTL_OFF = 139264, MISC_OFF = LDSCTL_OFF + 320;
constexpr int LDS_BYTES = 147456;
typedef unsigned u32x2 __attribute__((ext_vector_type(2)));
typedef unsigned u32x4v __attribute__((ext_vector_type(4)));
struct Frame {
    LAS unsigned char* lds;
    volatile LAS unsigned* MISC;
    gu32* ctl;
    int tid, lane, wave, vcu, G;
    const float *x, *c, *w_ada, *b_ada, *g_pre_mix, *w_in, *g_v, *w_s, *b_s, *w_pa, *w_pb, *w_o, *g_post_mix, *g_pre_mlp, *w_ff1, *w_ff2, *g_post_mlp;
    float* out; unsigned char* ws;
    __device__ __forceinline__ float* mod() const { return (float*)(ws + WS_MOD); }
    __device__ __forceinline__ float* stat() const { return (float*)(ws + WS_STAT); }
    __device__ __forceinline__ float* part() const { return (float*)(ws + WS_PART); }
    __device__ __forceinline__ bf16* Win_t() const { return (bf16*)(ws + WS_WIN); }
    __device__ __forceinline__ bf16* Wpa_t() const { return (bf16*)(ws + WS_WPA); }
    __device__ __forceinline__ bf16* Wpb_t() const { return (bf16*)(ws + WS_WPB); }
    __device__ __forceinline__ bf16* Wo_t() const { return (bf16*)(ws + WS_WO); }
    __device__ __forceinline__ bf16* Wf1_t() const { return (bf16*)(ws + WS_WF1); }
    __device__ __forceinline__ bf16* Wf2_t() const { return (bf16*)(ws + WS_WF2); }
    __device__ __forceinline__ bf16* H() const { return (bf16*)(ws + WS_H); }
    __device__ __forceinline__ bf16* GZ() const { return (bf16*)(ws + WS_GZ); }
    __device__ __forceinline__ bf16* QKV() const { return (bf16*)(ws + WS_QKV); }
    __device__ __forceinline__ bf16* SA() const { return (bf16*)(ws + WS_SA); }
    __device__ __forceinline__ bf16* SB() const { return (bf16*)(ws + WS_SB); }
    __device__ __forceinline__ bf16* GA() const { return (bf16*)(ws + WS_GA); }
    __device__ __forceinline__ bf16* AT() const { return (bf16*)(ws + WS_AT); }
    __device__ __forceinline__ bf16* MIXIN() const { return (bf16*)(ws + WS_MIXIN); }
    __device__ __forceinline__ bf16* MIX() const { return (bf16*)(ws + WS_MIX); }
    __device__ __forceinline__ bf16* ACT() const { return (bf16*)(ws + WS_ACT); }
    __device__ __forceinline__ bf16* FF() const { return (bf16*)(ws + WS_FF); }
};
__device__ __forceinline__ float wave_sum(float v) {
#pragma unroll
    for (int o = 1; o < 64; o <<= 1) v += __shfl_xor(v, o);
    return v;
}
__device__ __forceinline__ unsigned pkbf(float lo, float hi) { return pg8::cvt_pk_bf16(lo, hi); }
__device__ __forceinline__ float bflo(unsigned u) { return __builtin_bit_cast(float, u << 16); }
__device__ __forceinline__ float bfhi(unsigned u) { return __builtin_bit_cast(float, u & 0xffff0000u); }

#ifndef W_TILED
#define W_TILED 1
#endif
#ifndef OUT_TILED
#define OUT_TILED 2
#endif
#ifndef AB_TILED
#define AB_TILED 1
#endif
template <int LAY> __device__ __forceinline__ size_t a_off(int row, int col, int N) {
    if (LAY == 1) return ((((size_t)(row >> 8) * (N >> 6) + (col >> 6)) << 8) + (row & 255)) * 64 + (col & 63);
    if (LAY == 2) return ((((size_t)(row >> 8) * (N >> 5) + (col >> 5)) << 8) + (row & 255)) * 32 + (col & 31);
    return (size_t)row * N + col; }
template <int LAY> __device__ __forceinline__ constexpr size_t a_rowstep(int N) { return LAY == 1 ? (size_t)64 : LAY == 2 ? (size_t)32 : (size_t)N; }
template <int COL0, int NCOLS> __device__ __forceinline__ void p0_gemv(Frame& F) {
    constexpr int NB = 256, CPB = NCOLS / NB, Q = CPB / 4, KL = (NWAVES * 64) / Q;
    static_assert(NCOLS % (4 * NB) == 0 && (NWAVES * 64) % Q == 0 && (KL * CPB + DM) * 4 <= RING_BYTES, "gemv geometry");
    LAS float* sc = (LAS float*)(F.lds + RING_OFF);
    LAS float* red = (LAS float*)(F.lds + RING_OFF + 16384);
    for (int i = F.tid; i < DM; i += NWAVES * 64) { const float cv = F.c[i]; sc[i] = cv / (1.0f + __expf(-cv)); }
    __syncthreads();
    for (int cb = blockIdx.x; cb < NB; cb += F.G) {
        { const int kq = F.tid / Q, cq = F.tid % Q; const float* wp = F.w_ada + (size_t)COL0 + (size_t)CPB * cb + 4 * cq;
            f32x4 a = {0.f, 0.f, 0.f, 0.f};
#pragma unroll 8
            for (int k = kq; k < DM; k += KL) { const f32x4 w = __builtin_nontemporal_load((const f32x4*)(wp + (size_t)k * NMODC)); a = a + w * sc[k]; }
            *(LAS f32x4*)(red + kq * CPB + 4 * cq) = a; }
        __syncthreads();
        if (F.tid < CPB) { float s = 0.f;
#pragma unroll 8
            for (int q = 0; q < KL; ++q) s += red[q * CPB + F.tid];
            F.mod()[COL0 + CPB * cb + F.tid] = s + F.b_ada[COL0 + CPB * cb + F.tid]; }
        __syncthreads();
    }
}
__device__ __forceinline__ void p0_tile_load(f32x4 (&v)[16], const float* W, int N, int item, int lane, int nb0 = 0, int nbn = 0) {
    const int nblk = nbn ? nbn : N / 64, kb = item / nblk, nb = nb0 + item % nblk; const float* src = W + (size_t)(64 * kb + (lane >> 4)) * N + 64 * nb + 4 * (lane & 15);
#pragma unroll
    for (int i = 0; i < 16; ++i) v[i] = __builtin_nontemporal_load((const f32x4*)(src + (size_t)(4 * i) * N));
}
__device__ __forceinline__ void p0_tile_store(const f32x4 (&v)[16], int K, int N, bf16* WT, LAS float* scr, int item, int lane, int nb0 = 0, int nbn = 0) {
    const int nblk = nbn ? nbn : N / 64, kb = item / nblk, nb = nb0 + item % nblk, k0 = 64 * kb, n0 = 64 * nb;
    const int n4 = lane & 15, kr = lane >> 4;
#pragma unroll
    for (int i = 0; i < 16; ++i) { const int k = 4 * i + kr; *(LAS f32x4*)(scr + k * 64 + ((4 * n4 + 8 * (k >> 3)) & 63)) = v[i]; }
    asm volatile("s_waitcnt lgkmcnt(0)" ::: "memory");
    const int c = lane >> 3, nn = lane & 7;
#pragma unroll
    for (int it = 0; it < 8; ++it) { const int n = it * 8 + nn; const LAS float* s = scr + (8 * c) * 64 + ((n + 8 * c) & 63);
        v4u o; o.x = pkbf(s[0], s[64]); o.y = pkbf(s[128], s[192]); o.z = pkbf(s[256], s[320]); o.w = pkbf(s[384], s[448]);
        *(GAS v4u*)(WT + a_off<W_TILED>(n0 + n, k0 + 8 * c, K)) = o; }
    asm volatile("s_waitcnt lgkmcnt(0)" ::: "memory");
}
__device__ __forceinline__ void p0_convert(const float* W, int K, int N, bf16* WT, LAS float* scr, int first, int stride, int lane, int nb0 = 0, int nbn = 0) {
    const int nitems = (K / 64) * (nbn ? nbn : N / 64);
    if (first >= nitems) return;
    f32x4 va[16], vb[16];
    p0_tile_load(va, W, N, first, lane, nb0, nbn);
    for (int it = first;;) {
        const bool n1 = it + stride < nitems; if (n1) p0_tile_load(vb, W, N, it + stride, lane, nb0, nbn);
        p0_tile_store(va, K, N, WT, scr, it, lane, nb0, nbn);
        if (!n1) break; it += stride;
        const bool n2 = it + stride < nitems; if (n2) p0_tile_load(va, W, N, it + stride, lane, nb0, nbn);
        p0_tile_store(vb, K, N, WT, scr, it, lane, nb0, nbn);
        if (!n2) break; it += stride;
    }
}
#ifndef WIN_SPLIT
#define WIN_SPLIT 0
#endif
template <int WHICH> __device__ __forceinline__ void p0_weights(Frame& F) {
    LAS float* scr = (LAS float*)(F.lds + RING_OFF + F.wave * 16384);
    const int gw = F.vcu * NWAVES + F.wave, NGW = F.G * NWAVES;
    if (WHICH & 1) p0_convert(F.w_in, DM, NIN, F.Win_t(), scr, gw, NGW, F.lane, 0, (WHICH & 64) ? 0 : (WIN_SPLIT ? (2 * GW + 3 * SBW) / 64 : 0));
    if (WHICH & 2) p0_convert(F.w_pa, GW, DM, F.Wpa_t(), scr, gw, NGW, F.lane);
    if (WHICH & 4) p0_convert(F.w_pb, SBW, DM, F.Wpb_t(), scr, gw, NGW, F.lane);
    if (WHICH & 8) p0_convert(F.w_o, DM, DM, F.Wo_t(), scr, gw, NGW, F.lane);
    if (WHICH & 16) p0_convert(F.w_ff1, DM, DFF, F.Wf1_t(), scr, gw, NGW, F.lane);
    if (WHICH & 32) p0_convert(F.w_ff2, DFF, DM, F.Wf2_t(), scr, gw, NGW, F.lane);
    if ((WHICH & 64) && !(WHICH & 1)) p0_convert(F.w_in, DM, NIN, F.Win_t(), scr, gw, NGW, F.lane, (2 * GW + 3 * SBW) / 64, (2 * DM) / 64);
}
#ifndef H_TILED
#define H_TILED 1
#endif
#if H_TILED == 2
constexpr int H_JSTEP = 4 * 256 * 64 * 2 / 8;
__device__ __forceinline__ GAS unsigned long long* h_row_ptr(bf16* H, int row, int lane) {
    return (GAS unsigned long long*)(H + (((size_t)(row >> 8) * 128 + (lane >> 3)) * 256 + (row & 255)) * 32) + (lane & 7); }
#elif H_TILED == 1
constexpr int H_JSTEP = 4 * 256 * 64 * 2 / 8;
__device__ __forceinline__ GAS unsigned long long* h_row_ptr(bf16* H, int row, int lane) {
    return (GAS unsigned long long*)(H + (((size_t)(row >> 8) * 64 + (lane >> 4)) * 256 + (row & 255)) * 64) + (lane & 15); }
#else
constexpr int H_JSTEP = 64;
__device__ __forceinline__ GAS unsigned long long* h_row_ptr(bf16* H, int row, int lane) { return (GAS unsigned long long*)(H + (size_t)row * DM) + lane; }
#endif
#if OUT_TILED == 2
constexpr int O_JSTEP = 4 * 256 * 64 * 2 / 8;
__device__ __forceinline__ const GAS u32x2* o_row_ptr(const bf16* O, int row, int lane) {
    return (const GAS u32x2*)(O + (((size_t)(row >> 8) * 128 + (lane >> 3)) * 256 + (row & 255)) * 32) + (lane & 7); }
#elif OUT_TILED == 1
constexpr int O_JSTEP = 4 * 256 * 64 * 2 / 8;
__device__ __forceinline__ const GAS u32x2* o_row_ptr(const bf16* O, int row, int lane) {
    return (const GAS u32x2*)(O + (((size_t)(row >> 8) * 64 + (lane >> 4)) * 256 + (row & 255)) * 64) + (lane & 15); }
#else
constexpr int O_JSTEP = 64;
__device__ __forceinline__ const GAS u32x2* o_row_ptr(const bf16* O, int row, int lane) { return (const GAS u32x2*)(O + (size_t)row * DM) + lane; }
#endif
#ifndef X1_NT
#define X1_NT 0
#endif
#ifndef X1_RECOMP
#define X1_RECOMP 0
#endif
#ifndef T_STAGGER
#define T_STAGGER 40
#endif
__device__ __forceinline__ void t0_rows(Frame& F) {
    LAS float* Av = (LAS float*)(F.lds + RING_OFF); LAS float* Bv = Av + DM;
    for (int i = F.tid; i < DM; i += NWAVES * 64) { Av[i] = F.g_pre_mix[i] * (1.0f + F.mod()[DM + i]); Bv[i] = F.mod()[i]; }
    __syncthreads();
    const int gw = F.vcu * NWAVES + F.wave, NGW = F.G * NWAVES;
    if (T_STAGGER && F.wave >= 4) __builtin_amdgcn_s_sleep(T_STAGGER);
    for (int row = gw; row < SEQ; row += NGW) {
        const GAS f32x4* xr = (const GAS f32x4*)(F.x + (size_t)row * DM) + F.lane;
        f32x4 v[16]; float s = 0.f;
#pragma unroll
        for (int j = 0; j < 16; ++j) { v[j] = xr[64 * j]; s += (v[j].x * v[j].x + v[j].y * v[j].y) + (v[j].z * v[j].z + v[j].w * v[j].w); }
        const float inv = 1.0f / sqrtf(wave_sum(s) * (1.0f / DM) + EPS);
        GAS unsigned long long* o8 = h_row_ptr(F.H(), row, F.lane);
#pragma unroll
        for (int j = 0; j < 16; ++j) { const f32x4 a = *(LAS f32x4*)(Av + 4 * (F.lane + 64 * j)), b = *(LAS f32x4*)(Bv + 4 * (F.lane + 64 * j));
            const f32x4 h = v[j] * inv * a + b;
            o8[H_JSTEP * j] = (unsigned long long)pkbf(h.x, h.y) | ((unsigned long long)pkbf(h.z, h.w) << 32); if ((j & 3) == 3) asm volatile("" ::: "memory"); }
    }
}
__device__ __forceinline__ void t1_rows(Frame& F) {
    LAS float* G1 = (LAS float*)(F.lds + RING_OFF); LAS float* A2 = G1 + DM; LAS float* B2 = A2 + DM;
    for (int i = F.tid; i < DM; i += NWAVES * 64) { G1[i] = F.mod()[2 * DM + i] * F.g_post_mix[i]; A2[i] = F.g_pre_mlp[i] * (1.0f + F.mod()[4 * DM + i]); B2[i] = F.mod()[3 * DM + i]; }
    __syncthreads();
    const int gw = F.vcu * NWAVES + F.wave, NGW = F.G * NWAVES;
    if (T_STAGGER && F.wave >= 4) __builtin_amdgcn_s_sleep(T_STAGGER);
#define T_STEP(ptr, n) do { (ptr) += (n); asm volatile("" : "+v"(ptr)); } while (0)
    for (int row = gw; row < SEQ; row += NGW) {
        const GAS u32x2* mr = o_row_ptr(F.MIX(), row, F.lane);
        const GAS f32x4* xr = (const GAS f32x4*)(F.x + (size_t)row * DM) + F.lane;
        u32x2 mu[16]; f32x4 v[16];
#pragma unroll
        for (int j = 0; j < 16; ++j) { mu[j] = *mr; T_STEP(mr, O_JSTEP); }
#pragma unroll
        for (int j = 0; j < 16; ++j) { v[j] = *xr; T_STEP(xr, 64); }
        float s = 0.f;
#pragma unroll
        for (int j = 0; j < 16; ++j) { const float a = bflo(mu[j].x), b = bfhi(mu[j].x), c = bflo(mu[j].y), d = bfhi(mu[j].y); s += (a * a + b * b) + (c * c + d * d); }
        const float inv1 = 1.0f / sqrtf(wave_sum(s) * (1.0f / DM) + EPS);
        GAS f32x4* orow = (GAS f32x4*)(F.out + (size_t)row * DM) + F.lane;
        float s2 = 0.f;
#pragma unroll
        for (int j = 0; j < 16; ++j) { const f32x4 g = *(LAS f32x4*)(G1 + 4 * (F.lane + 64 * j)); const f32x4 m = (f32x4){bflo(mu[j].x), bfhi(mu[j].x), bflo(mu[j].y), bfhi(mu[j].y)};
            v[j] = v[j] + g * (m * inv1); if (!X1_RECOMP) { *orow = v[j]; T_STEP(orow, 64); } s2 += (v[j].x * v[j].x + v[j].y * v[j].y) + (v[j].z * v[j].z + v[j].w * v[j].w); if ((j & 3) == 3) asm volatile("" ::: "memory"); }
        const float inv2 = 1.0f / sqrtf(wave_sum(s2) * (1.0f / DM) + EPS);
        GAS unsigned long long* o8 = h_row_ptr(F.H(), row, F.lane);
#pragma unroll
        for (int j = 0; j < 16; ++j) { const f32x4 a = *(LAS f32x4*)(A2 + 4 * (F.lane + 64 * j)), b = *(LAS f32x4*)(B2 + 4 * (F.lane + 64 * j));
            const f32x4 h = v[j] * inv2 * a + b;
            *o8 = (unsigned long long)pkbf(h.x, h.y) | ((unsigned long long)pkbf(h.z, h.w) << 32); T_STEP(o8, H_JSTEP); if ((j & 3) == 3) asm volatile("" ::: "memory"); }
    }
}
#if X1_RECOMP
__device__ __forceinline__ void t2_rows(Frame& F) {
    LAS float* G2 = (LAS float*)(F.lds + RING_OFF); LAS float* G1 = G2 + DM;
    for (int i = F.tid; i < DM; i += NWAVES * 64) { G2[i] = F.mod()[5 * DM + i] * F.g_post_mlp[i]; G1[i] = F.mod()[2 * DM + i] * F.g_post_mix[i]; }
    __syncthreads();
    const int gw = F.vcu * NWAVES + F.wave, NGW = F.G * NWAVES;
    if (T_STAGGER && F.wave >= 4) __builtin_amdgcn_s_sleep(T_STAGGER);
    for (int row = gw; row < SEQ; row += NGW) {
        const GAS u32x2* fr_ = o_row_ptr(F.FF(), row, F.lane); const GAS u32x2* mr = o_row_ptr(F.MIX(), row, F.lane);
        const GAS f32x4* xr = (const GAS f32x4*)(F.x + (size_t)row * DM) + F.lane;
        GAS f32x4* orow = (GAS f32x4*)(F.out + (size_t)row * DM) + F.lane;
        u32x2 fu[16], mu[16];
#pragma unroll
        for (int j = 0; j < 16; ++j) { mu[j] = *mr; T_STEP(mr, O_JSTEP); }
#pragma unroll
        for (int j = 0; j < 16; ++j) { fu[j] = *fr_; T_STEP(fr_, O_JSTEP); }
        float s1 = 0.f, s3 = 0.f;
#pragma unroll
        for (int j = 0; j < 16; ++j) { const float a = bflo(mu[j].x), b = bfhi(mu[j].x), c = bflo(mu[j].y), d = bfhi(mu[j].y); s1 += (a * a + b * b) + (c * c + d * d); }
#pragma unroll
        for (int j = 0; j < 16; ++j) { const float a = bflo(fu[j].x), b = bfhi(fu[j].x), c = bflo(fu[j].y), d = bfhi(fu[j].y); s3 += (a * a + b * b) + (c * c + d * d); }
        const float inv1 = 1.0f / sqrtf(wave_sum(s1) * (1.0f / DM) + EPS), inv3 = 1.0f / sqrtf(wave_sum(s3) * (1.0f / DM) + EPS);
#define T2_CHUNK(c) do { f32x4 xc[4]; _Pragma("unroll") for (int j = 0; j < 4; ++j) { xc[j] = *xr; T_STEP(xr, 64); } \
            _Pragma("unroll") for (int j = 0; j < 4; ++j) { const int jj = 4 * (c) + j; \
                const f32x4 g1 = *(LAS f32x4*)(G1 + 4 * (F.lane + 64 * jj)), g2 = *(LAS f32x4*)(G2 + 4 * (F.lane + 64 * jj)); \
                const f32x4 m = (f32x4){bflo(mu[jj].x), bfhi(mu[jj].x), bflo(mu[jj].y), bfhi(mu[jj].y)}, f = (f32x4){bflo(fu[jj].x), bfhi(fu[jj].x), bflo(fu[jj].y), bfhi(fu[jj].y)}; \
                const f32x4 x1 = xc[j] + g1 * (m * inv1); *orow = x1 + g2 * (f * inv3); T_STEP(orow, 64); } \
            asm volatile("" ::: "memory"); } while (0)
        asm volatile("" ::: "memory");
        T2_CHUNK(0); T2_CHUNK(1); T2_CHUNK(2); T2_CHUNK(3);
#undef T2_CHUNK
    }
}
#else
__device__ __forceinline__ void t2_rows(Frame& F) {
    LAS float* G2 = (LAS float*)(F.lds + RING_OFF);
    for (int i = F.tid; i < DM; i += NWAVES * 64) G2[i] = F.mod()[5 * DM + i] * F.g_post_mlp[i];
    __syncthreads();
    const int gw = F.vcu * NWAVES + F.wave, NGW = F.G * NWAVES;
    if (T_STAGGER && F.wave >= 4) __builtin_amdgcn_s_sleep(T_STAGGER);
    for (int row = gw; row < SEQ; row += NGW) {
        const GAS u32x2* fr_ = o_row_ptr(F.FF(), row, F.lane);
        GAS f32x4* orow = (GAS f32x4*)(F.out + (size_t)row * DM) + F.lane;
        u32x2 fu[16]; f32x4 v[16];
#pragma unroll
        for (int j = 0; j < 16; ++j) fu[j] = fr_[O_JSTEP * j];
#pragma unroll
        for (int j = 0; j < 16; ++j) v[j] = orow[64 * j];
        float s = 0.f;
#pragma unroll
        for (int j = 0; j < 16; ++j) { const float a = bflo(fu[j].x), b = bfhi(fu[j].x), c = bflo(fu[j].y), d = bfhi(fu[j].y); s += (a * a + b * b) + (c * c + d * d); }
        const float inv = 1.0f / sqrtf(wave_sum(s) * (1.0f / DM) + EPS);
#pragma unroll
        for (int j = 0; j < 16; ++j) { const f32x4 g = *(LAS f32x4*)(G2 + 4 * (F.lane + 64 * j)); const f32x4 m = (f32x4){bflo(fu[j].x), bfhi(fu[j].x), bflo(fu[j].y), bfhi(fu[j].y)};
            orow[64 * j] = v[j] + g * (m * inv); if ((j & 3) == 3) asm volatile("" ::: "memory"); }
    }
}
#endif
__device__ __forceinline__ void gmlp_stats_naive(Frame& F) {
    const int gw = F.vcu * NWAVES + F.wave, NGW = F.G * NWAVES;
    if (T_STAGGER && F.wave >= 4) __builtin_amdgcn_s_sleep(T_STAGGER);
    for (int row = gw; row < SEQ; row += NGW) {
        const GAS u32x2* vr = (const GAS u32x2*)(F.GZ() + (size_t)row * DM + GW) + F.lane;
        f32x4 v[8]; float s = 0.f;
#pragma unroll
        for (int j = 0; j < 8; ++j) { const u32x2 u = vr[64 * j]; v[j] = (f32x4){bflo(u.x), bfhi(u.x), bflo(u.y), bfhi(u.y)}; s += (v[j].x + v[j].y) + (v[j].z + v[j].w); }
        const float mean = wave_sum(s) * (1.0f / GW); float s2 = 0.f;
#pragma unroll
        for (int j = 0; j < 8; ++j) { const f32x4 d = v[j] - mean; s2 += (d.x * d.x + d.y * d.y) + (d.z * d.z + d.w * d.w); }
        const float rstd = 1.0f / sqrtf(wave_sum(s2) * (1.0f / GW) + EPS);
        if (F.lane == 0) { F.stat()[2 * row] = mean; F.stat()[2 * row + 1] = rstd; }
    }
}
__device__ __forceinline__ void gmlp_main_naive(Frame& F) {
    const size_t total = (size_t)SEQ * GW, stride = (size_t)F.G * NWAVES * 64;
    for (size_t idx = (size_t)blockIdx.x * NWAVES * 64 + F.tid; idx < total; idx += stride) {
        const int row = (int)(idx / GW), c = (int)(idx % GW), n = row >> 7, t = row & 127, g = c >> 7;
        const int smax = t < 64 ? 64 : 128;
        const float* wr_ = F.w_s + ((size_t)g * 128 + t) * 128;
        const float gv = F.g_v[c]; float y = 0.f;
        for (int s = 0; s < smax; ++s) { const int r = n * 128 + s; const unsigned short hv = F.GZ()[(size_t)r * DM + GW + c];
            const float vn = (__builtin_bit_cast(float, (unsigned)hv << 16) - __hip_atomic_load(F.stat() + 2 * r, __ATOMIC_RELAXED, __HIP_MEMORY_SCOPE_AGENT)) * __hip_atomic_load(F.stat() + 2 * r + 1, __ATOMIC_RELAXED, __HIP_MEMORY_SCOPE_AGENT) * gv; y += wr_[s] * vn; }
        y += F.b_s[g * 128 + t];
        const float u = __builtin_bit_cast(float, (unsigned)F.GZ()[(size_t)row * DM + c] << 16);
        const unsigned pk = pkbf(u * y, 0.f);
        F.GA()[(size_t)row * GW + c] = (bf16)(pk & 0xffffu);
    }
}
__device__ __forceinline__ void attn_naive(Frame& F) {
    const int gw = F.vcu * NWAVES + F.wave, NGW = F.G * NWAVES;
    for (int item = gw; item < SEQ * NH; item += NGW) {
        const int t = item / NH, h = item % NH;
        const bf16* Q = F.QKV() + ((size_t)(0 * NH + h) * SEQ) * HD; const bf16* K = F.QKV() + ((size_t)(1 * NH + h) * SEQ) * HD; const bf16* V = F.QKV() + ((size_t)(2 * NH + h) * SEQ) * HD;
        const unsigned qq = *(const GAS unsigned*)(Q + (size_t)t * HD + 2 * F.lane);
        const float q0 = bflo(qq), q1 = bfhi(qq);
        float o0 = 0.f, o1 = 0.f, R = 1.0f;
        for (int s = t - 1; s >= 0; --s) {
            const unsigned kk = *(const GAS unsigned*)(K + (size_t)s * HD + 2 * F.lane), vv = *(const GAS unsigned*)(V + (size_t)s * HD + 2 * F.lane);
            const float z2 = wave_sum(q0 * bflo(kk) + q1 * bfhi(kk));
            const float e = __builtin_amdgcn_exp2f(fminf(z2, 120.f)), r = __builtin_amdgcn_rcpf(1.0f + e), a = e * r * R;
            R *= r; o0 += a * bflo(vv); o1 += a * bfhi(vv);
        }
        *(GAS unsigned*)(F.AT() + (size_t)t * SBW + h * HD + 2 * F.lane) = pkbf(o0, o1);
    }
}
namespace sba {
typedef short bf16x8 __attribute__((ext_vector_type(8)));
typedef short s16x4 __attribute__((ext_vector_type(4)));
typedef float f32x16 __attribute__((ext_vector_type(16)));
typedef unsigned u32x4 __attribute__((ext_vector_type(4)));
constexpr int D = 128, KVBLK = 64, QBLK = 32, QB = 256;
constexpr int SHM_V = KVBLK * D * 2, SHM_K = KVBLK * D * 2;
constexpr int LDS_FLAGS = 2 * SHM_V + 2 * SHM_K;
constexpr int LDS_NEED = LDS_FLAGS + 128;
#define KSWZ(row, colB) ((row) * 256 + ((colB) ^ (((row) & 7) << 4)))
#define SBAR() __builtin_amdgcn_sched_barrier(0)
__device__ __forceinline__ int v_st(int k, int c) { const int kk = (k & ~0xC) | ((k & 4) << 1) | ((k & 8) >> 1); return ((kk >> 3) * 4 + (c >> 5)) * 512 + ((kk & 7) * 32 + (c & 31)) * 2; }
__device__ __forceinline__ int v_rd_base(int lane) { return ((lane & 3) << 3) | (((lane >> 2) & 3) << 6) | (((lane >> 4) & 1) << 5) | (((lane >> 5) & 1) << 8); }
constexpr int v_rd_off(int d0, int ks, int half) { return d0 * 512 + ks * 4096 + half * 2048; }
__device__ __forceinline__ int crow(int r, int hi) { return (r & 3) + 8 * (r >> 2) + 4 * hi; }
__device__ __forceinline__ unsigned cvtpk(float lo, float hi) { return pg8::cvt_pk_bf16(lo, hi); }

template <int KB>
__device__ __forceinline__ void qkt(f32x16& p0, f32x16& p1, const LAS char* K_lds, int r32, int hi, const bf16x8* qr) {
    p0 = f32x16{}; p1 = f32x16{};
    const LAS char* kb[4];
#pragma unroll
    for (int dd = 0; dd < 4; ++dd) kb[dd] = K_lds + KB * SHM_K + KSWZ(r32, (dd * 16 + hi * 8) * 2);
#pragma unroll
    for (int d0 = 0; d0 < 8; ++d0) { const LAS char* a = kb[d0 & 3] + (d0 >> 2) * 128;
        bf16x8 b0 = *reinterpret_cast<const LAS bf16x8*>(a);
        bf16x8 b1 = *reinterpret_cast<const LAS bf16x8*>(a + 32 * 256);
        p0 = __builtin_amdgcn_mfma_f32_32x32x16_bf16(b0, qr[d0], p0, 0, 0, 0);
        p1 = __builtin_amdgcn_mfma_f32_32x32x16_bf16(b1, qr[d0], p1, 0, 0, 0); }
}
template <int VB>
__device__ __forceinline__ void pv_tile(f32x16* o, int vb0, bf16x8 pa0, bf16x8 pa1, bf16x8 pa2, bf16x8 pa3) {
#define TRRD(dst, off) asm volatile("ds_read_b64_tr_b16 %0, %1 offset:%2" : "=&v"(dst) : "v"(vb0), "i"(off) : "memory")
#define PV_D0(d0) do { s16x4 l0, l1, l2, l3, h0, h1, h2, h3; constexpr int b_ = VB * SHM_V + v_rd_off(d0, 0, 0); \
        TRRD(l0, b_); TRRD(h0, b_ + 2048); TRRD(l1, b_ + 4096); TRRD(h1, b_ + 6144); TRRD(l2, b_ + 8192); TRRD(h2, b_ + 10240); TRRD(l3, b_ + 12288); TRRD(h3, b_ + 14336); \
        asm volatile("s_waitcnt lgkmcnt(0)" ::: "memory"); SBAR(); \
        o[d0] = __builtin_amdgcn_mfma_f32_32x32x16_bf16(pa0, (bf16x8){l0[0], l0[1], l0[2], l0[3], h0[0], h0[1], h0[2], h0[3]}, o[d0], 0, 0, 0); \
        o[d0] = __builtin_amdgcn_mfma_f32_32x32x16_bf16(pa1, (bf16x8){l1[0], l1[1], l1[2], l1[3], h1[0], h1[1], h1[2], h1[3]}, o[d0], 0, 0, 0); \
        o[d0] = __builtin_amdgcn_mfma_f32_32x32x16_bf16(pa2, (bf16x8){l2[0], l2[1], l2[2], l2[3], h2[0], h2[1], h2[2], h2[3]}, o[d0], 0, 0, 0); \
        o[d0] = __builtin_amdgcn_mfma_f32_32x32x16_bf16(pa3, (bf16x8){l3[0], l3[1], l3[2], l3[3], h3[0], h3[1], h3[2], h3[3]}, o[d0], 0, 0, 0); } while (0)
    PV_D0(0); PV_D0(1); PV_D0(2); PV_D0(3);
#undef PV_D0
#undef TRRD
}
__device__ __forceinline__ void sb_half(f32x16& p, float& R, int hi, bf16x8& paA, bf16x8& paB) {
    f32x16 c;
#pragma unroll
    for (int r = 0; r < 16; ++r) { const float e = __builtin_amdgcn_exp2f(fminf(p[r], 120.f)); c[r] = __builtin_amdgcn_rcpf(1.0f + e); p[r] = e * c[r]; }
    float TE[4], TO[4];
#pragma unroll
    for (int i = 0; i < 4; ++i) { const float T = (c[4 * i] * c[4 * i + 1]) * (c[4 * i + 2] * c[4 * i + 3]);
        auto rr = __builtin_amdgcn_permlane32_swap(__float_as_uint(T), __float_as_uint(T), false, false); TE[i] = __uint_as_float(rr[0]); TO[i] = __uint_as_float(rr[1]); }
    float X[4]; float x = R;
#pragma unroll
    for (int i = 3; i >= 0; --i) { const float xo = x; x *= TO[i]; const float xe = x; x *= TE[i]; X[i] = hi ? xo : xe; }
    R = x;
#pragma unroll
    for (int i = 0; i < 4; ++i) { const float f3 = X[i], f2 = f3 * c[4 * i + 3], f1 = f2 * c[4 * i + 2], f0 = f1 * c[4 * i + 1];
        p[4 * i + 3] *= f3; p[4 * i + 2] *= f2; p[4 * i + 1] *= f1; p[4 * i] *= f0; }
#define PK4(P, B_, OUT) do { unsigned a0 = cvtpk(P[B_+0], P[B_+1]), a1 = cvtpk(P[B_+2], P[B_+3]); \
        unsigned b0 = cvtpk(P[B_+4], P[B_+5]), b1 = cvtpk(P[B_+6], P[B_+7]); \
        auto r0 = __builtin_amdgcn_permlane32_swap(a0, b0, false, false); auto r1 = __builtin_amdgcn_permlane32_swap(a1, b1, false, false); \
        u32x4 w = {r0[0], r1[0], r0[1], r1[1]}; OUT = __builtin_bit_cast(bf16x8, w); } while (0)
    PK4(p, 0, paA); PK4(p, 8, paB);
#undef PK4
}
__device__ __forceinline__ void mask_tile(f32x16& p0, f32x16& p1, int dq) {
    const float NEG = -__builtin_inff();
#pragma unroll
    for (int r = 0; r < 16; ++r) { const int c = (r & 3) + 8 * (r >> 2);
        if (dq - c <= 0) p0[r] = NEG;
        if (dq - c - 32 <= 0) p1[r] = NEG; }
}
template <bool SKIP>
__device__ __forceinline__ void attn_unit(const bf16* Qh, const bf16* Kh, const bf16* Vh, bf16* Oh, int ocol0, int opitch, int P0, LAS char* lds) {
    const int tid = threadIdx.x, wid = __builtin_amdgcn_readfirstlane(tid >> 6), lane = tid & 63, r32 = lane & 31, hi = lane >> 5;
    const int NT = P0 / KVBLK + 4;
    const int qlo = P0 + wid * QBLK, qm = qlo + r32 - 4 * hi;
    LAS char* V_lds = lds; LAS char* K_lds = lds + 2 * SHM_V;
    volatile LAS unsigned* flags = (volatile LAS unsigned*)(lds + LDS_FLAGS);
    const int sr = tid >> 4, sc = (tid & 15) * 8, vst0 = v_st(sr, sc), vst1 = v_st(32 + sr, sc), kws = KSWZ(sr, sc * 2);
    const int vb0 = (int)(uintptr_t)V_lds + v_rd_base(lane);
    bf16x8 qr[8];
#pragma unroll
    for (int d0 = 0; d0 < 8; ++d0) qr[d0] = *(const GAS bf16x8*)(Qh + (size_t)(qlo + r32) * D + d0 * 16 + hi * 8);
    f32x16 o[4] = {}; float R = 1.0f;
    bf16x8 st_v0, st_v1, st_k0, st_k1;
#define KBASE(t) ((NT - 1 - (t)) * KVBLK)
#define SLOAD(t) do { const size_t k0_ = (size_t)KBASE(t); st_v0 = *(const GAS bf16x8*)(Vh + (k0_ + sr) * D + sc); st_v1 = *(const GAS bf16x8*)(Vh + (k0_ + 32 + sr) * D + sc); \
                      st_k0 = *(const GAS bf16x8*)(Kh + (k0_ + sr) * D + sc); st_k1 = *(const GAS bf16x8*)(Kh + (k0_ + 32 + sr) * D + sc); } while (0)
#define SWRITE(bf) do { *(LAS bf16x8*)(V_lds + (bf) * SHM_V + vst0) = st_v0; *(LAS bf16x8*)(V_lds + (bf) * SHM_V + vst1) = st_v1; \
                        *(LAS bf16x8*)(K_lds + (bf) * SHM_K + kws) = st_k0; *(LAS bf16x8*)(K_lds + (bf) * SHM_K + kws + 32 * 256) = st_k1; } while (0)
#define TILE(t, BF) do { const int kb_ = KBASE(t); bool act_ = kb_ < qlo + QBLK - 1; if (SKIP) act_ = act_ && !__all(R == 0.0f); \
        if (act_) { f32x16 p0, p1; bf16x8 pa0, pa1, pa2, pa3; \
            qkt<BF>(p0, p1, K_lds, r32, hi, qr); \
            if (kb_ + KVBLK - 1 >= qlo) mask_tile(p0, p1, qm - kb_); \
            sb_half(p1, R, hi, pa2, pa3); sb_half(p0, R, hi, pa0, pa1); \
            pv_tile<BF>(o, vb0, pa0, pa1, pa2, pa3); } } while (0)
    SLOAD(0); asm volatile("s_waitcnt vmcnt(0)" ::: "memory"); SWRITE(0);
    if (SKIP) { if (tid < 16) flags[tid] = 0u; }
    __syncthreads();
    int t = 0;
    for (;;) {
        if (t + 1 < NT) SLOAD(t + 1);
        TILE(t, 0);
        if (SKIP) { if (lane == 0) flags[wid] = (__all(R == 0.0f) && KBASE(t) <= qlo) ? 1u : 0u; }
        if (t + 1 < NT) { asm volatile("s_waitcnt vmcnt(0)" ::: "memory"); SWRITE(1); }
        __syncthreads();
        ++t; if (t >= NT) break;
        if (SKIP) { unsigned all_ = 1u; for (int w = 0; w < 8; ++w) all_ &= flags[w]; if (all_) break; }
        if (t + 1 < NT) SLOAD(t + 1);
        TILE(t, 1);
        if (SKIP) { if (lane == 0) flags[8 + wid] = (__all(R == 0.0f) && KBASE(t) <= qlo) ? 1u : 0u; }
        if (t + 1 < NT) { asm volatile("s_waitcnt vmcnt(0)" ::: "memory"); SWRITE(0); }
        __syncthreads();
        ++t; if (t >= NT) break;
        if (SKIP) { unsigned all_ = 1u; for (int w = 0; w < 8; ++w) all_ &= flags[8 + w]; if (all_) break; }
    }
    bf16* odst = Oh + a_off<AB_TILED>(qlo + 4 * hi, ocol0 + r32, opitch);
#pragma unroll
    for (int r = 0; r < 16; ++r) { const int dt = (r & 3) + 8 * (r >> 2);
#pragma unroll
        for (int d0 = 0; d0 < 4; ++d0) { const float v = o[d0][r]; const float vn = __shfl_xor(v, 1);
            const size_t coff = AB_TILED == 2 ? (size_t)d0 * (256 * 32) : AB_TILED == 1 ? (size_t)(d0 >> 1) * (256 * 64) + (d0 & 1) * 32 : (size_t)d0 * 32;
            if ((r32 & 1) == 0) *(GAS unsigned*)(odst + (size_t)dt * a_rowstep<AB_TILED>(opitch) + coff) = cvtpk(v, vn); } }
    __syncthreads();
#undef KBASE
#undef SLOAD
#undef SWRITE
#undef TILE
}
#undef KSWZ
#undef SBAR
}
#ifndef ATT_SKIP
#define ATT_SKIP 1
#endif
__device__ __forceinline__ void attn_phase(Frame& F) {
    for (int p = F.vcu; p < NH * 16; p += F.G) {
        const int h = p >> 4, pi = p & 15;
        const bf16* Qh = F.QKV() + ((size_t)(0 * NH + h) * SEQ) * HD; const bf16* Kh = F.QKV() + ((size_t)(1 * NH + h) * SEQ) * HD; const bf16* Vh = F.QKV() + ((size_t)(2 * NH + h) * SEQ) * HD;
        sba::attn_unit<ATT_SKIP != 0>(Qh, Kh, Vh, F.AT(), h * HD, SBW, (31 - pi) * 256, (LAS char*)(F.lds + RING_OFF));
        sba::attn_unit<ATT_SKIP != 0>(Qh, Kh, Vh, F.AT(), h * HD, SBW, pi * 256, (LAS char*)(F.lds + RING_OFF));
    }
}
namespace gm {
typedef short bf16x8 __attribute__((ext_vector_type(8)));
typedef short s16x4 __attribute__((ext_vector_type(4)));
typedef float f32x16 __attribute__((ext_vector_type(16)));
constexpr int LDS_TILES = 0, LDS_STAT = 2 * sba::SHM_V;
__device__ __forceinline__ void gmlp_unit(Frame& F, int n, int q4, LAS char* lds) {
    const int tid = F.tid, wid = F.wave, lane = F.lane, r32 = lane & 31, hi = lane >> 5;
    const int row0 = n * 128;
    LAS float* st = (LAS float*)(lds + LDS_STAT);
    { const int row = tid >> 2, qtr = tid & 3; const GAS f32x4* pp = (const GAS f32x4*)(F.part() + ((size_t)(row0 + row) * 32 + qtr * 8) * 2);
      float s = 0.f, ss = 0.f;
#pragma unroll
      for (int j = 0; j < 4; ++j) { const f32x4 v = pp[j]; s += v.x + v.z; ss += v.y + v.w; }
      s += __shfl_xor(s, 1); ss += __shfl_xor(ss, 1); s += __shfl_xor(s, 2); ss += __shfl_xor(ss, 2);
      const float mean = s * (1.0f / GW), var = fmaxf(ss * (1.0f / GW) - mean * mean, 0.f);
      if (qtr == 0) { st[row] = mean; st[128 + row] = 1.0f / sqrtf(var + EPS); } }
    __syncthreads();
    const int tb = wid >> 1, nks = tb < 2 ? 4 : 8;
    const int vb = (int)(uintptr_t)(lds + LDS_TILES) + sba::v_rd_base(lane);
    const int cc = (tid & 15) * 8;
    const size_t zstep = (size_t)32 * a_rowstep<OUT_TILED>(DM);
    u32x4v raw[4];
    { const bf16* zsrc = F.GZ() + a_off<OUT_TILED>(row0 + (tid >> 4), GW + (4 * q4) * 128 + cc, DM);
#pragma unroll
      for (int it = 0; it < 4; ++it) raw[it] = *(const GAS u32x4v*)(zsrc + it * zstep); }
    for (int gi = 0; gi < 4; ++gi) { const int g = 4 * q4 + gi;
        const f32x4 g0 = *(const GAS f32x4*)(F.g_v + g * 128 + cc), g1 = *(const GAS f32x4*)(F.g_v + g * 128 + cc + 4);
        f32x4 wa[8], wb[8];
        { const float* wrow = F.w_s + ((size_t)g * 128 + 32 * tb + r32) * 128 + 8 * hi;
#pragma unroll
          for (int ks = 0; ks < 8; ++ks) { if (ks < nks) { wa[ks] = *(const GAS f32x4*)(wrow + 16 * ks); wb[ks] = *(const GAS f32x4*)(wrow + 16 * ks + 4); } else { wa[ks] = f32x4{}; wb[ks] = f32x4{}; } } }
        const int tbase = 32 * tb + 4 * hi;
        unsigned short uv[2][16]; float bs[16];
#pragma unroll
        for (int r = 0; r < 16; ++r) bs[r] = F.b_s[g * 128 + tbase + (r & 3) + 8 * (r >> 2)];
#pragma unroll
        for (int dd = 0; dd < 2; ++dd) { const bf16* usrc = F.GZ() + a_off<OUT_TILED>(row0 + tbase, g * 128 + (2 * (wid & 1) + dd) * 32 + r32, DM);
#pragma unroll
            for (int r = 0; r < 16; ++r) uv[dd][r] = usrc[(size_t)((r & 3) + 8 * (r >> 2)) * a_rowstep<OUT_TILED>(DM)]; }
#pragma unroll
        for (int it = 0; it < 4; ++it) { const int s = (it * 512 + tid) >> 4; const u32x4v rw = raw[it];
            const float mu = st[s], rs = st[128 + s];
            u32x4v w; w.x = pkbf((bflo(rw.x) - mu) * rs * g0.x, (bfhi(rw.x) - mu) * rs * g0.y); w.y = pkbf((bflo(rw.y) - mu) * rs * g0.z, (bfhi(rw.y) - mu) * rs * g0.w);
            w.z = pkbf((bflo(rw.z) - mu) * rs * g1.x, (bfhi(rw.z) - mu) * rs * g1.y); w.w = pkbf((bflo(rw.w) - mu) * rs * g1.z, (bfhi(rw.w) - mu) * rs * g1.w);
            *(LAS u32x4v*)(lds + LDS_TILES + (s >> 6) * sba::SHM_V + sba::v_st(s & 63, cc)) = w; }
        if (gi < 3) { const bf16* zsrc = F.GZ() + a_off<OUT_TILED>(row0 + (tid >> 4), GW + (g + 1) * 128 + cc, DM);
#pragma unroll
            for (int it = 0; it < 4; ++it) raw[it] = *(const GAS u32x4v*)(zsrc + it * zstep); }
        __syncthreads();
        bf16x8 afr[8];
#pragma unroll
        for (int ks = 0; ks < 8; ++ks) { u32x4v w = {pkbf(wa[ks].x, wa[ks].y), pkbf(wa[ks].z, wa[ks].w), pkbf(wb[ks].x, wb[ks].y), pkbf(wb[ks].z, wb[ks].w)}; afr[ks] = __builtin_bit_cast(bf16x8, w); }
#pragma unroll
        for (int dd = 0; dd < 2; ++dd) { const int d0 = 2 * (wid & 1) + dd; const int vbd = vb + d0 * 512;
            f32x16 acc = {};
#define GTR(dst, off) asm volatile("ds_read_b64_tr_b16 %0, %1 offset:%2" : "=&v"(dst) : "v"(vbd), "i"(off) : "memory")
#define GSTEP(ks) do { if ((ks) < nks) { s16x4 l, h; GTR(l, ((ks) >> 2) * sba::SHM_V + ((ks) & 3) * 4096); GTR(h, ((ks) >> 2) * sba::SHM_V + ((ks) & 3) * 4096 + 2048); \
                asm volatile("s_waitcnt lgkmcnt(0)" ::: "memory"); __builtin_amdgcn_sched_barrier(0); \
                acc = __builtin_amdgcn_mfma_f32_32x32x16_bf16(afr[ks], (bf16x8){l[0], l[1], l[2], l[3], h[0], h[1], h[2], h[3]}, acc, 0, 0, 0); } } while (0)
            GSTEP(0); GSTEP(1); GSTEP(2); GSTEP(3); GSTEP(4); GSTEP(5); GSTEP(6); GSTEP(7);
#undef GSTEP
#undef GTR
            bf16* odst = F.GA() + a_off<AB_TILED>(row0 + tbase, g * 128 + d0 * 32 + r32, GW);
#pragma unroll
            for (int r = 0; r < 16; ++r) { const int dt = (r & 3) + 8 * (r >> 2);
                const float y = acc[r] + bs[r];
                const float u = __builtin_bit_cast(float, (unsigned)uv[dd][r] << 16);
                const float v = u * y, vn = __shfl_xor(v, 1);
                if ((r32 & 1) == 0) *(GAS unsigned*)(odst + (size_t)dt * a_rowstep<AB_TILED>(GW)) = pkbf(v, vn); } }
        __syncthreads();
    }
}
__device__ __forceinline__ void gmlp_phase(Frame& F) {
    for (int u = F.vcu; u < (SEQ / 128) * 4; u += F.G) gmlp_unit(F, u >> 2, u & 3, (LAS char*)(F.lds + RING_OFF));
}
}
constexpr int N_PHASES = 11;
struct Args { const float* in[17]; float* out; unsigned char* ws; int ph_lo, ph_hi; };
__global__ void __launch_bounds__(NWAVES * 64, 2) fwd(Args args) {
    extern __shared__ __attribute__((aligned(16))) unsigned char lds[];
    Frame F;
    F.lds = (LAS unsigned char*)lds;
    F.MISC = (volatile LAS unsigned*)(F.lds + MISC_OFF);
    F.tid = threadIdx.x; F.lane = F.tid & 63; F.wave = __builtin_amdgcn_readfirstlane(F.tid >> 6);
    F.G = gridDim.x; { const int bx = blockIdx.x; F.vcu = (F.G % 8 == 0) ? (bx % 8) * (F.G / 8) + bx / 8 : bx; }
    unsigned char* ws = args.ws;
    F.ctl = (gu32*)(ws + WS_CTL);
    F.x = args.in[0]; F.c = args.in[1]; F.w_ada = args.in[2]; F.b_ada = args.in[3]; F.g_pre_mix = args.in[4]; F.w_in = args.in[5]; F.g_v = args.in[6]; F.w_s = args.in[7]; F.b_s = args.in[8];
    F.w_pa = args.in[9]; F.w_pb = args.in[10]; F.w_o = args.in[11]; F.g_post_mix = args.in[12]; F.g_pre_mlp = args.in[13]; F.w_ff1 = args.in[14]; F.w_ff2 = args.in[15]; F.g_post_mlp = args.in[16];
    F.out = args.out; F.ws = ws;
    for (int u = F.tid; u < (LDS_BYTES - LDSCTL_OFF) / 4; u += NWAVES * 64) ((LAS unsigned*)(F.lds + LDSCTL_OFF))[u] = 0u;
    __syncthreads();
    const int lo = args.ph_lo, hi = args.ph_hi;
    XcdBarrier bar; bar.bar = (unsigned*)(F.ctl + CW_BAR); bar.x = 0; bar.st = nullptr;
    if (hi - lo > 1) bar = xcd_barrier_post((unsigned*)(F.ctl + CW_BAR), F.MISC + 8);
#if OUT_TILED
#define EPI_T(a) pg8::EpiAct<a, OUT_TILED>
#define EPI_T0 , 0
#else
#define EPI_T(a) pg8::EpiAct<a, 0>
#define EPI_T0 , 0
#endif
#ifndef W_T1
#define W_T1 16
#endif
#ifndef W_T0
#define W_T0 1
#endif
#ifndef GEMV_LATE
#define GEMV_LATE 0
#endif
#ifndef W_FIRST
#define W_FIRST 0
#endif
#ifndef W_P4
#define W_P4 (WIN_SPLIT ? 70 : 6)
#endif
#ifndef W_P8
#define W_P8 32
#endif
#ifndef W_P5
#define W_P5 8
#endif
#ifndef W_P6
#define W_P6 0
#endif
#define W_P0 (63 & ~(W_T1) & ~(W_T0) & ~(W_P4) & ~(W_P8) & ~(W_P5) & ~(W_P6))
#ifndef FFN_MSPLIT
#define FFN_MSPLIT 0
#endif
#ifndef GATES_IN_P5
#define GATES_IN_P5 1
#endif
#ifndef GEMM_EPIOV
#define GEMM_EPIOV 0
#endif
#ifndef FF2_KREV
#define FF2_KREV 0
#endif
#ifndef GEMM_SPLIT
#define GEMM_SPLIT 0
#endif
#if GEMM_SPLIT
#define SPLIT_ORDER pg8::SplitOrder
#define SPLIT_INIT(S, M_, N_, G_, c_, ntk_) S.init(M_, N_, G_, c_, ntk_, (float*)(ws + WS_SPLIT) + (size_t)blockIdx.x * 65536)
#else
#define SPLIT_ORDER pg8::StaticOrder
#define SPLIT_INIT(S, M_, N_, G_, c_, ntk_) S.init(M_, N_, G_, c_)
#endif
#ifndef W_TILED
#define W_TILED 1
#endif
#ifndef MIXIN_TILED
#define MIXIN_TILED 2
#endif
#ifndef ACT_TILED
#define ACT_TILED 2
#endif
#ifndef GEMM_ALIGN
#define GEMM_ALIGN true
#endif
#ifndef GEMM_SP2
#define GEMM_SP2 true
#endif
#ifndef REP_G
#define REP_G 0
#endif
#if REP_G
#define GREP(i) , ((((REP_G) >> (i)) & 1) ? 2 : 1)
#else
#define GREP(i)
#endif
#ifndef REP_MASK
#define REP_MASK 0
#endif
#if REP_MASK
#define REPFOR(p) for (int rep_ = 0; rep_ < (((REP_MASK >> (p)) & 1) ? 2 : 1); ++rep_)
#else
#define REPFOR(p)
#endif
#ifndef PH_MASK
#define PH_MASK 0x7ff
#endif
#define IN(k) (((PH_MASK >> (k)) & 1) && lo <= (k) && (k) < hi)
#define BOTH(k) (IN(k) && IN((k) + 1))
#ifdef BAR_TWICE
#define GRID_BAR() do { xcd_barrier(bar); xcd_barrier(bar); } while (0)
#else
#define GRID_BAR() xcd_barrier(bar)
#endif
#ifndef P5_FUSED
#define P5_FUSED 1
#endif
#ifndef W_STAG
#define W_STAG 0
#endif
#ifndef TEAM_SEL
#define TEAM_SEL ((int)blockIdx.x >> 3)
#endif
#define TEAM_B(k) ((((W_STAG) >> (k)) & 1) && ((TEAM_SEL) & 1))
#ifndef SKEW_SHIFT
#define SKEW_SHIFT 1
#endif
#ifndef SKEW_TICKS
#define SKEW_TICKS 0
#endif
#define XCD_SKEW() do { if (SKEW_TICKS) { const unsigned long long t0_ = __builtin_amdgcn_s_memrealtime(), w_ = (unsigned long long)((blockIdx.x & 7) >> SKEW_SHIFT) * SKEW_TICKS; \
        while (__builtin_amdgcn_s_memrealtime() - t0_ < w_) __builtin_amdgcn_s_sleep(2); } } while (0)
#if MK_STAMP
    unsigned long long* const ts_ = (unsigned long long*)(ws + WS_END + 8192);
#define STAMP(k) do { if (blockIdx.x == 0 && F.tid == 0) ts_[k] = __builtin_amdgcn_s_memrealtime(); } while (0)
#else
#define STAMP(k) do { } while (0)
#endif
    STAMP(0);
    REPFOR(0)
    if (IN(0)) {
#if GEMV_LATE
        p0_gemv<0, 2 * DM>(F);
#else
        p0_gemv<0, 2 * DM>(F); p0_gemv<2 * DM, 4 * DM>(F);
#endif
#ifdef GEMV_REP
        p0_gemv<0, 2 * DM>(F); p0_gemv<2 * DM, 4 * DM>(F);
#endif
#ifdef WCONV_REP
        p0_weights<W_P0>(F);
#endif
        p0_weights<W_P0>(F); if (BOTH(0)) GRID_BAR(); }
    STAMP(1);
    REPFOR(1)
    if (IN(1)) {
#ifdef T0_REP
        _Pragma("unroll 1") for (int rep1 = 0; rep1 < T0_REP; ++rep1) { t0_rows(F); __syncthreads(); }
#endif
        if (W_T0 && W_FIRST) { p0_weights<W_T0>(F); __syncthreads(); } t0_rows(F); if (GEMV_LATE) { __syncthreads(); p0_gemv<2 * DM, 4 * DM>(F); } if (W_T0 && !W_FIRST) { __syncthreads(); p0_weights<W_T0>(F); } if (BOTH(1)) GRID_BAR(); }
    STAMP(2);
    REPFOR(2)
    if (IN(2)) { XCD_SKEW();
#if !GATES_IN_P5
        { pg8::Gemm g{F.H(), F.Win_t() + (size_t)(2 * GW + 3 * SBW) * DM, SEQ, 2 * DM, DM}; SPLIT_ORDER S; SPLIT_INIT(S, SEQ, 2 * DM, F.G, (int)blockIdx.x, DM / 64);
          EPI_T(3) E{F.SA(), 2 * DM EPI_T0};
          pg8::gemm_phase<EPI_T(3), SPLIT_ORDER, GEMM_ALIGN, GEMM_SP2, H_TILED, W_TILED != 0, false, false>(F.lds + RING_OFF, g, S, E); }
#endif
        { pg8::Gemm g{F.H(), F.Win_t() + (size_t)(2 * GW) * DM, SEQ, 3 * SBW, DM}; SPLIT_ORDER S; SPLIT_INIT(S, SEQ, 3 * SBW, F.G, (int)blockIdx.x, DM / 64);
          pg8::EpiQKV E{F.QKV(), SEQ, QSCALE};
          pg8::gemm_phase<pg8::EpiQKV, SPLIT_ORDER, GEMM_ALIGN, GEMM_SP2, H_TILED, W_TILED != 0, false, false>(F.lds + RING_OFF, g, S, E); }
        { pg8::Gemm g{F.H(), F.Win_t(), SEQ, GW, DM}; pg8::StaticOrder S; S.init(SEQ, GW, F.G, (int)blockIdx.x GREP(0));
          EPI_T(2) E{F.GZ(), DM EPI_T0};
          pg8::gemm_phase<EPI_T(2), pg8::StaticOrder, GEMM_ALIGN, GEMM_SP2, H_TILED, W_TILED != 0, false, false>(F.lds + RING_OFF, g, S, E); }
        { pg8::Gemm g{F.H(), F.Win_t() + (size_t)GW * DM, SEQ, GW, DM}; pg8::StaticOrder S; S.init(SEQ, GW, F.G, (int)blockIdx.x GREP(1));
          pg8::EpiGeluStats<OUT_TILED> E{F.GZ(), DM, GW / 256, F.part()};
          pg8::gemm_phase<pg8::EpiGeluStats<OUT_TILED>, pg8::StaticOrder, GEMM_ALIGN, GEMM_SP2, H_TILED, W_TILED != 0, false, false>(F.lds + RING_OFF, g, S, E); }
        if (BOTH(2)) GRID_BAR();
    }
#ifndef GMLP_FAST
#define GMLP_FAST 1
#endif
    STAMP(3);
    REPFOR(3)
    if (IN(3)) { if (!GMLP_FAST) { gmlp_stats_naive(F); if (BOTH(3)) GRID_BAR(); } }
#ifndef ATT_FAST
#define ATT_FAST 1
#endif
    STAMP(4);
    REPFOR(4)
    if (IN(4)) {
#ifdef P4_REP
        _Pragma("unroll 1") for (int rep4 = 0; rep4 < P4_REP; ++rep4) { if (P4_REP_WHAT & 1) gm::gmlp_phase(F); if (P4_REP_WHAT & 2) attn_phase(F); __syncthreads(); }
#endif
        if ((W_P4) != 0 && TEAM_B(4)) { p0_weights<W_P4>(F); __syncthreads(); }
        if (GMLP_FAST) gm::gmlp_phase(F); else gmlp_main_naive(F); if (ATT_FAST) attn_phase(F); else attn_naive(F); if ((W_P4) != 0 && !TEAM_B(4)) { __syncthreads(); p0_weights<W_P4>(F); } if (BOTH(4)) GRID_BAR(); }
    STAMP(5);
    REPFOR(5)
    if (IN(5)) { XCD_SKEW();
        if (W_P5 && TEAM_B(5)) { p0_weights<W_P5>(F); __syncthreads(); }
#if GATES_IN_P5
        { pg8::Gemm g{F.H(), F.Win_t() + (size_t)(2 * GW + 3 * SBW) * DM, SEQ, 2 * DM, DM}; pg8::GateOrder S; S.init(SEQ, DM, F.G, (int)blockIdx.x);
          EPI_T(3) E{F.SA(), 2 * DM EPI_T0};
          pg8::gemm_phase<EPI_T(3), pg8::GateOrder, GEMM_ALIGN, GEMM_SP2, H_TILED, W_TILED != 0, false, false>(F.lds + RING_OFF, g, S, E); }
#endif
#if P5_FUSED
        { pg8::Gemm g{F.GA(), F.Wpa_t(), SEQ, DM, GW}; pg8::DualOrder S; S.init(SEQ, DM, F.G, (int)blockIdx.x);
          pg8::EpiGateDual<MIXIN_TILED, OUT_TILED> E{F.SA(), 2 * DM, 0, DM / 256, F.MIXIN(), DM};
          pg8::gemm_phase<pg8::EpiGateDual<MIXIN_TILED, OUT_TILED>, pg8::DualOrder, GEMM_ALIGN, GEMM_SP2, AB_TILED, W_TILED != 0, false, false>(F.lds + RING_OFF, g, S, E, F.AT(), F.Wpb_t()); }
#else
        { pg8::Gemm g{F.GA(), F.Wpa_t(), SEQ, DM, GW}; pg8::StaticOrder S; S.init(SEQ, DM, F.G, (int)blockIdx.x GREP(4));
          pg8::EpiGate<true, MIXIN_TILED, OUT_TILED> E{F.SA(), 2 * DM, 0, F.MIXIN(), DM};
          pg8::gemm_phase<pg8::EpiGate<true, MIXIN_TILED, OUT_TILED>, pg8::StaticOrder, GEMM_ALIGN, GEMM_SP2, AB_TILED, W_TILED != 0, false, false>(F.lds + RING_OFF, g, S, E); }
        { pg8::Gemm g{F.AT(), F.Wpb_t(), SEQ, DM, SBW}; pg8::StaticOrder S; S.init(SEQ, DM, F.G, (int)blockIdx.x GREP(5));
          pg8::EpiGate<false, MIXIN_TILED, OUT_TILED> E{F.SA(), 2 * DM, DM / 256, F.MIXIN(), DM};
          pg8::gemm_phase<pg8::EpiGate<false, MIXIN_TILED, OUT_TILED>, pg8::StaticOrder, GEMM_ALIGN, GEMM_SP2, AB_TILED, W_TILED != 0, false, false>(F.lds + RING_OFF, g, S, E); }
#endif
        if (W_P5 && !TEAM_B(5)) { p0_weights<W_P5>(F); }
        if (BOTH(5)) GRID_BAR();
    }
    STAMP(6);
    REPFOR(6)
    if (IN(6)) { XCD_SKEW();
        if (W_P6 && TEAM_B(6)) { p0_weights<W_P6>(F); __syncthreads(); }
        pg8::Gemm g{F.MIXIN(), F.Wo_t(), SEQ, DM, DM}; pg8::StaticOrder S; S.init(SEQ, DM, F.G, (int)blockIdx.x GREP(6));
        EPI_T(0) E{F.MIX(), DM EPI_T0};
        pg8::gemm_phase<EPI_T(0), pg8::StaticOrder, GEMM_ALIGN, GEMM_SP2, MIXIN_TILED, W_TILED != 0, false, false>(F.lds + RING_OFF, g, S, E);
        if (W_P6 && !TEAM_B(6)) { p0_weights<W_P6>(F); }
        if (BOTH(6)) GRID_BAR();
    }
    STAMP(7);
    REPFOR(7)
    if (IN(7)) {
#ifdef T1_REP
        _Pragma("unroll 1") for (int rep7 = 0; rep7 < T1_REP; ++rep7) { t1_rows(F); __syncthreads(); }
#endif
        if (W_T1 && W_FIRST) { p0_weights<W_T1>(F); __syncthreads(); } t1_rows(F); if (W_T1 && !W_FIRST) { __syncthreads(); p0_weights<W_T1>(F); } if (BOTH(7)) GRID_BAR(); }
    STAMP(8);
    REPFOR(8)
#if FFN_MSPLIT
    if (IN(8) && IN(9)) {
        _Pragma("unroll") for (int mh = 0; mh < 2; ++mh) { const size_t r0 = (size_t)mh * (SEQ / 2);
            { pg8::Gemm g{F.H() + r0 * DM, F.Wf1_t(), SEQ / 2, DFF, DM}; pg8::StaticOrder S; S.init(SEQ / 2, DFF, F.G, (int)blockIdx.x);
              pg8::EpiActTiled<1> E{F.ACT() + r0 * DFF, DFF, 0};
              pg8::gemm_phase<pg8::EpiAct<1, ACT_TILED>, pg8::StaticOrder, GEMM_ALIGN, GEMM_SP2, H_TILED, W_TILED != 0, false, GEMM_EPIOV != 0>(F.lds + RING_OFF, g, S, E); }
            GRID_BAR();
            { pg8::Gemm g{F.ACT() + r0 * DFF, F.Wf2_t(), SEQ / 2, DM, DFF}; pg8::StaticOrder S; S.init(SEQ / 2, DM, F.G, (int)blockIdx.x);
              EPI_T(0) E{F.FF() + r0 * DM, DM EPI_T0};
              pg8::gemm_phase<EPI_T(0), pg8::StaticOrder, GEMM_ALIGN, GEMM_SP2, ACT_TILED, W_TILED != 0, false, false>(F.lds + RING_OFF, g, S, E); }
            GRID_BAR(); }
    }
#else
    if (IN(8)) { XCD_SKEW();
        if (W_P8 && TEAM_B(8)) { p0_weights<W_P8>(F); __syncthreads(); }
        pg8::Gemm g{F.H(), F.Wf1_t(), SEQ, DFF, DM}; SPLIT_ORDER S; SPLIT_INIT(S, SEQ, DFF, F.G, (int)blockIdx.x, DM / 64);
        #if ACT_TILED
        pg8::EpiAct<1, ACT_TILED> E{F.ACT(), DFF, 0};
        pg8::gemm_phase<pg8::EpiAct<1, ACT_TILED>, SPLIT_ORDER, GEMM_ALIGN, GEMM_SP2, H_TILED, W_TILED != 0, false, GEMM_EPIOV != 0>(F.lds + RING_OFF, g, S, E);
#else
        pg8::EpiAct<1, 0> E{F.ACT(), DFF, 0};
        pg8::gemm_phase<pg8::EpiAct<1, 0>, SPLIT_ORDER, GEMM_ALIGN, GEMM_SP2, H_TILED, W_TILED != 0, false, GEMM_EPIOV != 0>(F.lds + RING_OFF, g, S, E);
#endif
#ifdef W8_REP
        p0_weights<W_P8>(F); __syncthreads();
#endif
        if (W_P8 && !TEAM_B(8)) { p0_weights<W_P8>(F); }
        if (BOTH(8)) GRID_BAR();
    }
    STAMP(9);
    REPFOR(9)
#if MK_CLK
    unsigned long long clk_c0 = 0, clk_r0 = 0;
    if (blockIdx.x == 0 && F.tid == 0) { clk_c0 = __builtin_amdgcn_s_memtime(); clk_r0 = __builtin_amdgcn_s_memrealtime(); }
#endif
    if (IN(9)) { XCD_SKEW();
#ifdef HALF_CU_P9
        pg8::Gemm g{F.ACT(), F.Wf2_t(), SEQ, DM, DFF}; pg8::StaticOrder S; S.init(SEQ, DM, (blockIdx.x & 8) ? 1 : F.G / 2, (blockIdx.x & 8) ? 1000000 : (int)((blockIdx.x & 7) | ((blockIdx.x >> 4) << 3)));
#else
        pg8::Gemm g{F.ACT(), F.Wf2_t(), SEQ, DM, DFF}; pg8::StaticOrder S; S.init(SEQ, DM, F.G, (int)blockIdx.x GREP(8));
#endif
        EPI_T(0) E{F.FF(), DM EPI_T0};
        pg8::gemm_phase<EPI_T(0), pg8::StaticOrder, GEMM_ALIGN, GEMM_SP2, ACT_TILED, W_TILED != 0, FF2_KREV != 0, false>(F.lds + RING_OFF, g, S, E);
        if (BOTH(9)) GRID_BAR();
    }
#endif
    STAMP(10);
    REPFOR(10)
#if MK_CLK
    if (blockIdx.x == 0 && F.tid == 0) { const unsigned long long c1 = __builtin_amdgcn_s_memtime(), r1 = __builtin_amdgcn_s_memrealtime();
        ((unsigned long long*)(ws + WS_END + 8192))[0] = c1 - clk_c0; ((unsigned long long*)(ws + WS_END + 8192))[1] = r1 - clk_r0; }
#endif
    if (IN(10)) { t2_rows(F); }
    STAMP(11);
#undef IN
#undef BOTH
#undef GRID_BAR
}

extern "C" void kernel_launch(void* const* d_in, const int* in_sizes, int n_in, void* d_out, int out_size, void* d_ws, size_t ws_size, hipStream_t stream) {
    static int grid = 0;
    if (grid == 0) {
        if (n_in != 17 || out_size != SEQ * DM || ws_size < WS_END) { fprintf(stderr, "kernel_launch: unexpected shapes (n_in %d out %d ws %zu)\n", n_in, out_size, ws_size); grid = -1; return; }
        int dev = 0, cus = 0, per_cu = 0;
        if (hipGetDevice(&dev) != hipSuccess || hipDeviceGetAttribute(&cus, hipDeviceAttributeMultiprocessorCount, dev) != hipSuccess) { grid = -1; return; }
        if (hipFuncSetAttribute((const void*)fwd, hipFuncAttributeMaxDynamicSharedMemorySize, LDS_BYTES) != hipSuccess) { fprintf(stderr, "kernel_launch: hipFuncSetAttribute failed\n"); grid = -1; return; }
        if (hipOccupancyMaxActiveBlocksPerMultiprocessor(&per_cu, (const void*)fwd, NWAVES * 64, LDS_BYTES) != hipSuccess || per_cu < 1)
            fprintf(stderr, "kernel_launch: note: occupancy query reports %d workgroups per CU\n", per_cu);
        (void)hipGetLastError();
        grid = cus;
    }
    if (grid < 0) return;
    (void)hipMemsetAsync((char*)d_ws + WS_CTL, 0, CTL_ZERO_BYTES, stream);
    Args a{};
    for (int i = 0; i < 17; ++i) a.in[i] = (const float*)d_in[i];
    a.out = (float*)d_out; a.ws = (unsigned char*)d_ws;
#if MK_ONE_LAUNCH
    a.ph_lo = 0; a.ph_hi = N_PHASES;
    hipLaunchKernelGGL(fwd, dim3(grid), dim3(NWAVES * 64), LDS_BYTES, stream, a);
#if MK_CLK
    hipLaunchKernelGGL(clk_leak, dim3(1), dim3(1), 0, stream, a);
#endif
#if MK_STAMP
    hipLaunchKernelGGL(stamp_leak, dim3(SEQ * DM / 256), dim3(256), 0, stream, a);
#endif
#else
#if MK_DEBUG
    (void)hipMemsetAsync((char*)d_ws + WS_DBG, 0, 4096, stream);
#endif
    for (int p = 0; p < N_PHASES; ++p) { a.ph_lo = p; a.ph_hi = p + 1; hipLaunchKernelGGL(fwd, dim3(grid), dim3(NWAVES * 64), LDS_BYTES, stream, a);
#if MK_DEBUG
        static const int chk[N_PHASES][3] = {{1, 0, 0}, {2, 0, 0}, {3, 4, 5}, {0, 0, 0}, {0, 0, 0}, {8, 0, 0}, {9, 0, 0}, {13, 0, 0}, {11, 0, 0}, {12, 0, 0}, {14, 0, 0}};
        for (int q = 0; q < 3; ++q) if (chk[p][q]) { Args b = a; b.ph_lo = chk[p][q]; b.ph_hi = 0; hipLaunchKernelGGL(dbg_check, dim3(2048), dim3(64), 0, stream, b); }
#endif
    }
#if MK_DEBUG
    hipLaunchKernelGGL(dbg_leak, dim3(1), dim3(1), 0, stream, a);
#endif
#endif
}
```

```cpp
#include <hip/hip_runtime.h>
#include <cstdio>
#include <cstdint>
#ifndef PG8_WGM
#define PG8_WGM 8
#endif
namespace pg8 {
#define PG8_LAS __attribute__((address_space(3)))
typedef unsigned short bf16_t;
typedef short bf16x8 __attribute__((ext_vector_type(8)));
typedef float f32x4 __attribute__((ext_vector_type(4)));
typedef unsigned u32x4 __attribute__((ext_vector_type(4)));
constexpr int BM = 256, BK = 64, HALF = 128, HTB = HALF * BK * 2  , STAGE_BYTES = 8 * HTB, NXCD = 8, WGM = PG8_WGM;

__host__ __device__ __forceinline__ int lds_byte(int r, int c) { const int st = (r >> 4) * 2 + (c >> 5), rr = r & 15, cc = c & 31, ob = rr * 64 + cc * 2; return st * 1024 + (ob ^ (((ob >> 9) & 1) << 5)); }
__host__ __device__ __forceinline__ void stage_rc(int b, int& R, int& C) { const int st = b / 1024, sb = b % 1024, swz = sb ^ (((sb >> 9) & 1) << 5); R = (st >> 1) * 16 + swz / 64; C = (st & 1) * 32 + (swz % 64) / 2; }
__host__ __device__ __forceinline__ int perm32(int rho) { const int n = rho >> 4, i = rho & 15; return 8 * (i >> 2) + 4 * n + (i & 3); }

struct Unit { int pm, pn; int k0 = 0, nt = 0, mode = 0; };
struct Gemm { const bf16_t* A; const bf16_t* Bt; int M, N, K; };

struct StaticOrder {
    static constexpr bool SPLIT = false, DUAL = false;
    int nM, nN, nwg, G, c, rep;
    __host__ __device__ void init(int M, int N, int G_, int c_, int rep_ = 1) { nM = M / BM; nN = N / BM; nwg = nM * nN; G = G_; c = c_; rep = rep_; }
    __host__ __device__ bool next(int i, Unit& u) const {
        const long L = (long)i * G + c; if (L >= (long)nwg * rep) return false;
        int wgid = rep > 1 ? (int)(L % nwg) : (int)L; { const int q = nwg / NXCD, r = nwg % NXCD, xcd = wgid % NXCD, off = wgid / NXCD; wgid = (xcd < r ? xcd * (q + 1) : r * (q + 1) + (xcd - r) * q) + off; }
        const int nig = WGM * nN, gid = wgid / nig, fm = gid * WGM, gsz = (nM - fm) < WGM ? (nM - fm) : WGM;
        u.pm = fm + ((wgid % nig) % gsz); u.pn = (wgid % nig) / gsz; return true;
    }
    __device__ __forceinline__ void a_ready(const Unit&) const {}
    __device__ __forceinline__ void done(const Unit&) const {}
};
struct GateOrder : StaticOrder {
    static constexpr bool SPLIT = false, DUAL = false;
    int nNh;
    __host__ __device__ void init(int M, int N, int G_, int c_) { StaticOrder::init(M, N, G_, c_); nNh = N / BM; }
    __host__ __device__ bool next(int i, Unit& u) const { if (!StaticOrder::next(i >> 1, u)) return false; u.pn += (i & 1) * nNh; return true; }
};
struct DualOrder : StaticOrder {
    static constexpr bool SPLIT = false, DUAL = true;
    __host__ __device__ bool next(int i, Unit& u) const { if (!StaticOrder::next(i >> 1, u)) return false; u.mode = i & 1; return true; }
};
struct SplitOrder : StaticOrder {
    static constexpr bool SPLIT = true, DUAL = false;
    int d, R, ntk; float* part;
    __host__ __device__ void init(int M, int N, int G_, int c_, int ntk_, float* part_) { StaticOrder::init(M, N, G_, c_); ntk = ntk_; part = part_; R = nwg / G_;
        d = (nwg % G_ == 0 && ntk_ >= 16) ? (((c_ & 7) * ntk_ / 8) & ~1) : 0; }
    __host__ __device__ bool next(int i, Unit& u) const {
        if (d == 0) { if (!StaticOrder::next(i, u)) return false; u.k0 = 0; u.nt = ntk; u.mode = 0; return true; }
        if (i > R) return false;
        StaticOrder::next(i == R ? 0 : i, u);
        if (i == 0) { u.k0 = d; u.nt = ntk - d; u.mode = 1; } else if (i == R) { u.k0 = 0; u.nt = d; u.mode = 2; } else { u.k0 = 0; u.nt = ntk; u.mode = 0; }
        return true;
    }
};


typedef float f32x2_c __attribute__((ext_vector_type(2))); typedef __bf16 bf16x2_c __attribute__((ext_vector_type(2)));
__device__ __forceinline__ unsigned cvt_pk_bf16(float lo, float hi) { f32x2_c v = {lo, hi}; bf16x2_c b = __builtin_convertvector(v, bf16x2_c); return __builtin_bit_cast(unsigned, b); }
typedef float f32x2 __attribute__((ext_vector_type(2)));
__device__ __forceinline__ f32x2 gelu_pk(f32x2 v) {
    const f32x2 av = __builtin_elementwise_abs(v), d = av * 0.2316418882f + 1.0f;
    f32x2 t; t.x = __builtin_amdgcn_rcpf(d.x); t.y = __builtin_amdgcn_rcpf(d.y);
    f32x2 q = t * 0.5307027145f + (-0.7265760135f); q = q * t + 0.7107068705f; q = q * t + (-0.142248368f); q = q * t + 0.127414796f; q = q * t;
    const f32x2 s = (v * v) * (-0.72134752044f);
    f32x2 e; e.x = __builtin_amdgcn_exp2f(s.x); e.y = __builtin_amdgcn_exp2f(s.y);
    const f32x2 m = v * (q * e), r = v - m;
    f32x2 o; o.x = v.x < 0.f ? m.x : r.x; o.y = v.y < 0.f ? m.y : r.y; return o;
}
__device__ __forceinline__ float sigmoid_f(float x) { return __builtin_amdgcn_rcpf(1.0f + __builtin_amdgcn_exp2f(-1.4426950408889634f * x)); }
__device__ __forceinline__ float bf_lo(unsigned u) { return __builtin_bit_cast(float, u << 16); }
__device__ __forceinline__ float bf_hi(unsigned u) { return __builtin_bit_cast(float, u & 0xffff0000u); }

template <int LAY> __device__ __forceinline__ size_t tile_base(int pm, int pn, int N, int wr, int wc, int fr, int fq) {
    if (LAY == 1) return (((size_t)pm * (N / 64) + pn * 4 + (wc >> 1)) * BM + wr * 64 + fr) * 64 + (wc & 1) * 32 + 8 * fq;
    if (LAY == 2) return (((size_t)pm * (N / 32) + pn * 8 + wc) * BM + wr * 64 + fr) * 32 + 8 * fq;
    return (size_t)(pm * BM + wr * 64 + fr) * N + (size_t)pn * BM + wc * 32 + 8 * fq;
}
template <int LAY> __device__ __forceinline__ size_t tile_rowstep(int N) { return LAY == 1 ? (size_t)64 : LAY == 2 ? (size_t)32 : (size_t)N; }
template <int LAY> __device__ __forceinline__ size_t tile_bjstep() { return LAY == 0 ? (size_t)HALF : (size_t)(2 * BM * 64); }

template <int ACT> __device__ __forceinline__ void epi_store_tile(const f32x4 (&acc)[2][2][4][2], bf16_t* base, size_t ld, size_t bjstride, int row0, int c8, float scale) {
#ifdef EPI_BJ_OUTER
#pragma unroll
    for (int bj = 0; bj < 2; ++bj)
#pragma unroll
    for (int ai = 0; ai < 2; ++ai)
#pragma unroll
        for (int m = 0; m < 4; ++m) { bf16_t* rowp = base + (size_t)(row0 + ai * HALF + m * 16) * ld + c8; {
#else
#pragma unroll
    for (int ai = 0; ai < 2; ++ai)
#pragma unroll
        for (int m = 0; m < 4; ++m) { bf16_t* rowp = base + (size_t)(row0 + ai * HALF + m * 16) * ld + c8;
#pragma unroll
            for (int bj = 0; bj < 2; ++bj) {
#endif
                f32x4 v0 = acc[ai][bj][m][0], v1 = acc[ai][bj][m][1];
                if (ACT == 1) {
#pragma unroll
                    for (int e = 0; e < 4; ++e) { const float a = fmaxf(v0[e], 0.f), b = fmaxf(v1[e], 0.f); v0[e] = a * a; v1[e] = b * b; } }
                if (ACT == 2) { f32x2 a = gelu_pk((f32x2){v0[0], v0[1]}), b = gelu_pk((f32x2){v0[2], v0[3]}), c = gelu_pk((f32x2){v1[0], v1[1]}), d = gelu_pk((f32x2){v1[2], v1[3]});
                    v0 = (f32x4){a.x, a.y, b.x, b.y}; v1 = (f32x4){c.x, c.y, d.x, d.y}; }
                if (ACT == 3) {
#pragma unroll
                    for (int e = 0; e < 4; ++e) { v0[e] = sigmoid_f(v0[e]); v1[e] = sigmoid_f(v1[e]); } }
                if (ACT == 4) { v0 = v0 * scale; v1 = v1 * scale; }
                u32x4 w; w.x = cvt_pk_bf16(v0[0], v0[1]); w.y = cvt_pk_bf16(v0[2], v0[3]); w.z = cvt_pk_bf16(v1[0], v1[1]); w.w = cvt_pk_bf16(v1[2], v1[3]);
                *(u32x4*)(rowp + bj * bjstride) = w;
                } }
}
template <int ACT> __device__ __forceinline__ void epi_store_tile_buf(const f32x4 (&acc)[2][2][4][2], __amdgpu_buffer_rsrc_t rsrc, unsigned voff0, unsigned ld2, unsigned bj2) {
#pragma unroll
    for (int ai = 0; ai < 2; ++ai)
#pragma unroll
        for (int m = 0; m < 4; ++m) {
#pragma unroll
            for (int bj = 0; bj < 2; ++bj) { f32x4 v0 = acc[ai][bj][m][0], v1 = acc[ai][bj][m][1];
                if (ACT == 1) {
#pragma unroll
                    for (int e = 0; e < 4; ++e) { const float a = fmaxf(v0[e], 0.f), b = fmaxf(v1[e], 0.f); v0[e] = a * a; v1[e] = b * b; } }
                if (ACT == 2) { f32x2 a = gelu_pk((f32x2){v0[0], v0[1]}), b = gelu_pk((f32x2){v0[2], v0[3]}), c = gelu_pk((f32x2){v1[0], v1[1]}), d = gelu_pk((f32x2){v1[2], v1[3]});
                    v0 = (f32x4){a.x, a.y, b.x, b.y}; v1 = (f32x4){c.x, c.y, d.x, d.y}; }
                if (ACT == 3) {
#pragma unroll
                    for (int e = 0; e < 4; ++e) { v0[e] = sigmoid_f(v0[e]); v1[e] = sigmoid_f(v1[e]); } }
                u32x4 w; w.x = cvt_pk_bf16(v0[0], v0[1]); w.y = cvt_pk_bf16(v0[2], v0[3]); w.z = cvt_pk_bf16(v1[0], v1[1]); w.w = cvt_pk_bf16(v1[2], v1[3]);
                __builtin_amdgcn_raw_buffer_store_b128(w, rsrc, voff0 + (unsigned)(ai * HALF + m * 16) * ld2 + (unsigned)bj * bj2, 0, 0); } }
}
template <int ACT, int LAY = 0> struct EpiAct {
    static constexpr bool PERM = true, AFTER_DRAIN = false, IDEM = true;
    bf16_t* O; int N; int pn_off;
    __device__ __forceinline__ void operator()(const f32x4 (&acc)[2][2][4][2], const Unit& u, int wr, int wc, int fr, int fq) const {
#ifdef EPI_BUFSTORE
        const __amdgpu_buffer_rsrc_t rsrc = __builtin_amdgcn_make_buffer_rsrc((void*)O, 0, 0x7ffffff0, 0x00020000);
        epi_store_tile_buf<ACT>(acc, rsrc, (unsigned)(tile_base<LAY>(u.pm, u.pn + pn_off, N, wr, wc, fr, fq) * 2), (unsigned)(tile_rowstep<LAY>(N) * 2), (unsigned)(tile_bjstep<LAY>() * 2));
#else
        epi_store_tile<ACT>(acc, O + tile_base<LAY>(u.pm, u.pn + pn_off, N, wr, wc, fr, fq), tile_rowstep<LAY>(N), tile_bjstep<LAY>(), 0, 0, 1.f);
#endif
    }
};
struct EpiQKV {
    static constexpr bool PERM = true, AFTER_DRAIN = false, IDEM = true;
    bf16_t* QKV; int M; float qscale;
    __device__ __forceinline__ void operator()(const f32x4 (&acc)[2][2][4][2], const Unit& u, int wr, int wc, int fr, int fq) const {
        const int t = u.pn >> 3, hp = u.pn & 7;
        epi_store_tile<4>(acc, QKV + (size_t)(t * 16 + 2 * hp) * M * 128, 128, (size_t)M * 128, u.pm * BM + wr * 64 + fr, wc * 32 + 8 * fq, t == 0 ? qscale : 1.f);
    }
};
template <int LAY = 0> struct EpiGeluStats {
    static constexpr bool PERM = true, AFTER_DRAIN = false, IDEM = true;
    bf16_t* O; int ldc; int pn_off; float* part;
    __device__ __forceinline__ void operator()(const f32x4 (&acc)[2][2][4][2], const Unit& u, int wr, int wc, int fr, int fq) const {
        const int row0 = u.pm * BM + wr * 64 + fr;
        bf16_t* base = O + tile_base<LAY>(u.pm, u.pn + pn_off, ldc, wr, wc, fr, fq);
        const size_t trow = tile_rowstep<LAY>(ldc), tbj = tile_bjstep<LAY>();
#pragma unroll
        for (int ai = 0; ai < 2; ++ai)
#pragma unroll
            for (int m = 0; m < 4; ++m) { const int row = row0 + ai * HALF + m * 16; bf16_t* rowp = base + (size_t)(ai * HALF + m * 16) * trow; float s = 0.f, ss = 0.f;
#pragma unroll
                for (int bj = 0; bj < 2; ++bj) { const f32x4 v0 = acc[ai][bj][m][0], v1 = acc[ai][bj][m][1];
                    const f32x2 a = gelu_pk((f32x2){v0[0], v0[1]}), b = gelu_pk((f32x2){v0[2], v0[3]}), c = gelu_pk((f32x2){v1[0], v1[1]}), d = gelu_pk((f32x2){v1[2], v1[3]});
                    s += ((a.x + a.y) + (b.x + b.y)) + ((c.x + c.y) + (d.x + d.y));
                    ss += ((a.x * a.x + a.y * a.y) + (b.x * b.x + b.y * b.y)) + ((c.x * c.x + c.y * c.y) + (d.x * d.x + d.y * d.y));
                    u32x4 w; w.x = cvt_pk_bf16(a.x, a.y); w.y = cvt_pk_bf16(b.x, b.y); w.z = cvt_pk_bf16(c.x, c.y); w.w = cvt_pk_bf16(d.x, d.y);
                    *(u32x4*)(rowp + bj * tbj) = w; }
                s += __shfl_xor(s, 16); ss += __shfl_xor(ss, 16); s += __shfl_xor(s, 32); ss += __shfl_xor(ss, 32);
                if (fq == 0) *(f32x2*)(part + (((size_t)row * 8 + u.pn) * 4 + wc) * 2) = (f32x2){s, ss}; }
    }
};
template <bool FIRST, int TLAY = 0, int GLAY = 0> struct EpiGate {
    static constexpr bool PERM = true, AFTER_DRAIN = false, IDEM = FIRST;
    const bf16_t* G; int ldg; int gpn; bf16_t* T; int ldc;
    __device__ __forceinline__ void operator()(const f32x4 (&acc)[2][2][4][2], const Unit& u, int wr, int wc, int fr, int fq) const {
        const size_t tbase = tile_base<TLAY>(u.pm, u.pn, ldc, wr, wc, fr, fq), trow = tile_rowstep<TLAY>(ldc), tbj = tile_bjstep<TLAY>();
        const size_t gbase = tile_base<GLAY>(u.pm, u.pn + gpn, ldg, wr, wc, fr, fq), grow = tile_rowstep<GLAY>(ldg), gbj = tile_bjstep<GLAY>();
#pragma unroll
        for (int ai = 0; ai < 2; ++ai)
#pragma unroll
            for (int m = 0; m < 4; ++m) { const size_t off = tbase + (size_t)(ai * HALF + m * 16) * trow, goff = gbase + (size_t)(ai * HALF + m * 16) * grow;
#pragma unroll
                for (int bj = 0; bj < 2; ++bj) { const u32x4 g = *(const u32x4*)(G + goff + bj * gbj);
                    const f32x4 a0 = acc[ai][bj][m][0], a1 = acc[ai][bj][m][1];
                    float o[8] = {a0[0] * bf_lo(g.x), a0[1] * bf_hi(g.x), a0[2] * bf_lo(g.y), a0[3] * bf_hi(g.y), a1[0] * bf_lo(g.z), a1[1] * bf_hi(g.z), a1[2] * bf_lo(g.w), a1[3] * bf_hi(g.w)};
                    if (!FIRST) { const u32x4 p = *(const u32x4*)(T + off + bj * tbj);
                        o[0] += bf_lo(p.x); o[1] += bf_hi(p.x); o[2] += bf_lo(p.y); o[3] += bf_hi(p.y); o[4] += bf_lo(p.z); o[5] += bf_hi(p.z); o[6] += bf_lo(p.w); o[7] += bf_hi(p.w); }
                    u32x4 w; w.x = cvt_pk_bf16(o[0], o[1]); w.y = cvt_pk_bf16(o[2], o[3]); w.z = cvt_pk_bf16(o[4], o[5]); w.w = cvt_pk_bf16(o[6], o[7]);
                    *(u32x4*)(T + off + bj * tbj) = w; } }
    }
};
template <int TLAY = 0, int GLAY = 0> struct EpiGateDual {
    static constexpr bool PERM = true, AFTER_DRAIN = false, IDEM = false;
    const bf16_t* G; int ldg; int gpn_a, gpn_b; bf16_t* T; int ldc;
    static __device__ __forceinline__ float safe(float g) { return fmaxf(g, 8.673617379884035e-19f); }
    __device__ __forceinline__ void mid(f32x4 (&acc)[2][2][4][2], const Unit& u, int wr, int wc, int fr, int fq) const {
        const size_t ga0 = tile_base<GLAY>(u.pm, u.pn + gpn_a, ldg, wr, wc, fr, fq), gb0 = tile_base<GLAY>(u.pm, u.pn + gpn_b, ldg, wr, wc, fr, fq), grow = tile_rowstep<GLAY>(ldg), gbj = tile_bjstep<GLAY>();
#pragma unroll
        for (int ai = 0; ai < 2; ++ai)
#pragma unroll
            for (int m = 0; m < 4; ++m) { const size_t ro = (size_t)(ai * HALF + m * 16) * grow;
#pragma unroll
                for (int bj = 0; bj < 2; ++bj) { const u32x4 a = *(const u32x4*)(G + ga0 + ro + bj * gbj), b = *(const u32x4*)(G + gb0 + ro + bj * gbj);
                    f32x4& a0 = acc[ai][bj][m][0]; f32x4& a1 = acc[ai][bj][m][1];
                    a0[0] *= bf_lo(a.x) * __builtin_amdgcn_rcpf(safe(bf_lo(b.x))); a0[1] *= bf_hi(a.x) * __builtin_amdgcn_rcpf(safe(bf_hi(b.x)));
                    a0[2] *= bf_lo(a.y) * __builtin_amdgcn_rcpf(safe(bf_lo(b.y))); a0[3] *= bf_hi(a.y) * __builtin_amdgcn_rcpf(safe(bf_hi(b.y)));
                    a1[0] *= bf_lo(a.z) * __builtin_amdgcn_rcpf(safe(bf_lo(b.z))); a1[1] *= bf_hi(a.z) * __builtin_amdgcn_rcpf(safe(bf_hi(b.z)));
                    a1[2] *= bf_lo(a.w) * __builtin_amdgcn_rcpf(safe(bf_lo(b.w))); a1[3] *= bf_hi(a.w) * __builtin_amdgcn_rcpf(safe(bf_hi(b.w))); } }
    }
    __device__ __forceinline__ void operator()(const f32x4 (&acc)[2][2][4][2], const Unit& u, int wr, int wc, int fr, int fq) const {
        const size_t tbase = tile_base<TLAY>(u.pm, u.pn, ldc, wr, wc, fr, fq), trow = tile_rowstep<TLAY>(ldc), tbj = tile_bjstep<TLAY>();
        const size_t gb0 = tile_base<GLAY>(u.pm, u.pn + gpn_b, ldg, wr, wc, fr, fq), grow = tile_rowstep<GLAY>(ldg), gbj = tile_bjstep<GLAY>();
#pragma unroll
        for (int ai = 0; ai < 2; ++ai)
#pragma unroll
            for (int m = 0; m < 4; ++m) { const size_t off = tbase + (size_t)(ai * HALF + m * 16) * trow, goff = gb0 + (size_t)(ai * HALF + m * 16) * grow;
#pragma unroll
                for (int bj = 0; bj < 2; ++bj) { const u32x4 g = *(const u32x4*)(G + goff + bj * gbj);
                    const f32x4 a0 = acc[ai][bj][m][0], a1 = acc[ai][bj][m][1];
                    u32x4 w; w.x = cvt_pk_bf16(a0[0] * safe(bf_lo(g.x)), a0[1] * safe(bf_hi(g.x))); w.y = cvt_pk_bf16(a0[2] * safe(bf_lo(g.y)), a0[3] * safe(bf_hi(g.y)));
                    w.z = cvt_pk_bf16(a1[0] * safe(bf_lo(g.z)), a1[1] * safe(bf_hi(g.z))); w.w = cvt_pk_bf16(a1[2] * safe(bf_lo(g.w)), a1[3] * safe(bf_hi(g.w)));
                    *(u32x4*)(T + off + bj * tbj) = w; } }
    }
};
template <class Epi, class Sched, bool ALIGN_EPI = false, bool SP2 = false, int ATILED = 0, bool BTILED = false, bool KREV = false, bool EPI_OVERLAP = false>
__device__ __forceinline__ void gemm_phase(PG8_LAS unsigned char* lds, const Gemm g, const Sched& S, const Epi& E, const bf16_t* A2 = nullptr, const bf16_t* Bt2 = nullptr) {
    const int tid = threadIdx.x, wid = __builtin_amdgcn_readfirstlane(tid >> 6), lane = tid & 63, wr = wid >> 2, wc = wid & 3, fr = lane & 15, fq = lane >> 4;
    const int K = g.K, nt_full = K / BK;
    unsigned voffA[2], voffB[2];
#pragma unroll
    for (int i = 0; i < 2; ++i) { int R, C; stage_rc(tid * 16 + i * 8192, R, C); const int Rb = Epi::PERM ? ((R & ~31) + perm32(R & 31)) : R;
        voffA[i] = ATILED == 2 ? (unsigned)(((C >> 5) * BM + R) * 32 + (C & 31)) * 2u : (unsigned)(R * (ATILED ? BK : K) + C) * 2u; voffB[i] = (unsigned)(Rb * (BTILED ? BK : K) + C) * 2u; }
    const size_t kstep = (size_t)(BK * 2);
    const size_t hstep = (size_t)HALF * K * 2;
    const size_t tstep = 2 * hstep;
    const ptrdiff_t kstepA = (KREV ? -1 : 1) * (ptrdiff_t)(ATILED ? (size_t)BM * BK * 2 : kstep); const size_t hstepA = ATILED == 2 ? (size_t)HALF * 32 * 2 : ATILED ? (size_t)HALF * BK * 2 : hstep;
    const ptrdiff_t kstepB = (KREV ? -1 : 1) * (ptrdiff_t)(BTILED ? (size_t)BM * BK * 2 : kstep); const size_t hstepB = BTILED ? (size_t)HALF * BK * 2 : hstep;
    const ptrdiff_t krevA = KREV ? -(ptrdiff_t)(nt_full - 1) * kstepA : 0, krevB = KREV ? -(ptrdiff_t)(nt_full - 1) * kstepB : 0;
    const unsigned ldsw = (unsigned)wid * 1024u;
    const int aoff = lds_byte(wr * 64 + fr, fq * 8), boff = lds_byte(wc * 32 + fr, fq * 8);
#define PG8_SA(b, h) (((b) * 2 + (h)) * HTB)
#define PG8_SB(b, h) ((4 + (b) * 2 + (h)) * HTB)
#ifndef AUX_A
#define AUX_A 0
#endif
#ifndef AUX_B
#define AUX_B 0
#endif
#define PG8_STAGE(bufoff, gbase, voff, aux) do { _Pragma("unroll") for (int _i = 0; _i < 2; ++_i) \
        __builtin_amdgcn_global_load_lds((const unsigned*)((const char*)(gbase) + (voff)[_i]), (PG8_LAS unsigned*)(lds + (bufoff) + ldsw + _i * 8192), 16, 0, aux); } while (0)
#define PG8_LDA(dst, b, h) do { _Pragma("unroll") for (int m = 0; m < 4; ++m) _Pragma("unroll") for (int k = 0; k < 2; ++k) dst[m][k] = *(const PG8_LAS bf16x8*)(lds + PG8_SA(b, h) + aoff + m * 2048 + k * 1024); } while (0)
#define PG8_LDB(dst, b, h) do { _Pragma("unroll") for (int n = 0; n < 2; ++n) _Pragma("unroll") for (int k = 0; k < 2; ++k) dst[n][k] = *(const PG8_LAS bf16x8*)(lds + PG8_SB(b, h) + boff + n * 2048 + k * 1024); } while (0)
#ifdef NO_SETPRIO
#define PG8_PRIO(x)
#else
#define PG8_PRIO(x) __builtin_amdgcn_s_setprio(x)
#endif
#ifndef MMA_PRIO
#define MMA_PRIO 1
#endif
#ifndef BASE_PRIO
#define BASE_PRIO 0
#endif
#define PG8_MMA(ai, bj, At, Bt) do { PG8_PRIO(MMA_PRIO); _Pragma("unroll") for (int m = 0; m < 4; ++m) _Pragma("unroll") for (int n = 0; n < 2; ++n) _Pragma("unroll") for (int k = 0; k < 2; ++k) \
        acc[ai][bj][m][n] = __builtin_amdgcn_mfma_f32_16x16x32_bf16(Bt[n][k], At[m][k], acc[ai][bj][m][n], 0, 0, 0); PG8_PRIO(BASE_PRIO); } while (0)
#ifndef MMA_HOIST
#define MMA_HOIST 0
#endif
#define PG8_MMA_R(ai, bj, At, Bt, m0, m1) do { PG8_PRIO(MMA_PRIO); _Pragma("unroll") for (int m = (m0); m < (m1); ++m) _Pragma("unroll") for (int n = 0; n < 2; ++n) _Pragma("unroll") for (int k = 0; k < 2; ++k) \
        acc[ai][bj][m][n] = __builtin_amdgcn_mfma_f32_16x16x32_bf16(Bt[n][k], At[m][k], acc[ai][bj][m][n], 0, 0, 0); PG8_PRIO(BASE_PRIO); } while (0)
#define PG8_WAIT_V(n) asm volatile("s_waitcnt vmcnt(" #n ")" ::: "memory")
#define PG8_WAIT_L(n) asm volatile("s_waitcnt lgkmcnt(" #n ")" ::: "memory")
#define PG8_BAR __builtin_amdgcn_s_barrier()
#define PG8_SCHED __builtin_amdgcn_sched_barrier(0)
    Unit cur, nxt; int ui = 0;
    if (!S.next(0, cur)) return;
    f32x4 acc[2][2][4][2];
#pragma unroll
    for (int a = 0; a < 2; ++a)
#pragma unroll
        for (int b = 0; b < 2; ++b)
#pragma unroll
            for (int m = 0; m < 4; ++m)
#pragma unroll
                for (int n = 0; n < 2; ++n) acc[a][b][m][n] = (f32x4){0.f, 0.f, 0.f, 0.f};
    bf16x8 At[4][2], B0[2][2], B1[2][2];
    int nt = nt_full; if constexpr (Sched::SPLIT) nt = cur.nt;
    const char* cA = (const char*)g.A + (size_t)cur.pm * tstep + krevA; const char* cB = (const char*)g.Bt + (size_t)cur.pn * tstep + krevB;
    if constexpr (Sched::SPLIT) { cA += (ptrdiff_t)cur.k0 * kstepA; cB += (ptrdiff_t)cur.k0 * kstepB; }
    S.a_ready(cur);
    if constexpr (SP2) {
        PG8_STAGE(PG8_SB(0, 0), cB, voffB, AUX_B); PG8_STAGE(PG8_SB(0, 1), cB + hstepB, voffB, AUX_B); PG8_STAGE(PG8_SA(0, 0), cA, voffA, AUX_A); PG8_STAGE(PG8_SA(0, 1), cA + hstepA, voffA, AUX_A);
        if (wr == 1) PG8_BAR;
        PG8_WAIT_V(2); PG8_BAR;
        PG8_STAGE(PG8_SB(1, 0), cB + kstepB, voffB, AUX_B); PG8_STAGE(PG8_SA(1, 0), cA + kstepA, voffA, AUX_A); PG8_STAGE(PG8_SB(1, 1), cB + hstepB + kstepB, voffB, AUX_B);
        PG8_WAIT_V(6); PG8_BAR;
    } else {
        PG8_STAGE(PG8_SB(0, 0), cB, voffB, AUX_B); PG8_STAGE(PG8_SA(0, 0), cA, voffA, AUX_A); PG8_STAGE(PG8_SB(0, 1), cB + hstepB, voffB, AUX_B); PG8_STAGE(PG8_SA(0, 1), cA + hstepA, voffA, AUX_A);
        if (wr == 1) PG8_BAR;
        PG8_WAIT_V(4); PG8_BAR;
        PG8_STAGE(PG8_SB(1, 0), cB + kstepB, voffB, AUX_B); PG8_STAGE(PG8_SA(1, 0), cA + kstepA, voffA, AUX_A); PG8_STAGE(PG8_SB(1, 1), cB + hstepB + kstepB, voffB, AUX_B);
        PG8_WAIT_V(6); PG8_BAR;
    }
    for (;;) {
        const bool has_next = S.next(ui + 1, nxt);
        const char* nA = has_next ? (const char*)g.A + (size_t)nxt.pm * tstep + krevA : cA; const char* nB = has_next ? (const char*)g.Bt + (size_t)nxt.pn * tstep + krevB : cB;
        if constexpr (Sched::DUAL) { if (has_next && nxt.mode) { nA = (const char*)A2 + (size_t)nxt.pm * tstep + krevA; nB = (const char*)Bt2 + (size_t)nxt.pn * tstep + krevB; } }
        if constexpr (Sched::SPLIT) { if (has_next) { nA += (ptrdiff_t)nxt.k0 * kstepA; nB += (ptrdiff_t)nxt.k0 * kstepB; } }
        int t_first = 0;
        if constexpr (SP2 && EPI_OVERLAP) { if (ui > 0) {
            const int t = 0; const bool last = false;

#ifdef KWRAP_PROBE
#define PG8_KT(x) ((x) & 7)
#else
#define PG8_KT(x) (x)
#endif
            const char* a1 = cA + (ptrdiff_t)PG8_KT(t + 1) * kstepA;
            const char* a2 = last ? nA : cA + (ptrdiff_t)PG8_KT(t + 2) * kstepA; const char* b2 = last ? nB : cB + (ptrdiff_t)PG8_KT(t + 2) * kstepB;
            const char* a3 = last ? a2 + kstepA : cA + (ptrdiff_t)PG8_KT(t + 3) * kstepA; const char* b3 = last ? b2 + kstepB : cB + (ptrdiff_t)PG8_KT(t + 3) * kstepB;
            PG8_LDB(B0, 0, 0); PG8_LDB(B1, 0, 1); PG8_SCHED; PG8_LDA(At, 0, 0);
            PG8_WAIT_V(24); PG8_WAIT_L(0); PG8_BAR; PG8_MMA(0, 0, At, B0); PG8_MMA(0, 1, At, B1); PG8_BAR; PG8_SCHED;
            PG8_LDA(At, 0, 1); PG8_STAGE(PG8_SB(0, 0), b2, voffB, AUX_B); PG8_STAGE(PG8_SB(0, 1), b2 + hstepB, voffB, AUX_B); PG8_STAGE(PG8_SA(0, 0), a2, voffA, AUX_A);
            PG8_WAIT_V(24); PG8_WAIT_L(0); PG8_BAR; PG8_MMA(1, 0, At, B0); PG8_MMA(1, 1, At, B1); PG8_BAR; PG8_SCHED;
            PG8_LDB(B0, 1, 0); PG8_LDB(B1, 1, 1); PG8_SCHED; PG8_LDA(At, 1, 0); PG8_STAGE(PG8_SA(0, 1), a2 + hstepA, voffA, AUX_A);
            PG8_WAIT_V(24); PG8_WAIT_L(0); PG8_BAR; PG8_MMA(0, 0, At, B0); PG8_MMA(0, 1, At, B1); PG8_BAR; PG8_SCHED;
            PG8_LDA(At, 1, 1); PG8_STAGE(PG8_SB(1, 0), b3, voffB, AUX_B); PG8_STAGE(PG8_SB(1, 1), b3 + hstepB, voffB, AUX_B); PG8_STAGE(PG8_SA(1, 0), a3, voffA, AUX_A);
            PG8_WAIT_V(8); PG8_WAIT_L(0); PG8_BAR; PG8_MMA(1, 0, At, B0); PG8_MMA(1, 1, At, B1); PG8_BAR; PG8_SCHED;
            t_first = 2; } }
        for (int t = t_first; t < nt; t += 2) {
            const bool last = (t == nt - 2);
#ifdef KWRAP_PROBE
#define PG8_KT(x) ((x) & 7)
#else
#define PG8_KT(x) (x)
#endif
            const char* a1 = cA + (ptrdiff_t)PG8_KT(t + 1) * kstepA;
            const char* a2 = last ? nA : cA + (ptrdiff_t)PG8_KT(t + 2) * kstepA; const char* b2 = last ? nB : cB + (ptrdiff_t)PG8_KT(t + 2) * kstepB;
            const char* a3 = last ? a2 + kstepA : cA + (ptrdiff_t)PG8_KT(t + 3) * kstepA; const char* b3 = last ? b2 + kstepB : cB + (ptrdiff_t)PG8_KT(t + 3) * kstepB;
            if (last && has_next) S.a_ready(nxt);
            if constexpr (SP2) {
            PG8_LDB(B0, 0, 0); PG8_LDB(B1, 0, 1); PG8_SCHED; PG8_LDA(At, 0, 0); PG8_STAGE(PG8_SA(1, 1), a1 + hstepA, voffA, AUX_A);
            PG8_WAIT_V(8); PG8_WAIT_L(0); PG8_BAR; PG8_MMA(0, 0, At, B0); PG8_MMA(0, 1, At, B1); PG8_BAR; PG8_SCHED;
            PG8_LDA(At, 0, 1); PG8_STAGE(PG8_SB(0, 0), b2, voffB, AUX_B); PG8_STAGE(PG8_SB(0, 1), b2 + hstepB, voffB, AUX_B); PG8_STAGE(PG8_SA(0, 0), a2, voffA, AUX_A);
            PG8_WAIT_V(8); PG8_WAIT_L(0); PG8_BAR; PG8_MMA(1, 0, At, B0); PG8_MMA(1, 1, At, B1); PG8_BAR; PG8_SCHED;
            PG8_LDB(B0, 1, 0); PG8_LDB(B1, 1, 1); PG8_SCHED; PG8_LDA(At, 1, 0); PG8_STAGE(PG8_SA(0, 1), a2 + hstepA, voffA, AUX_A);
            PG8_WAIT_V(8); PG8_WAIT_L(0); PG8_BAR; PG8_MMA(0, 0, At, B0); PG8_MMA(0, 1, At, B1); PG8_BAR; PG8_SCHED;
            PG8_LDA(At, 1, 1); PG8_STAGE(PG8_SB(1, 0), b3, voffB, AUX_B); PG8_STAGE(PG8_SB(1, 1), b3 + hstepB, voffB, AUX_B); PG8_STAGE(PG8_SA(1, 0), a3, voffA, AUX_A);
            PG8_WAIT_V(8); PG8_WAIT_L(0); PG8_BAR; PG8_MMA(1, 0, At, B0); PG8_MMA(1, 1, At, B1); PG8_BAR; PG8_SCHED;
            } else {
            PG8_LDB(B0, 0, 0); PG8_SCHED; PG8_LDA(At, 0, 0); PG8_STAGE(PG8_SA(1, 1), a1 + hstepA, voffA, AUX_A);
            PG8_WAIT_L(8); PG8_BAR; PG8_WAIT_L(0); PG8_MMA(0, 0, At, B0); PG8_BAR; PG8_SCHED;
            PG8_LDB(B1, 0, 1); PG8_STAGE(PG8_SB(0, 0), b2, voffB, AUX_B);
            PG8_BAR; PG8_WAIT_L(0); PG8_MMA(0, 1, At, B1); PG8_BAR;
            PG8_LDA(At, 0, 1); PG8_STAGE(PG8_SA(0, 0), a2, voffA, AUX_A);
            PG8_BAR; PG8_WAIT_L(0); PG8_MMA(1, 0, At, B0); PG8_BAR; PG8_SCHED;
            PG8_STAGE(PG8_SB(0, 1), b2 + hstepB, voffB, AUX_B);
            PG8_WAIT_V(6); PG8_BAR; PG8_MMA(1, 1, At, B1); PG8_BAR;
            PG8_LDB(B0, 1, 0); PG8_SCHED; PG8_LDA(At, 1, 0); PG8_STAGE(PG8_SA(0, 1), a2 + hstepA, voffA, AUX_A);
            PG8_WAIT_L(8); PG8_BAR; PG8_WAIT_L(0); PG8_MMA(0, 0, At, B0); PG8_BAR; PG8_SCHED;
            PG8_LDB(B1, 1, 1); PG8_STAGE(PG8_SB(1, 0), b3, voffB, AUX_B);
            PG8_BAR; PG8_WAIT_L(0); PG8_MMA(0, 1, At, B1); PG8_BAR;
            PG8_LDA(At, 1, 1); PG8_STAGE(PG8_SA(1, 0), a3, voffA, AUX_A);
            PG8_BAR; PG8_WAIT_L(0); PG8_MMA(1, 0, At, B0); PG8_BAR; PG8_SCHED;
            PG8_STAGE(PG8_SB(1, 1), b3 + hstepB, voffB, AUX_B);
            PG8_WAIT_V(6); PG8_BAR; PG8_MMA(1, 1, At, B1); PG8_BAR;
            }
        }
        if constexpr (ALIGN_EPI) { if (wr == 0) PG8_BAR; }
        if constexpr (SP2 && EPI_OVERLAP) {
            static_assert(ALIGN_EPI, "EPI_OVERLAP needs the aligned epilogues");
            PG8_STAGE(PG8_SA(1, 1), nA + kstepA + hstepA, voffA, AUX_A); PG8_SCHED; asm volatile("" ::: "memory"); }
        bool part_store_ = false; if constexpr (Sched::SPLIT) part_store_ = (cur.mode == 1);
        if (part_store_) {
            if constexpr (Sched::SPLIT) {
            { f32x4* pp_ = (f32x4*)S.part + tid;
_Pragma("unroll") for (int q = 0; q < 32; ++q) { *pp_ = acc[q >> 4][(q >> 3) & 1][(q >> 1) & 3][q & 1]; pp_ += 512; asm volatile("" : "+v"(pp_)); } } }
        } else
        if constexpr (Sched::DUAL) { if (cur.mode == 0) E.mid(acc, cur, wr, wc, fr, fq); else E(acc, cur, wr, wc, fr, fq); }
        else if constexpr (!Epi::AFTER_DRAIN) { E(acc, cur, wr, wc, fr, fq);
#ifdef EPI_TWICE
            if constexpr (Epi::IDEM) { asm volatile("" ::: "memory"); E(acc, cur, wr, wc, fr, fq); }
#endif
            S.done(cur); }
        if (!has_next) break;
        bool part_load_ = false; if constexpr (Sched::SPLIT) part_load_ = (nxt.mode == 2);
        if (part_load_) { if constexpr (Sched::SPLIT) {
            { const f32x4* pp_ = (const f32x4*)S.part + tid;
_Pragma("unroll") for (int q = 0; q < 32; ++q) { acc[q >> 4][(q >> 3) & 1][(q >> 1) & 3][q & 1] = *pp_; pp_ += 512; asm volatile("" : "+v"(pp_)); } } }
#pragma unroll
            for (int q = 0; q < 32; ++q) asm volatile("" : "+v"(acc[q >> 4][(q >> 3) & 1][(q >> 1) & 3][q & 1]));
        } else if (!(Sched::DUAL && cur.mode == 0)) {
#pragma unroll
        for (int a = 0; a < 2; ++a)
#pragma unroll
            for (int b = 0; b < 2; ++b)
#pragma unroll
                for (int m = 0; m < 4; ++m)
#pragma unroll
                    for (int n = 0; n < 2; ++n) acc[a][b][m][n] = (f32x4){0.f, 0.f, 0.f, 0.f};
        }
        cur = nxt; cA = nA; cB = nB; ++ui; if constexpr (Sched::SPLIT) nt = cur.nt;
        if constexpr (ALIGN_EPI) { if (wr == 1) PG8_BAR; }
    }
    PG8_WAIT_V(0);
    if constexpr (!ALIGN_EPI) { if (wr == 0) PG8_BAR; }
    PG8_BAR;
    if constexpr (Epi::AFTER_DRAIN) { E.fused(acc, cur, wr, wc, fr, fq, lds, wid, lane); S.done(cur); }
#undef PG8_SA
#undef PG8_SB
#undef PG8_STAGE
#undef PG8_LDA
#undef PG8_LDB
#undef PG8_MMA
#undef PG8_WAIT_V
#undef PG8_WAIT_L
#undef PG8_BAR
#undef PG8_SCHED
}
}
#define GAS __attribute__((address_space(1)))
#define LAS __attribute__((address_space(3)))
typedef unsigned short bf16;
typedef unsigned v4u __attribute__((ext_vector_type(4)));
typedef float f32x4 __attribute__((ext_vector_type(4)));
typedef short bf16x8 __attribute__((ext_vector_type(8)));
typedef GAS unsigned gu32;
typedef GAS unsigned long long gu64;
#define RLX_AGENT __ATOMIC_RELAXED, __HIP_MEMORY_SCOPE_AGENT
#define LDS_WAIT() asm volatile("s_waitcnt lgkmcnt(0)" ::: "memory")
#define VM_WAIT() asm volatile("s_waitcnt vmcnt(0)" ::: "memory")
__device__ __forceinline__ unsigned long long rt() { return __builtin_amdgcn_s_memrealtime(); }
__device__ __forceinline__ unsigned f2bf(float f) { unsigned u = __builtin_bit_cast(unsigned, f); return (u + 0x7fffu + ((u >> 16) & 1u)) >> 16; }
__device__ __forceinline__ unsigned pk2(float lo, float hi) { return f2bf(lo) | (f2bf(hi) << 16); }
#define XB_TMO      128
#define XB_XCNT(j)  (256  + 64 * (j))
#define XB_XSUB(j)  (1280 + 64 * (j))
#define XB_XGEN(j)  (2304 + 64 * (j))
#define XB_TOP      3328
#define XB_TOPGEN   3392
#define XCD_BAR_WORDS 3456
#define XB_SPIN_CAP (1u << 18)

__device__ __forceinline__ unsigned xb_ld(unsigned* p)              { return __hip_atomic_load(p, __ATOMIC_RELAXED, __HIP_MEMORY_SCOPE_AGENT); }
__device__ __forceinline__ unsigned xb_add(unsigned* p, unsigned v) { return __hip_atomic_fetch_add(p, v, __ATOMIC_RELAXED, __HIP_MEMORY_SCOPE_AGENT); }
__device__ __forceinline__ unsigned xb_xcc_id() { return (unsigned)__builtin_amdgcn_s_getreg((3 << 11) | 20) & 0xFu; }
#define XB_SPIN(cond, bar) do { unsigned _sp = 0; while (cond) { __builtin_amdgcn_s_sleep(1); \
    if ((++_sp & 255u) == 0u) { if (xb_ld(&(bar)[XB_TMO])) break; if (_sp > XB_SPIN_CAP) { atomicAdd(&(bar)[XB_TMO], 1u); break; } } } } while (0)

struct XcdBarrier {
    unsigned* bar; unsigned x;
    volatile LAS unsigned* st;
};

__device__ __forceinline__ XcdBarrier xcd_barrier_post(unsigned* bar, volatile LAS unsigned* st) {
    XcdBarrier b; b.bar = bar; b.x = xb_xcc_id(); b.st = st;
    if (threadIdx.x == 0) (void)xb_add(&bar[XB_XCNT(b.x)], 1u);
    return b;
}
__device__ __forceinline__ void xcd_barrier_complete(unsigned* bar, unsigned x, unsigned& nloc, unsigned& nx) {
    const unsigned G = gridDim.x * gridDim.y * gridDim.z;
    unsigned sum, cnt, mine, sp = 0u;
    for (;;) {
        sum = 0u; cnt = 0u; mine = 0u;
#pragma unroll
        for (unsigned j = 0; j < 16; ++j) { const unsigned c = xb_ld(&bar[XB_XCNT(j)]); sum += c; cnt += (c > 0u) ? 1u : 0u; mine = (j == x) ? c : mine; }
        if (sum == G) break;
        __builtin_amdgcn_s_sleep(1);
        if ((++sp & 255u) == 0u) { if (xb_ld(&bar[XB_TMO])) break; if (sp > XB_SPIN_CAP) { atomicAdd(&bar[XB_TMO], 1u); break; } }
    }
    nloc = mine > 0u ? mine : 1u; nx = cnt > 0u ? cnt : 1u;
}

__device__ __forceinline__ void xcd_barrier(const XcdBarrier& b) {
    asm volatile("s_waitcnt vmcnt(0)" ::: "memory");
    __syncthreads();
    if (threadIdx.x == 0) {
        unsigned* bar = b.bar;
        __builtin_amdgcn_s_waitcnt(0);
        unsigned nloc = b.st[0], nx = b.st[1];
        if (nloc == 0u) { xcd_barrier_complete(bar, b.x, nloc, nx); b.st[0] = nloc; b.st[1] = nx; }
        const unsigned old = xb_add(&bar[XB_XSUB(b.x)], 1u);
        const unsigned gen = old / nloc;
        if (old + 1u == (gen + 1u) * nloc) {
            __builtin_amdgcn_fence(__ATOMIC_RELEASE, "agent");
            asm volatile("s_waitcnt vmcnt(0)" ::: "memory");
            const unsigned og = xb_add(&bar[XB_TOP], 1u);
            const unsigned tg = og / nx;
            if (og + 1u == (tg + 1u) * nx) xb_add(&bar[XB_TOPGEN], 1u);
            else XB_SPIN(xb_ld(&bar[XB_TOPGEN]) == tg, bar);
            __builtin_amdgcn_fence(__ATOMIC_ACQUIRE, "agent");
            xb_add(&bar[XB_XGEN(b.x)], 1u);
            asm volatile("s_waitcnt vmcnt(0)" ::: "memory");
        } else {
            XB_SPIN(xb_ld(&bar[XB_XGEN(b.x)]) == gen, bar);
            __builtin_amdgcn_fence(__ATOMIC_ACQUIRE, "agent");
            asm volatile("s_waitcnt vmcnt(0)" ::: "memory");
        }
    }
    __syncthreads();
}
constexpr int SEQ = 8192, DM = 4096, NIN = 18432, GW = 2048, SBW = 2048, NH = 16, HD = 128, DFF = 16384, NMODC = 6 * DM;
constexpr float EPS = 1e-6f;
constexpr float QSCALE = 0.12751743f;
constexpr int NWAVES = 8;
#ifndef MK_ONE_LAUNCH
#define MK_ONE_LAUNCH 1
#endif
#ifndef MK_CLK
#define MK_CLK 0
#endif
#ifndef MK_STAMP
#define MK_STAMP 0
#endif
#ifndef MK_DEBUG
#define MK_DEBUG 0
#endif
constexpr size_t MiB = 1u << 20;
constexpr size_t WS_CTL = 0, CTL_ZERO_BYTES = 64 * 1024;
constexpr size_t WS_MOD = 1 * MiB;
constexpr size_t WS_STAT = 1 * MiB + 128 * 1024;
constexpr size_t WS_WIN = 2 * MiB;
constexpr size_t WS_WPA = 146 * MiB, WS_WPB = 162 * MiB;
constexpr size_t WS_WO = 178 * MiB;
constexpr size_t WS_WF1 = 210 * MiB;
constexpr size_t WS_WF2 = 338 * MiB;
constexpr size_t WS_H = 466 * MiB;
constexpr size_t WS_GZ = 530 * MiB;
constexpr size_t WS_QKV = 594 * MiB;
constexpr size_t WS_SA = 690 * MiB, WS_SB = 754 * MiB;
constexpr size_t WS_GA = 818 * MiB, WS_AT = 850 * MiB;
constexpr size_t WS_MIXIN = 882 * MiB;
constexpr size_t WS_MIX = 946 * MiB;
constexpr size_t WS_ACT = 1010 * MiB;
constexpr size_t WS_FF = 1266 * MiB;
constexpr size_t WS_PART = 1330 * MiB;
constexpr size_t WS_SPLIT = 1332 * MiB;
constexpr size_t WS_END = 1396 * MiB;
constexpr int CW_TMO = 0, CW_CODE = 1, CW_BAR = 4096;
constexpr int RING_OFF = 0, RING_BYTES = 131072;
constexpr int LDSCTL_OFF = 139264, MISC_OFF = LDSCTL_OFF + 320;
constexpr int LDS_BYTES = 147456;
typedef unsigned u32x2 __attribute__((ext_vector_type(2)));
typedef unsigned u32x4v __attribute__((ext_vector_type(4)));
struct Frame {
    LAS unsigned char* lds;
    volatile LAS unsigned* MISC;
    gu32* ctl;
    int tid, lane, wave, vcu, G;
    const float *x, *c, *w_ada, *b_ada, *g_pre_mix, *w_in, *g_v, *w_s, *b_s, *w_pa, *w_pb, *w_o, *g_post_mix, *g_pre_mlp, *w_ff1, *w_ff2, *g_post_mlp;
    float* out; unsigned char* ws;
    __device__ __forceinline__ float* mod() const { return (float*)(ws + WS_MOD); }
    __device__ __forceinline__ float* stat() const { return (float*)(ws + WS_STAT); }
    __device__ __forceinline__ float* part() const { return (float*)(ws + WS_PART); }
    __device__ __forceinline__ bf16* Win_t() const { return (bf16*)(ws + WS_WIN); }
    __device__ __forceinline__ bf16* Wpa_t() const { return (bf16*)(ws + WS_WPA); }
    __device__ __forceinline__ bf16* Wpb_t() const { return (bf16*)(ws + WS_WPB); }
    __device__ __forceinline__ bf16* Wo_t() const { return (bf16*)(ws + WS_WO); }
    __device__ __forceinline__ bf16* Wf1_t() const { return (bf16*)(ws + WS_WF1); }
    __device__ __forceinline__ bf16* Wf2_t() const { return (bf16*)(ws + WS_WF2); }
    __device__ __forceinline__ bf16* H() const { return (bf16*)(ws + WS_H); }
    __device__ __forceinline__ bf16* GZ() const { return (bf16*)(ws + WS_GZ); }
    __device__ __forceinline__ bf16* QKV() const { return (bf16*)(ws + WS_QKV); }
    __device__ __forceinline__ bf16* SA() const { return (bf16*)(ws + WS_SA); }
    __device__ __forceinline__ bf16* SB() const { return (bf16*)(ws + WS_SB); }
    __device__ __forceinline__ bf16* GA() const { return (bf16*)(ws + WS_GA); }
    __device__ __forceinline__ bf16* AT() const { return (bf16*)(ws + WS_AT); }
    __device__ __forceinline__ bf16* MIXIN() const { return (bf16*)(ws + WS_MIXIN); }
    __device__ __forceinline__ bf16* MIX() const { return (bf16*)(ws + WS_MIX); }
    __device__ __forceinline__ bf16* ACT() const { return (bf16*)(ws + WS_ACT); }
    __device__ __forceinline__ bf16* FF() const { return (bf16*)(ws + WS_FF); }
};
__device__ __forceinline__ float wave_sum(float v) {
#pragma unroll
    for (int o = 1; o < 64; o <<= 1) v += __shfl_xor(v, o);
    return v;
}
__device__ __forceinline__ unsigned pkbf(float lo, float hi) { return pg8::cvt_pk_bf16(lo, hi); }
__device__ __forceinline__ float bflo(unsigned u) { return __builtin_bit_cast(float, u << 16); }
__device__ __forceinline__ float bfhi(unsigned u) { return __builtin_bit_cast(float, u & 0xffff0000u); }

#ifndef W_TILED
#define W_TILED 1
#endif
#ifndef OUT_TILED
#define OUT_TILED 2
#endif
#ifndef AB_TILED
#define AB_TILED 1
#endif
template <int LAY> __device__ __forceinline__ size_t a_off(int row, int col, int N) {
    if (LAY == 1) return ((((size_t)(row >> 8) * (N >> 6) + (col >> 6)) << 8) + (row & 255)) * 64 + (col & 63);
    if (LAY == 2) return ((((size_t)(row >> 8) * (N >> 5) + (col >> 5)) << 8) + (row & 255)) * 32 + (col & 31);
    return (size_t)row * N + col; }
template <int LAY> __device__ __forceinline__ constexpr size_t a_rowstep(int N) { return LAY == 1 ? (size_t)64 : LAY == 2 ? (size_t)32 : (size_t)N; }
template <int COL0, int NCOLS> __device__ __forceinline__ void p0_gemv(Frame& F) {
    constexpr int NB = 256, CPB = NCOLS / NB, Q = CPB / 4, KL = (NWAVES * 64) / Q;
    static_assert(NCOLS % (4 * NB) == 0 && (NWAVES * 64) % Q == 0 && (KL * CPB + DM) * 4 <= RING_BYTES, "gemv geometry");
    LAS float* sc = (LAS float*)(F.lds + RING_OFF);
    LAS float* red = (LAS float*)(F.lds + RING_OFF + 16384);
    for (int i = F.tid; i < DM; i += NWAVES * 64) { const float cv = F.c[i]; sc[i] = cv / (1.0f + __expf(-cv)); }
    __syncthreads();
    for (int cb = blockIdx.x; cb < NB; cb += F.G) {
        { const int kq = F.tid / Q, cq = F.tid % Q; const float* wp = F.w_ada + (size_t)COL0 + (size_t)CPB * cb + 4 * cq;
            f32x4 a = {0.f, 0.f, 0.f, 0.f};
#pragma unroll 8
            for (int k = kq; k < DM; k += KL) { const f32x4 w = __builtin_nontemporal_load((const f32x4*)(wp + (size_t)k * NMODC)); a = a + w * sc[k]; }
            *(LAS f32x4*)(red + kq * CPB + 4 * cq) = a; }
        __syncthreads();
        if (F.tid < CPB) { float s = 0.f;
#pragma unroll 8
            for (int q = 0; q < KL; ++q) s += red[q * CPB + F.tid];
            F.mod()[COL0 + CPB * cb + F.tid] = s + F.b_ada[COL0 + CPB * cb + F.tid]; }
        __syncthreads();
    }
}
__device__ __forceinline__ void p0_tile_load(f32x4 (&v)[16], const float* W, int N, int item, int lane, int nb0 = 0, int nbn = 0) {
    const int nblk = nbn ? nbn : N / 64, kb = item / nblk, nb = nb0 + item % nblk; const float* src = W + (size_t)(64 * kb + (lane >> 4)) * N + 64 * nb + 4 * (lane & 15);
#pragma unroll
    for (int i = 0; i < 16; ++i) v[i] = __builtin_nontemporal_load((const f32x4*)(src + (size_t)(4 * i) * N));
}
__device__ __forceinline__ void p0_tile_store(const f32x4 (&v)[16], int K, int N, bf16* WT, LAS float* scr, int item, int lane, int nb0 = 0, int nbn = 0) {
    const int nblk = nbn ? nbn : N / 64, kb = item / nblk, nb = nb0 + item % nblk, k0 = 64 * kb, n0 = 64 * nb;
    const int n4 = lane & 15, kr = lane >> 4;
#pragma unroll
    for (int i = 0; i < 16; ++i) { const int k = 4 * i + kr; *(LAS f32x4*)(scr + k * 64 + ((4 * n4 + 8 * (k >> 3)) & 63)) = v[i]; }
    asm volatile("s_waitcnt lgkmcnt(0)" ::: "memory");
    const int c = lane >> 3, nn = lane & 7;
#pragma unroll
    for (int it = 0; it < 8; ++it) { const int n = it * 8 + nn; const LAS float* s = scr + (8 * c) * 64 + ((n + 8 * c) & 63);
        v4u o; o.x = pkbf(s[0], s[64]); o.y = pkbf(s[128], s[192]); o.z = pkbf(s[256], s[320]); o.w = pkbf(s[384], s[448]);
        *(GAS v4u*)(WT + a_off<W_TILED>(n0 + n, k0 + 8 * c, K)) = o; }
    asm volatile("s_waitcnt lgkmcnt(0)" ::: "memory");
}
__device__ __forceinline__ void p0_convert(const float* W, int K, int N, bf16* WT, LAS float* scr, int first, int stride, int lane, int nb0 = 0, int nbn = 0) {
    const int nitems = (K / 64) * (nbn ? nbn : N / 64);
    if (first >= nitems) return;
    f32x4 va[16], vb[16];
    p0_tile_load(va, W, N, first, lane, nb0, nbn);
    for (int it = first;;) {
        const bool n1 = it + stride < nitems; if (n1) p0_tile_load(vb, W, N, it + stride, lane, nb0, nbn);
        p0_tile_store(va, K, N, WT, scr, it, lane, nb0, nbn);
        if (!n1) break; it += stride;
        const bool n2 = it + stride < nitems; if (n2) p0_tile_load(va, W, N, it + stride, lane, nb0, nbn);
        p0_tile_store(vb, K, N, WT, scr, it, lane, nb0, nbn);
        if (!n2) break; it += stride;
    }
}
#ifndef WIN_SPLIT
#define WIN_SPLIT 1
#endif
template <int WHICH> __device__ __forceinline__ void p0_weights(Frame& F) {
    LAS float* scr = (LAS float*)(F.lds + RING_OFF + F.wave * 16384);
    const int gw = F.vcu * NWAVES + F.wave, NGW = F.G * NWAVES;
    if (WHICH & 1) p0_convert(F.w_in, DM, NIN, F.Win_t(), scr, gw, NGW, F.lane, 0, (WHICH & 64) ? 0 : (WIN_SPLIT ? (2 * GW + 3 * SBW) / 64 : 0));
    if (WHICH & 2) p0_convert(F.w_pa, GW, DM, F.Wpa_t(), scr, gw, NGW, F.lane);
    if (WHICH & 4) p0_convert(F.w_pb, SBW, DM, F.Wpb_t(), scr, gw, NGW, F.lane);
    if (WHICH & 8) p0_convert(F.w_o, DM, DM, F.Wo_t(), scr, gw, NGW, F.lane);
    if (WHICH & 16) p0_convert(F.w_ff1, DM, DFF, F.Wf1_t(), scr, gw, NGW, F.lane);
    if (WHICH & 32) p0_convert(F.w_ff2, DFF, DM, F.Wf2_t(), scr, gw, NGW, F.lane);
    if ((WHICH & 64) && !(WHICH & 1)) p0_convert(F.w_in, DM, NIN, F.Win_t(), scr, gw, NGW, F.lane, (2 * GW + 3 * SBW) / 64, (2 * DM) / 64);
}
#ifndef H_TILED
#define H_TILED 1
#endif
#if H_TILED == 2
constexpr int H_JSTEP = 4 * 256 * 64 * 2 / 8;
__device__ __forceinline__ GAS unsigned long long* h_row_ptr(bf16* H, int row, int lane) {
    return (GAS unsigned long long*)(H + (((size_t)(row >> 8) * 128 + (lane >> 3)) * 256 + (row & 255)) * 32) + (lane & 7); }
#elif H_TILED == 1
constexpr int H_JSTEP = 4 * 256 * 64 * 2 / 8;
__device__ __forceinline__ GAS unsigned long long* h_row_ptr(bf16* H, int row, int lane) {
    return (GAS unsigned long long*)(H + (((size_t)(row >> 8) * 64 + (lane >> 4)) * 256 + (row & 255)) * 64) + (lane & 15); }
#else
constexpr int H_JSTEP = 64;
__device__ __forceinline__ GAS unsigned long long* h_row_ptr(bf16* H, int row, int lane) { return (GAS unsigned long long*)(H + (size_t)row * DM) + lane; }
#endif
#if OUT_TILED == 2
constexpr int O_JSTEP = 4 * 256 * 64 * 2 / 8;
__device__ __forceinline__ const GAS u32x2* o_row_ptr(const bf16* O, int row, int lane) {
    return (const GAS u32x2*)(O + (((size_t)(row >> 8) * 128 + (lane >> 3)) * 256 + (row & 255)) * 32) + (lane & 7); }
#elif OUT_TILED == 1
constexpr int O_JSTEP = 4 * 256 * 64 * 2 / 8;
__device__ __forceinline__ const GAS u32x2* o_row_ptr(const bf16* O, int row, int lane) {
    return (const GAS u32x2*)(O + (((size_t)(row >> 8) * 64 + (lane >> 4)) * 256 + (row & 255)) * 64) + (lane & 15); }
#else
constexpr int O_JSTEP = 64;
__device__ __forceinline__ const GAS u32x2* o_row_ptr(const bf16* O, int row, int lane) { return (const GAS u32x2*)(O + (size_t)row * DM) + lane; }
#endif
#ifndef X1_NT
#define X1_NT 0
#endif
#ifndef X1_RECOMP
#define X1_RECOMP 0
#endif
#ifndef T_STAGGER
#define T_STAGGER 40
#endif
#ifndef T_NT
#define T_NT 1
#endif
#define T_LDX(p) ((T_NT & 1) ? __builtin_nontemporal_load(p) : *(p))
#define T_LDL(p) ((T_NT & 2) ? __builtin_nontemporal_load(p) : *(p))
__device__ __forceinline__ void t0_rows(Frame& F) {
    LAS float* Av = (LAS float*)(F.lds + RING_OFF); LAS float* Bv = Av + DM;
    for (int i = F.tid; i < DM; i += NWAVES * 64) { Av[i] = F.g_pre_mix[i] * (1.0f + F.mod()[DM + i]); Bv[i] = F.mod()[i]; }
    __syncthreads();
    const int gw = F.vcu * NWAVES + F.wave, NGW = F.G * NWAVES;
    if (T_STAGGER && F.wave >= 4) __builtin_amdgcn_s_sleep(T_STAGGER);
    for (int row = gw; row < SEQ; row += NGW) {
        const GAS f32x4* xr = (const GAS f32x4*)(F.x + (size_t)row * DM) + F.lane;
        f32x4 v[16]; float s = 0.f;
#pragma unroll
        for (int j = 0; j < 16; ++j) { v[j] = T_LDX(xr + 64 * j); s += (v[j].x * v[j].x + v[j].y * v[j].y) + (v[j].z * v[j].z + v[j].w * v[j].w); }
        const float inv = 1.0f / sqrtf(wave_sum(s) * (1.0f / DM) + EPS);
        GAS unsigned long long* o8 = h_row_ptr(F.H(), row, F.lane);
#pragma unroll
        for (int j = 0; j < 16; ++j) { const f32x4 a = *(LAS f32x4*)(Av + 4 * (F.lane + 64 * j)), b = *(LAS f32x4*)(Bv + 4 * (F.lane + 64 * j));
            const f32x4 h = v[j] * inv * a + b;
            o8[H_JSTEP * j] = (unsigned long long)pkbf(h.x, h.y) | ((unsigned long long)pkbf(h.z, h.w) << 32); if ((j & 3) == 3) asm volatile("" ::: "memory"); }
    }
}
__device__ __forceinline__ void t1_rows(Frame& F) {
    LAS float* G1 = (LAS float*)(F.lds + RING_OFF); LAS float* A2 = G1 + DM; LAS float* B2 = A2 + DM;
    for (int i = F.tid; i < DM; i += NWAVES * 64) { G1[i] = F.mod()[2 * DM + i] * F.g_post_mix[i]; A2[i] = F.g_pre_mlp[i] * (1.0f + F.mod()[4 * DM + i]); B2[i] = F.mod()[3 * DM + i]; }
    __syncthreads();
    const int gw = F.vcu * NWAVES + F.wave, NGW = F.G * NWAVES;
    if (T_STAGGER && F.wave >= 4) __builtin_amdgcn_s_sleep(T_STAGGER);
#define T_STEP(ptr, n) do { (ptr) += (n); asm volatile("" : "+v"(ptr)); } while (0)
    for (int row = gw; row < SEQ; row += NGW) {
        const GAS u32x2* mr = o_row_ptr(F.MIX(), row, F.lane);
        const GAS f32x4* xr = (const GAS f32x4*)(F.x + (size_t)row * DM) + F.lane;
        u32x2 mu[16]; f32x4 v[16];
#pragma unroll
        for (int j = 0; j < 16; ++j) { mu[j] = T_LDL(mr); T_STEP(mr, O_JSTEP); }
#pragma unroll
        for (int j = 0; j < 16; ++j) { v[j] = T_LDX(xr); T_STEP(xr, 64); }
        float s = 0.f;
#pragma unroll
        for (int j = 0; j < 16; ++j) { const float a = bflo(mu[j].x), b = bfhi(mu[j].x), c = bflo(mu[j].y), d = bfhi(mu[j].y); s += (a * a + b * b) + (c * c + d * d); }
        const float inv1 = 1.0f / sqrtf(wave_sum(s) * (1.0f / DM) + EPS);
        GAS f32x4* orow = (GAS f32x4*)(F.out + (size_t)row * DM) + F.lane;
        float s2 = 0.f;
#pragma unroll
        for (int j = 0; j < 16; ++j) { const f32x4 g = *(LAS f32x4*)(G1 + 4 * (F.lane + 64 * j)); const f32x4 m = (f32x4){bflo(mu[j].x), bfhi(mu[j].x), bflo(mu[j].y), bfhi(mu[j].y)};
            v[j] = v[j] + g * (m * inv1); if (!X1_RECOMP) { *orow = v[j]; T_STEP(orow, 64); } s2 += (v[j].x * v[j].x + v[j].y * v[j].y) + (v[j].z * v[j].z + v[j].w * v[j].w); if ((j & 3) == 3) asm volatile("" ::: "memory"); }
        const float inv2 = 1.0f / sqrtf(wave_sum(s2) * (1.0f / DM) + EPS);
        GAS unsigned long long* o8 = h_row_ptr(F.H(), row, F.lane);
#pragma unroll
        for (int j = 0; j < 16; ++j) { const f32x4 a = *(LAS f32x4*)(A2 + 4 * (F.lane + 64 * j)), b = *(LAS f32x4*)(B2 + 4 * (F.lane + 64 * j));
            const f32x4 h = v[j] * inv2 * a + b;
            *o8 = (unsigned long long)pkbf(h.x, h.y) | ((unsigned long long)pkbf(h.z, h.w) << 32); T_STEP(o8, H_JSTEP); if ((j & 3) == 3) asm volatile("" ::: "memory"); }
    }
}
#if X1_RECOMP
__device__ __forceinline__ void t2_rows(Frame& F) {
    LAS float* G2 = (LAS float*)(F.lds + RING_OFF); LAS float* G1 = G2 + DM;
    for (int i = F.tid; i < DM; i += NWAVES * 64) { G2[i] = F.mod()[5 * DM + i] * F.g_post_mlp[i]; G1[i] = F.mod()[2 * DM + i] * F.g_post_mix[i]; }
    __syncthreads();
    const int gw = F.vcu * NWAVES + F.wave, NGW = F.G * NWAVES;
    if (T_STAGGER && F.wave >= 4) __builtin_amdgcn_s_sleep(T_STAGGER);
    for (int row = gw; row < SEQ; row += NGW) {
        const GAS u32x2* fr_ = o_row_ptr(F.FF(), row, F.lane); const GAS u32x2* mr = o_row_ptr(F.MIX(), row, F.lane);
        const GAS f32x4* xr = (const GAS f32x4*)(F.x + (size_t)row * DM) + F.lane;
        GAS f32x4* orow = (GAS f32x4*)(F.out + (size_t)row * DM) + F.lane;
        u32x2 fu[16], mu[16];
#pragma unroll
        for (int j = 0; j < 16; ++j) { mu[j] = *mr; T_STEP(mr, O_JSTEP); }
#pragma unroll
        for (int j = 0; j < 16; ++j) { fu[j] = *fr_; T_STEP(fr_, O_JSTEP); }
        float s1 = 0.f, s3 = 0.f;
#pragma unroll
        for (int j = 0; j < 16; ++j) { const float a = bflo(mu[j].x), b = bfhi(mu[j].x), c = bflo(mu[j].y), d = bfhi(mu[j].y); s1 += (a * a + b * b) + (c * c + d * d); }
#pragma unroll
        for (int j = 0; j < 16; ++j) { const float a = bflo(fu[j].x), b = bfhi(fu[j].x), c = bflo(fu[j].y), d = bfhi(fu[j].y); s3 += (a * a + b * b) + (c * c + d * d); }
        const float inv1 = 1.0f / sqrtf(wave_sum(s1) * (1.0f / DM) + EPS), inv3 = 1.0f / sqrtf(wave_sum(s3) * (1.0f / DM) + EPS);
#define T2_CHUNK(c) do { f32x4 xc[4]; _Pragma("unroll") for (int j = 0; j < 4; ++j) { xc[j] = *xr; T_STEP(xr, 64); } \
            _Pragma("unroll") for (int j = 0; j < 4; ++j) { const int jj = 4 * (c) + j; \
                const f32x4 g1 = *(LAS f32x4*)(G1 + 4 * (F.lane + 64 * jj)), g2 = *(LAS f32x4*)(G2 + 4 * (F.lane + 64 * jj)); \
                const f32x4 m = (f32x4){bflo(mu[jj].x), bfhi(mu[jj].x), bflo(mu[jj].y), bfhi(mu[jj].y)}, f = (f32x4){bflo(fu[jj].x), bfhi(fu[jj].x), bflo(fu[jj].y), bfhi(fu[jj].y)}; \
                const f32x4 x1 = xc[j] + g1 * (m * inv1); *orow = x1 + g2 * (f * inv3); T_STEP(orow, 64); } \
            asm volatile("" ::: "memory"); } while (0)
        asm volatile("" ::: "memory");
        T2_CHUNK(0); T2_CHUNK(1); T2_CHUNK(2); T2_CHUNK(3);
#undef T2_CHUNK
    }
}
#else
__device__ __forceinline__ void t2_rows(Frame& F) {
    LAS float* G2 = (LAS float*)(F.lds + RING_OFF);
    for (int i = F.tid; i < DM; i += NWAVES * 64) G2[i] = F.mod()[5 * DM + i] * F.g_post_mlp[i];
    __syncthreads();
    const int gw = F.vcu * NWAVES + F.wave, NGW = F.G * NWAVES;
    if (T_STAGGER && F.wave >= 4) __builtin_amdgcn_s_sleep(T_STAGGER);
    for (int row = gw; row < SEQ; row += NGW) {
        const GAS u32x2* fr_ = o_row_ptr(F.FF(), row, F.lane);
        GAS f32x4* orow = (GAS f32x4*)(F.out + (size_t)row * DM) + F.lane;
        u32x2 fu[16]; f32x4 v[16];
#pragma unroll
        for (int j = 0; j < 16; ++j) fu[j] = T_LDL(fr_ + O_JSTEP * j);
#pragma unroll
        for (int j = 0; j < 16; ++j) v[j] = T_LDL(orow + 64 * j);
        float s = 0.f;
#pragma unroll
        for (int j = 0; j < 16; ++j) { const float a = bflo(fu[j].x), b = bfhi(fu[j].x), c = bflo(fu[j].y), d = bfhi(fu[j].y); s += (a * a + b * b) + (c * c + d * d); }
        const float inv = 1.0f / sqrtf(wave_sum(s) * (1.0f / DM) + EPS);
#pragma unroll
        for (int j = 0; j < 16; ++j) { const f32x4 g = *(LAS f32x4*)(G2 + 4 * (F.lane + 64 * j)); const f32x4 m = (f32x4){bflo(fu[j].x), bfhi(fu[j].x), bflo(fu[j].y), bfhi(fu[j].y)};
            if (T_NT & 4) __builtin_nontemporal_store(v[j] + g * (m * inv), orow + 64 * j); else orow[64 * j] = v[j] + g * (m * inv); if ((j & 3) == 3) asm volatile("" ::: "memory"); }
    }
}
#endif
__device__ __forceinline__ void gmlp_stats_naive(Frame& F) {
    const int gw = F.vcu * NWAVES + F.wave, NGW = F.G * NWAVES;
    if (T_STAGGER && F.wave >= 4) __builtin_amdgcn_s_sleep(T_STAGGER);
    for (int row = gw; row < SEQ; row += NGW) {
        const GAS u32x2* vr = (const GAS u32x2*)(F.GZ() + (size_t)row * DM + GW) + F.lane;
        f32x4 v[8]; float s = 0.f;
#pragma unroll
        for (int j = 0; j < 8; ++j) { const u32x2 u = vr[64 * j]; v[j] = (f32x4){bflo(u.x), bfhi(u.x), bflo(u.y), bfhi(u.y)}; s += (v[j].x + v[j].y) + (v[j].z + v[j].w); }
        const float mean = wave_sum(s) * (1.0f / GW); float s2 = 0.f;
#pragma unroll
        for (int j = 0; j < 8; ++j) { const f32x4 d = v[j] - mean; s2 += (d.x * d.x + d.y * d.y) + (d.z * d.z + d.w * d.w); }
        const float rstd = 1.0f / sqrtf(wave_sum(s2) * (1.0f / GW) + EPS);
        if (F.lane == 0) { F.stat()[2 * row] = mean; F.stat()[2 * row + 1] = rstd; }
    }
}
__device__ __forceinline__ void gmlp_main_naive(Frame& F) {
    const size_t total = (size_t)SEQ * GW, stride = (size_t)F.G * NWAVES * 64;
    for (size_t idx = (size_t)blockIdx.x * NWAVES * 64 + F.tid; idx < total; idx += stride) {
        const int row = (int)(idx / GW), c = (int)(idx % GW), n = row >> 7, t = row & 127, g = c >> 7;
        const int smax = t < 64 ? 64 : 128;
        const float* wr_ = F.w_s + ((size_t)g * 128 + t) * 128;
        const float gv = F.g_v[c]; float y = 0.f;
        for (int s = 0; s < smax; ++s) { const int r = n * 128 + s; const unsigned short hv = F.GZ()[(size_t)r * DM + GW + c];
            const float vn = (__builtin_bit_cast(float, (unsigned)hv << 16) - __hip_atomic_load(F.stat() + 2 * r, __ATOMIC_RELAXED, __HIP_MEMORY_SCOPE_AGENT)) * __hip_atomic_load(F.stat() + 2 * r + 1, __ATOMIC_RELAXED, __HIP_MEMORY_SCOPE_AGENT) * gv; y += wr_[s] * vn; }
        y += F.b_s[g * 128 + t];
        const float u = __builtin_bit_cast(float, (unsigned)F.GZ()[(size_t)row * DM + c] << 16);
        const unsigned pk = pkbf(u * y, 0.f);
        F.GA()[(size_t)row * GW + c] = (bf16)(pk & 0xffffu);
    }
}
__device__ __forceinline__ void attn_naive(Frame& F) {
    const int gw = F.vcu * NWAVES + F.wave, NGW = F.G * NWAVES;
    for (int item = gw; item < SEQ * NH; item += NGW) {
        const int t = item / NH, h = item % NH;
        const bf16* Q = F.QKV() + ((size_t)(0 * NH + h) * SEQ) * HD; const bf16* K = F.QKV() + ((size_t)(1 * NH + h) * SEQ) * HD; const bf16* V = F.QKV() + ((size_t)(2 * NH + h) * SEQ) * HD;
        const unsigned qq = *(const GAS unsigned*)(Q + (size_t)t * HD + 2 * F.lane);
        const float q0 = bflo(qq), q1 = bfhi(qq);
        float o0 = 0.f, o1 = 0.f, R = 1.0f;
        for (int s = t - 1; s >= 0; --s) {
            const unsigned kk = *(const GAS unsigned*)(K + (size_t)s * HD + 2 * F.lane), vv = *(const GAS unsigned*)(V + (size_t)s * HD + 2 * F.lane);
            const float z2 = wave_sum(q0 * bflo(kk) + q1 * bfhi(kk));
            const float e = __builtin_amdgcn_exp2f(fminf(z2, 120.f)), r = __builtin_amdgcn_rcpf(1.0f + e), a = e * r * R;
            R *= r; o0 += a * bflo(vv); o1 += a * bfhi(vv);
        }
        *(GAS unsigned*)(F.AT() + (size_t)t * SBW + h * HD + 2 * F.lane) = pkbf(o0, o1);
    }
}
namespace sba {
typedef short bf16x8 __attribute__((ext_vector_type(8)));
typedef short s16x4 __attribute__((ext_vector_type(4)));
typedef float f32x16 __attribute__((ext_vector_type(16)));
typedef unsigned u32x4 __attribute__((ext_vector_type(4)));
constexpr int D = 128, KVBLK = 64, QBLK = 32, QB = 256;
constexpr int SHM_V = KVBLK * D * 2, SHM_K = KVBLK * D * 2;
constexpr int LDS_FLAGS = 2 * SHM_V + 2 * SHM_K;
constexpr int LDS_NEED = LDS_FLAGS + 128;
#define KSWZ(row, colB) ((row) * 256 + ((colB) ^ (((row) & 7) << 4)))
#define SBAR() __builtin_amdgcn_sched_barrier(0)
__device__ __forceinline__ int v_st(int k, int c) { const int kk = (k & ~0xC) | ((k & 4) << 1) | ((k & 8) >> 1); return ((kk >> 3) * 4 + (c >> 5)) * 512 + ((kk & 7) * 32 + (c & 31)) * 2; }
__device__ __forceinline__ int v_rd_base(int lane) { return ((lane & 3) << 3) | (((lane >> 2) & 3) << 6) | (((lane >> 4) & 1) << 5) | (((lane >> 5) & 1) << 8); }
constexpr int v_rd_off(int d0, int ks, int half) { return d0 * 512 + ks * 4096 + half * 2048; }
__device__ __forceinline__ int crow(int r, int hi) { return (r & 3) + 8 * (r >> 2) + 4 * hi; }
__device__ __forceinline__ unsigned cvtpk(float lo, float hi) { return pg8::cvt_pk_bf16(lo, hi); }

template <int KB>
__device__ __forceinline__ void qkt(f32x16& p0, f32x16& p1, const LAS char* K_lds, int r32, int hi, const bf16x8* qr) {
    p0 = f32x16{}; p1 = f32x16{};
    const LAS char* kb[4];
#pragma unroll
    for (int dd = 0; dd < 4; ++dd) kb[dd] = K_lds + KB * SHM_K + KSWZ(r32, (dd * 16 + hi * 8) * 2);
#pragma unroll
    for (int d0 = 0; d0 < 8; ++d0) { const LAS char* a = kb[d0 & 3] + (d0 >> 2) * 128;
        bf16x8 b0 = *reinterpret_cast<const LAS bf16x8*>(a);
        bf16x8 b1 = *reinterpret_cast<const LAS bf16x8*>(a + 32 * 256);
        p0 = __builtin_amdgcn_mfma_f32_32x32x16_bf16(b0, qr[d0], p0, 0, 0, 0);
        p1 = __builtin_amdgcn_mfma_f32_32x32x16_bf16(b1, qr[d0], p1, 0, 0, 0); }
}
template <int VB>
__device__ __forceinline__ void pv_tile(f32x16* o, int vb0, bf16x8 pa0, bf16x8 pa1, bf16x8 pa2, bf16x8 pa3) {
#define TRRD(dst, off) asm volatile("ds_read_b64_tr_b16 %0, %1 offset:%2" : "=&v"(dst) : "v"(vb0), "i"(off) : "memory")
#define PV_D0(d0) do { s16x4 l0, l1, l2, l3, h0, h1, h2, h3; constexpr int b_ = VB * SHM_V + v_rd_off(d0, 0, 0); \
        TRRD(l0, b_); TRRD(h0, b_ + 2048); TRRD(l1, b_ + 4096); TRRD(h1, b_ + 6144); TRRD(l2, b_ + 8192); TRRD(h2, b_ + 10240); TRRD(l3, b_ + 12288); TRRD(h3, b_ + 14336); \
        asm volatile("s_waitcnt lgkmcnt(0)" ::: "memory"); SBAR(); \
        o[d0] = __builtin_amdgcn_mfma_f32_32x32x16_bf16(pa0, (bf16x8){l0[0], l0[1], l0[2], l0[3], h0[0], h0[1], h0[2], h0[3]}, o[d0], 0, 0, 0); \
        o[d0] = __builtin_amdgcn_mfma_f32_32x32x16_bf16(pa1, (bf16x8){l1[0], l1[1], l1[2], l1[3], h1[0], h1[1], h1[2], h1[3]}, o[d0], 0, 0, 0); \
        o[d0] = __builtin_amdgcn_mfma_f32_32x32x16_bf16(pa2, (bf16x8){l2[0], l2[1], l2[2], l2[3], h2[0], h2[1], h2[2], h2[3]}, o[d0], 0, 0, 0); \
        o[d0] = __builtin_amdgcn_mfma_f32_32x32x16_bf16(pa3, (bf16x8){l3[0], l3[1], l3[2], l3[3], h3[0], h3[1], h3[2], h3[3]}, o[d0], 0, 0, 0); } while (0)
    PV_D0(0); PV_D0(1); PV_D0(2); PV_D0(3);
#undef PV_D0
#undef TRRD
}
__device__ __forceinline__ void sb_half(f32x16& p, float& R, int hi, bf16x8& paA, bf16x8& paB) {
    f32x16 c;
#pragma unroll
    for (int r = 0; r < 16; ++r) { const float e = __builtin_amdgcn_exp2f(fminf(p[r], 120.f)); c[r] = __builtin_amdgcn_rcpf(1.0f + e); p[r] = e * c[r]; }
    float TE[4], TO[4];
#pragma unroll
    for (int i = 0; i < 4; ++i) { const float T = (c[4 * i] * c[4 * i + 1]) * (c[4 * i + 2] * c[4 * i + 3]);
        auto rr = __builtin_amdgcn_permlane32_swap(__float_as_uint(T), __float_as_uint(T), false, false); TE[i] = __uint_as_float(rr[0]); TO[i] = __uint_as_float(rr[1]); }
    float X[4]; float x = R;
#pragma unroll
    for (int i = 3; i >= 0; --i) { const float xo = x; x *= TO[i]; const float xe = x; x *= TE[i]; X[i] = hi ? xo : xe; }
    R = x;
#pragma unroll
    for (int i = 0; i < 4; ++i) { const float f3 = X[i], f2 = f3 * c[4 * i + 3], f1 = f2 * c[4 * i + 2], f0 = f1 * c[4 * i + 1];
        p[4 * i + 3] *= f3; p[4 * i + 2] *= f2; p[4 * i + 1] *= f1; p[4 * i] *= f0; }
#define PK4(P, B_, OUT) do { unsigned a0 = cvtpk(P[B_+0], P[B_+1]), a1 = cvtpk(P[B_+2], P[B_+3]); \
        unsigned b0 = cvtpk(P[B_+4], P[B_+5]), b1 = cvtpk(P[B_+6], P[B_+7]); \
        auto r0 = __builtin_amdgcn_permlane32_swap(a0, b0, false, false); auto r1 = __builtin_amdgcn_permlane32_swap(a1, b1, false, false); \
        u32x4 w = {r0[0], r1[0], r0[1], r1[1]}; OUT = __builtin_bit_cast(bf16x8, w); } while (0)
    PK4(p, 0, paA); PK4(p, 8, paB);
#undef PK4
}
__device__ __forceinline__ void mask_tile(f32x16& p0, f32x16& p1, int dq) {
    const float NEG = -__builtin_inff();
#pragma unroll
    for (int r = 0; r < 16; ++r) { const int c = (r & 3) + 8 * (r >> 2);
        if (dq - c <= 0) p0[r] = NEG;
        if (dq - c - 32 <= 0) p1[r] = NEG; }
}
template <bool SKIP>
__device__ __forceinline__ void attn_unit(const bf16* Qh, const bf16* Kh, const bf16* Vh, bf16* Oh, int ocol0, int opitch, int P0, LAS char* lds) {
    const int tid = threadIdx.x, wid = __builtin_amdgcn_readfirstlane(tid >> 6), lane = tid & 63, r32 = lane & 31, hi = lane >> 5;
    const int NT = P0 / KVBLK + 4;
    const int qlo = P0 + wid * QBLK, qm = qlo + r32 - 4 * hi;
    LAS char* V_lds = lds; LAS char* K_lds = lds + 2 * SHM_V;
    volatile LAS unsigned* flags = (volatile LAS unsigned*)(lds + LDS_FLAGS);
    const int sr = tid >> 4, sc = (tid & 15) * 8, vst0 = v_st(sr, sc), vst1 = v_st(32 + sr, sc), kws = KSWZ(sr, sc * 2);
    const int vb0 = (int)(uintptr_t)V_lds + v_rd_base(lane);
    bf16x8 qr[8];
#pragma unroll
    for (int d0 = 0; d0 < 8; ++d0) qr[d0] = *(const GAS bf16x8*)(Qh + (size_t)(qlo + r32) * D + d0 * 16 + hi * 8);
    f32x16 o[4] = {}; float R = 1.0f;
    bf16x8 st_v0, st_v1, st_k0, st_k1;
#define KBASE(t) ((NT - 1 - (t)) * KVBLK)
#define SLOAD(t) do { const size_t k0_ = (size_t)KBASE(t); st_v0 = *(const GAS bf16x8*)(Vh + (k0_ + sr) * D + sc); st_v1 = *(const GAS bf16x8*)(Vh + (k0_ + 32 + sr) * D + sc); \
                      st_k0 = *(const GAS bf16x8*)(Kh + (k0_ + sr) * D + sc); st_k1 = *(const GAS bf16x8*)(Kh + (k0_ + 32 + sr) * D + sc); } while (0)
#define SWRITE(bf) do { *(LAS bf16x8*)(V_lds + (bf) * SHM_V + vst0) = st_v0; *(LAS bf16x8*)(V_lds + (bf) * SHM_V + vst1) = st_v1; \
                        *(LAS bf16x8*)(K_lds + (bf) * SHM_K + kws) = st_k0; *(LAS bf16x8*)(K_lds + (bf) * SHM_K + kws + 32 * 256) = st_k1; } while (0)
#define TILE(t, BF) do { const int kb_ = KBASE(t); bool act_ = kb_ < qlo + QBLK - 1; if (SKIP) act_ = act_ && !__all(R == 0.0f); \
        if (act_) { f32x16 p0, p1; bf16x8 pa0, pa1, pa2, pa3; \
            qkt<BF>(p0, p1, K_lds, r32, hi, qr); \
            if (kb_ + KVBLK - 1 >= qlo) mask_tile(p0, p1, qm - kb_); \
            sb_half(p1, R, hi, pa2, pa3); sb_half(p0, R, hi, pa0, pa1); \
            pv_tile<BF>(o, vb0, pa0, pa1, pa2, pa3); } } while (0)
    SLOAD(0); asm volatile("s_waitcnt vmcnt(0)" ::: "memory"); SWRITE(0);
    if (SKIP) { if (tid < 16) flags[tid] = 0u; }
    __syncthreads();
    int t = 0;
    for (;;) {
        if (t + 1 < NT) SLOAD(t + 1);
        TILE(t, 0);
        if (SKIP) { if (lane == 0) flags[wid] = (__all(R == 0.0f) && KBASE(t) <= qlo) ? 1u : 0u; }
        if (t + 1 < NT) { asm volatile("s_waitcnt vmcnt(0)" ::: "memory"); SWRITE(1); }
        __syncthreads();
        ++t; if (t >= NT) break;
        if (SKIP) { unsigned all_ = 1u; for (int w = 0; w < 8; ++w) all_ &= flags[w]; if (all_) break; }
        if (t + 1 < NT) SLOAD(t + 1);
        TILE(t, 1);
        if (SKIP) { if (lane == 0) flags[8 + wid] = (__all(R == 0.0f) && KBASE(t) <= qlo) ? 1u : 0u; }
        if (t + 1 < NT) { asm volatile("s_waitcnt vmcnt(0)" ::: "memory"); SWRITE(0); }
        __syncthreads();
        ++t; if (t >= NT) break;
        if (SKIP) { unsigned all_ = 1u; for (int w = 0; w < 8; ++w) all_ &= flags[8 + w]; if (all_) break; }
    }
    bf16* odst = Oh + a_off<AB_TILED>(qlo + 4 * hi, ocol0 + r32, opitch);
#pragma unroll
    for (int r = 0; r < 16; ++r) { const int dt = (r & 3) + 8 * (r >> 2);
#pragma unroll
        for (int d0 = 0; d0 < 4; ++d0) { const float v = o[d0][r]; const float vn = __shfl_xor(v, 1);
            const size_t coff = AB_TILED == 2 ? (size_t)d0 * (256 * 32) : AB_TILED == 1 ? (size_t)(d0 >> 1) * (256 * 64) + (d0 & 1) * 32 : (size_t)d0 * 32;
            if ((r32 & 1) == 0) *(GAS unsigned*)(odst + (size_t)dt * a_rowstep<AB_TILED>(opitch) + coff) = cvtpk(v, vn); } }
    __syncthreads();
#undef KBASE
#undef SLOAD
#undef SWRITE
#undef TILE
}
#undef KSWZ
#undef SBAR
}
#ifndef ATT_SKIP
#define ATT_SKIP 1
#endif
__device__ __forceinline__ void attn_phase(Frame& F) {
    for (int p = F.vcu; p < NH * 16; p += F.G) {
        const int h = p >> 4, pi = p & 15;
        const bf16* Qh = F.QKV() + ((size_t)(0 * NH + h) * SEQ) * HD; const bf16* Kh = F.QKV() + ((size_t)(1 * NH + h) * SEQ) * HD; const bf16* Vh = F.QKV() + ((size_t)(2 * NH + h) * SEQ) * HD;
        sba::attn_unit<ATT_SKIP != 0>(Qh, Kh, Vh, F.AT(), h * HD, SBW, (31 - pi) * 256, (LAS char*)(F.lds + RING_OFF));
        sba::attn_unit<ATT_SKIP != 0>(Qh, Kh, Vh, F.AT(), h * HD, SBW, pi * 256, (LAS char*)(F.lds + RING_OFF));
    }
}
namespace gm {
typedef short bf16x8 __attribute__((ext_vector_type(8)));
typedef short s16x4 __attribute__((ext_vector_type(4)));
typedef float f32x16 __attribute__((ext_vector_type(16)));
constexpr int LDS_TILES = 0, LDS_STAT = 2 * sba::SHM_V;
__device__ __forceinline__ void gmlp_unit(Frame& F, int n, int q4, LAS char* lds) {
    const int tid = F.tid, wid = F.wave, lane = F.lane, r32 = lane & 31, hi = lane >> 5;
    const int row0 = n * 128;
    LAS float* st = (LAS float*)(lds + LDS_STAT);
    { const int row = tid >> 2, qtr = tid & 3; const GAS f32x4* pp = (const GAS f32x4*)(F.part() + ((size_t)(row0 + row) * 32 + qtr * 8) * 2);
      float s = 0.f, ss = 0.f;
#pragma unroll
      for (int j = 0; j < 4; ++j) { const f32x4 v = pp[j]; s += v.x + v.z; ss += v.y + v.w; }
      s += __shfl_xor(s, 1); ss += __shfl_xor(ss, 1); s += __shfl_xor(s, 2); ss += __shfl_xor(ss, 2);
      const float mean = s * (1.0f / GW), var = fmaxf(ss * (1.0f / GW) - mean * mean, 0.f);
      if (qtr == 0) { st[row] = mean; st[128 + row] = 1.0f / sqrtf(var + EPS); } }
    __syncthreads();
    const int tb = wid >> 1, nks = tb < 2 ? 4 : 8;
    const int vb = (int)(uintptr_t)(lds + LDS_TILES) + sba::v_rd_base(lane);
    const int cc = (tid & 15) * 8;
    const size_t zstep = (size_t)32 * a_rowstep<OUT_TILED>(DM);
    u32x4v raw[4];
    { const bf16* zsrc = F.GZ() + a_off<OUT_TILED>(row0 + (tid >> 4), GW + (4 * q4) * 128 + cc, DM);
#pragma unroll
      for (int it = 0; it < 4; ++it) raw[it] = *(const GAS u32x4v*)(zsrc + it * zstep); }
    for (int gi = 0; gi < 4; ++gi) { const int g = 4 * q4 + gi;
        const f32x4 g0 = *(const GAS f32x4*)(F.g_v + g * 128 + cc), g1 = *(const GAS f32x4*)(F.g_v + g * 128 + cc + 4);
        f32x4 wa[8], wb[8];
        { const float* wrow = F.w_s + ((size_t)g * 128 + 32 * tb + r32) * 128 + 8 * hi;
#pragma unroll
          for (int ks = 0; ks < 8; ++ks) { if (ks < nks) { wa[ks] = *(const GAS f32x4*)(wrow + 16 * ks); wb[ks] = *(const GAS f32x4*)(wrow + 16 * ks + 4); } else { wa[ks] = f32x4{}; wb[ks] = f32x4{}; } } }
        const int tbase = 32 * tb + 4 * hi;
        unsigned short uv[2][16]; float bs[16];
#pragma unroll
        for (int r = 0; r < 16; ++r) bs[r] = F.b_s[g * 128 + tbase + (r & 3) + 8 * (r >> 2)];
#pragma unroll
        for (int dd = 0; dd < 2; ++dd) { const bf16* usrc = F.GZ() + a_off<OUT_TILED>(row0 + tbase, g * 128 + (2 * (wid & 1) + dd) * 32 + r32, DM);
#pragma unroll
            for (int r = 0; r < 16; ++r) uv[dd][r] = usrc[(size_t)((r & 3) + 8 * (r >> 2)) * a_rowstep<OUT_TILED>(DM)]; }
#pragma unroll
        for (int it = 0; it < 4; ++it) { const int s = (it * 512 + tid) >> 4; const u32x4v rw = raw[it];
            const float mu = st[s], rs = st[128 + s];
            u32x4v w; w.x = pkbf((bflo(rw.x) - mu) * rs * g0.x, (bfhi(rw.x) - mu) * rs * g0.y); w.y = pkbf((bflo(rw.y) - mu) * rs * g0.z, (bfhi(rw.y) - mu) * rs * g0.w);
            w.z = pkbf((bflo(rw.z) - mu) * rs * g1.x, (bfhi(rw.z) - mu) * rs * g1.y); w.w = pkbf((bflo(rw.w) - mu) * rs * g1.z, (bfhi(rw.w) - mu) * rs * g1.w);
            *(LAS u32x4v*)(lds + LDS_TILES + (s >> 6) * sba::SHM_V + sba::v_st(s & 63, cc)) = w; }
        if (gi < 3) { const bf16* zsrc = F.GZ() + a_off<OUT_TILED>(row0 + (tid >> 4), GW + (g + 1) * 128 + cc, DM);
#pragma unroll
            for (int it = 0; it < 4; ++it) raw[it] = *(const GAS u32x4v*)(zsrc + it * zstep); }
        __syncthreads();
        bf16x8 afr[8];
#pragma unroll
        for (int ks = 0; ks < 8; ++ks) { u32x4v w = {pkbf(wa[ks].x, wa[ks].y), pkbf(wa[ks].z, wa[ks].w), pkbf(wb[ks].x, wb[ks].y), pkbf(wb[ks].z, wb[ks].w)}; afr[ks] = __builtin_bit_cast(bf16x8, w); }
#pragma unroll
        for (int dd = 0; dd < 2; ++dd) { const int d0 = 2 * (wid & 1) + dd; const int vbd = vb + d0 * 512;
            f32x16 acc = {};
#define GTR(dst, off) asm volatile("ds_read_b64_tr_b16 %0, %1 offset:%2" : "=&v"(dst) : "v"(vbd), "i"(off) : "memory")
#define GSTEP(ks) do { if ((ks) < nks) { s16x4 l, h; GTR(l, ((ks) >> 2) * sba::SHM_V + ((ks) & 3) * 4096); GTR(h, ((ks) >> 2) * sba::SHM_V + ((ks) & 3) * 4096 + 2048); \
                asm volatile("s_waitcnt lgkmcnt(0)" ::: "memory"); __builtin_amdgcn_sched_barrier(0); \
                acc = __builtin_amdgcn_mfma_f32_32x32x16_bf16(afr[ks], (bf16x8){l[0], l[1], l[2], l[3], h[0], h[1], h[2], h[3]}, acc, 0, 0, 0); } } while (0)
            GSTEP(0); GSTEP(1); GSTEP(2); GSTEP(3); GSTEP(4); GSTEP(5); GSTEP(6); GSTEP(7);
#undef GSTEP
#undef GTR
            bf16* odst = F.GA() + a_off<AB_TILED>(row0 + tbase, g * 128 + d0 * 32 + r32, GW);
#pragma unroll
            for (int r = 0; r < 16; ++r) { const int dt = (r & 3) + 8 * (r >> 2);
                const float y = acc[r] + bs[r];
                const float u = __builtin_bit_cast(float, (unsigned)uv[dd][r] << 16);
                const float v = u * y, vn = __shfl_xor(v, 1);
                if ((r32 & 1) == 0) *(GAS unsigned*)(odst + (size_t)dt * a_rowstep<AB_TILED>(GW)) = pkbf(v, vn); } }
        __syncthreads();
    }
}
__device__ __forceinline__ void gmlp_phase(Frame& F) {
    for (int u = F.vcu; u < (SEQ / 128) * 4; u += F.G) gmlp_unit(F, u >> 2, u & 3, (LAS char*)(F.lds + RING_OFF));
}
}
constexpr int N_PHASES = 11;
struct Args { const float* in[17]; float* out; unsigned char* ws; int ph_lo, ph_hi; };
__global__ void __launch_bounds__(NWAVES * 64, 2) fwd(Args args) {
    extern __shared__ __attribute__((aligned(16))) unsigned char lds[];
    Frame F;
    F.lds = (LAS unsigned char*)lds;
    F.MISC = (volatile LAS unsigned*)(F.lds + MISC_OFF);
    F.tid = threadIdx.x; F.lane = F.tid & 63; F.wave = __builtin_amdgcn_readfirstlane(F.tid >> 6);
    F.G = gridDim.x; { const int bx = blockIdx.x; F.vcu = (F.G % 8 == 0) ? (bx % 8) * (F.G / 8) + bx / 8 : bx; }
    unsigned char* ws = args.ws;
    F.ctl = (gu32*)(ws + WS_CTL);
    F.x = args.in[0]; F.c = args.in[1]; F.w_ada = args.in[2]; F.b_ada = args.in[3]; F.g_pre_mix = args.in[4]; F.w_in = args.in[5]; F.g_v = args.in[6]; F.w_s = args.in[7]; F.b_s = args.in[8];
    F.w_pa = args.in[9]; F.w_pb = args.in[10]; F.w_o = args.in[11]; F.g_post_mix = args.in[12]; F.g_pre_mlp = args.in[13]; F.w_ff1 = args.in[14]; F.w_ff2 = args.in[15]; F.g_post_mlp = args.in[16];
    F.out = args.out; F.ws = ws;
    for (int u = F.tid; u < (LDS_BYTES - LDSCTL_OFF) / 4; u += NWAVES * 64) ((LAS unsigned*)(F.lds + LDSCTL_OFF))[u] = 0u;
    __syncthreads();
    const int lo = args.ph_lo, hi = args.ph_hi;
    XcdBarrier bar; bar.bar = (unsigned*)(F.ctl + CW_BAR); bar.x = 0; bar.st = nullptr;
    if (hi - lo > 1) bar = xcd_barrier_post((unsigned*)(F.ctl + CW_BAR), F.MISC + 8);
#if OUT_TILED
#define EPI_T(a) pg8::EpiAct<a, OUT_TILED>
#define EPI_T0 , 0
#else
#define EPI_T(a) pg8::EpiAct<a, 0>
#define EPI_T0 , 0
#endif
#ifndef W_T1
#define W_T1 16
#endif
#ifndef W_T0
#define W_T0 1
#endif
#ifndef GEMV_LATE
#define GEMV_LATE 0
#endif
#ifndef W_FIRST
#define W_FIRST 0
#endif
#ifndef W_P4
#define W_P4 (WIN_SPLIT ? 70 : 6)
#endif
#ifndef W_P8
#define W_P8 32
#endif
#ifndef W_P5
#define W_P5 8
#endif
#ifndef W_P6
#define W_P6 0
#endif
#define W_P0 (63 & ~(W_T1) & ~(W_T0) & ~(W_P4) & ~(W_P8) & ~(W_P5) & ~(W_P6))
#ifndef FFN_MSPLIT
#define FFN_MSPLIT 0
#endif
#ifndef GATES_IN_P5
#define GATES_IN_P5 1
#endif
#ifndef GEMM_EPIOV
#define GEMM_EPIOV 0
#endif
#ifndef FF2_KREV
#define FF2_KREV 0
#endif
#ifndef GEMM_SPLIT
#define GEMM_SPLIT 0
#endif
#if GEMM_SPLIT
#define SPLIT_ORDER pg8::SplitOrder
#define SPLIT_INIT(S, M_, N_, G_, c_, ntk_) S.init(M_, N_, G_, c_, ntk_, (float*)(ws + WS_SPLIT) + (size_t)blockIdx.x * 65536)
#else
#define SPLIT_ORDER pg8::StaticOrder
#define SPLIT_INIT(S, M_, N_, G_, c_, ntk_) S.init(M_, N_, G_, c_)
#endif
#ifndef W_TILED
#define W_TILED 1
#endif
#ifndef MIXIN_TILED
#define MIXIN_TILED 2
#endif
#ifndef ACT_TILED
#define ACT_TILED 2
#endif
#ifndef GEMM_ALIGN
#define GEMM_ALIGN true
#endif
#ifndef GEMM_SP2
#define GEMM_SP2 true
#endif
#ifndef REP_G
#define REP_G 0
#endif
#if REP_G
#define GREP(i) , ((((REP_G) >> (i)) & 1) ? 2 : 1)
#else
#define GREP(i)
#endif
#ifndef REP_MASK
#define REP_MASK 0
#endif
#if REP_MASK
#define REPFOR(p) for (int rep_ = 0; rep_ < (((REP_MASK >> (p)) & 1) ? 2 : 1); ++rep_)
#else
#define REPFOR(p)
#endif
#ifndef PH_MASK
#define PH_MASK 0x7ff
#endif
#define IN(k) (((PH_MASK >> (k)) & 1) && lo <= (k) && (k) < hi)
#define BOTH(k) (IN(k) && IN((k) + 1))
#ifdef BAR_TWICE
#define GRID_BAR() do { xcd_barrier(bar); xcd_barrier(bar); } while (0)
#else
#define GRID_BAR() xcd_barrier(bar)
#endif
#ifndef P5_FUSED
#define P5_FUSED 1
#endif
#ifndef W_STAG
#define W_STAG 0
#endif
#ifndef TEAM_SEL
#define TEAM_SEL ((int)blockIdx.x >> 3)
#endif
#define TEAM_B(k) ((((W_STAG) >> (k)) & 1) && ((TEAM_SEL) & 1))
#ifndef SKEW_SHIFT
#define SKEW_SHIFT 1
#endif
#ifndef SKEW_TICKS
#define SKEW_TICKS 0
#endif
#define XCD_SKEW() do { if (SKEW_TICKS) { const unsigned long long t0_ = __builtin_amdgcn_s_memrealtime(), w_ = (unsigned long long)((blockIdx.x & 7) >> SKEW_SHIFT) * SKEW_TICKS; \
        while (__builtin_amdgcn_s_memrealtime() - t0_ < w_) __builtin_amdgcn_s_sleep(2); } } while (0)
#if MK_STAMP
    unsigned long long* const ts_ = (unsigned long long*)(ws + WS_END + 8192);
#define STAMP(k) do { if (blockIdx.x == 0 && F.tid == 0) ts_[k] = __builtin_amdgcn_s_memrealtime(); } while (0)
#else
#define STAMP(k) do { } while (0)
#endif
    STAMP(0);
    REPFOR(0)
    if (IN(0)) {
#if GEMV_LATE
        p0_gemv<0, 2 * DM>(F);
#else
        p0_gemv<0, 2 * DM>(F); p0_gemv<2 * DM, 4 * DM>(F);
#endif
#ifdef GEMV_REP
        p0_gemv<0, 2 * DM>(F); p0_gemv<2 * DM, 4 * DM>(F);
#endif
#ifdef WCONV_REP
        p0_weights<W_P0>(F);
#endif
        p0_weights<W_P0>(F); if (BOTH(0)) GRID_BAR(); }
    STAMP(1);
    REPFOR(1)
    if (IN(1)) {
#ifdef T0_REP
        _Pragma("unroll 1") for (int rep1 = 0; rep1 < T0_REP; ++rep1) { t0_rows(F); __syncthreads(); }
#endif
        if (W_T0 && W_FIRST) { p0_weights<W_T0>(F); __syncthreads(); } t0_rows(F); if (GEMV_LATE) { __syncthreads(); p0_gemv<2 * DM, 4 * DM>(F); } if (W_T0 && !W_FIRST) { __syncthreads(); p0_weights<W_T0>(F); } if (BOTH(1)) GRID_BAR(); }
    STAMP(2);
    REPFOR(2)
    if (IN(2)) { XCD_SKEW();
#if !GATES_IN_P5
        { pg8::Gemm g{F.H(), F.Win_t() + (size_t)(2 * GW + 3 * SBW) * DM, SEQ, 2 * DM, DM}; SPLIT_ORDER S; SPLIT_INIT(S, SEQ, 2 * DM, F.G, (int)blockIdx.x, DM / 64);
          EPI_T(3) E{F.SA(), 2 * DM EPI_T0};
          pg8::gemm_phase<EPI_T(3), SPLIT_ORDER, GEMM_ALIGN, GEMM_SP2, H_TILED, W_TILED != 0, false, false>(F.lds + RING_OFF, g, S, E); }
#endif
        { pg8::Gemm g{F.H(), F.Win_t() + (size_t)(2 * GW) * DM, SEQ, 3 * SBW, DM}; SPLIT_ORDER S; SPLIT_INIT(S, SEQ, 3 * SBW, F.G, (int)blockIdx.x, DM / 64);
          pg8::EpiQKV E{F.QKV(), SEQ, QSCALE};
          pg8::gemm_phase<pg8::EpiQKV, SPLIT_ORDER, GEMM_ALIGN, GEMM_SP2, H_TILED, W_TILED != 0, false, false>(F.lds + RING_OFF, g, S, E); }
        { pg8::Gemm g{F.H(), F.Win_t(), SEQ, GW, DM}; pg8::StaticOrder S; S.init(SEQ, GW, F.G, (int)blockIdx.x GREP(0));
          EPI_T(2) E{F.GZ(), DM EPI_T0};
          pg8::gemm_phase<EPI_T(2), pg8::StaticOrder, GEMM_ALIGN, GEMM_SP2, H_TILED, W_TILED != 0, false, false>(F.lds + RING_OFF, g, S, E); }
        { pg8::Gemm g{F.H(), F.Win_t() + (size_t)GW * DM, SEQ, GW, DM}; pg8::StaticOrder S; S.init(SEQ, GW, F.G, (int)blockIdx.x GREP(1));
          pg8::EpiGeluStats<OUT_TILED> E{F.GZ(), DM, GW / 256, F.part()};
          pg8::gemm_phase<pg8::EpiGeluStats<OUT_TILED>, pg8::StaticOrder, GEMM_ALIGN, GEMM_SP2, H_TILED, W_TILED != 0, false, false>(F.lds + RING_OFF, g, S, E); }
        if (BOTH(2)) GRID_BAR();
    }
#ifndef GMLP_FAST
#define GMLP_FAST 1
#endif
    STAMP(3);
    REPFOR(3)
    if (IN(3)) { if (!GMLP_FAST) { gmlp_stats_naive(F); if (BOTH(3)) GRID_BAR(); } }
#ifndef ATT_FAST
#define ATT_FAST 1
#endif
    STAMP(4);
    REPFOR(4)
    if (IN(4)) {
#ifdef P4_REP
        _Pragma("unroll 1") for (int rep4 = 0; rep4 < P4_REP; ++rep4) { if (P4_REP_WHAT & 1) gm::gmlp_phase(F); if (P4_REP_WHAT & 2) attn_phase(F); __syncthreads(); }
#endif
        if ((W_P4) != 0 && TEAM_B(4)) { p0_weights<W_P4>(F); __syncthreads(); }
        if (GMLP_FAST) gm::gmlp_phase(F); else gmlp_main_naive(F); if (ATT_FAST) attn_phase(F); else attn_naive(F); if ((W_P4) != 0 && !TEAM_B(4)) { __syncthreads(); p0_weights<W_P4>(F); } if (BOTH(4)) GRID_BAR(); }
    STAMP(5);
    REPFOR(5)
    if (IN(5)) { XCD_SKEW();
        if (W_P5 && TEAM_B(5)) { p0_weights<W_P5>(F); __syncthreads(); }
#if GATES_IN_P5
        { pg8::Gemm g{F.H(), F.Win_t() + (size_t)(2 * GW + 3 * SBW) * DM, SEQ, 2 * DM, DM}; pg8::GateOrder S; S.init(SEQ, DM, F.G, (int)blockIdx.x);
          EPI_T(3) E{F.SA(), 2 * DM EPI_T0};
          pg8::gemm_phase<EPI_T(3), pg8::GateOrder, GEMM_ALIGN, GEMM_SP2, H_TILED, W_TILED != 0, false, false>(F.lds + RING_OFF, g, S, E); }
#endif
#if P5_FUSED
        { pg8::Gemm g{F.GA(), F.Wpa_t(), SEQ, DM, GW}; pg8::DualOrder S; S.init(SEQ, DM, F.G, (int)blockIdx.x);
          pg8::EpiGateDual<MIXIN_TILED, OUT_TILED> E{F.SA(), 2 * DM, 0, DM / 256, F.MIXIN(), DM};
          pg8::gemm_phase<pg8::EpiGateDual<MIXIN_TILED, OUT_TILED>, pg8::DualOrder, GEMM_ALIGN, GEMM_SP2, AB_TILED, W_TILED != 0, false, false>(F.lds + RING_OFF, g, S, E, F.AT(), F.Wpb_t()); }
#else
        { pg8::Gemm g{F.GA(), F.Wpa_t(), SEQ, DM, GW}; pg8::StaticOrder S; S.init(SEQ, DM, F.G, (int)blockIdx.x GREP(4));
          pg8::EpiGate<true, MIXIN_TILED, OUT_TILED> E{F.SA(), 2 * DM, 0, F.MIXIN(), DM};
          pg8::gemm_phase<pg8::EpiGate<true, MIXIN_TILED, OUT_TILED>, pg8::StaticOrder, GEMM_ALIGN, GEMM_SP2, AB_TILED, W_TILED != 0, false, false>(F.lds + RING_OFF, g, S, E); }
        { pg8::Gemm g{F.AT(), F.Wpb_t(), SEQ, DM, SBW}; pg8::StaticOrder S; S.init(SEQ, DM, F.G, (int)blockIdx.x GREP(5));
          pg8::EpiGate<false, MIXIN_TILED, OUT_TILED> E{F.SA(), 2 * DM, DM / 256, F.MIXIN(), DM};
          pg8::gemm_phase<pg8::EpiGate<false, MIXIN_TILED, OUT_TILED>, pg8::StaticOrder, GEMM_ALIGN, GEMM_SP2, AB_TILED, W_TILED != 0, false, false>(F.lds + RING_OFF, g, S, E); }
#endif
        if (W_P5 && !TEAM_B(5)) { p0_weights<W_P5>(F); }
        if (BOTH(5)) GRID_BAR();
    }
    STAMP(6);
    REPFOR(6)
    if (IN(6)) { XCD_SKEW();
        if (W_P6 && TEAM_B(6)) { p0_weights<W_P6>(F); __syncthreads(); }
        pg8::Gemm g{F.MIXIN(), F.Wo_t(), SEQ, DM, DM}; pg8::StaticOrder S; S.init(SEQ, DM, F.G, (int)blockIdx.x GREP(6));
        EPI_T(0) E{F.MIX(), DM EPI_T0};
        pg8::gemm_phase<EPI_T(0), pg8::StaticOrder, GEMM_ALIGN, GEMM_SP2, MIXIN_TILED, W_TILED != 0, false, false>(F.lds + RING_OFF, g, S, E);
        if (W_P6 && !TEAM_B(6)) { p0_weights<W_P6>(F); }
        if (BOTH(6)) GRID_BAR();
    }
    STAMP(7);
    REPFOR(7)
    if (IN(7)) {
#ifdef T1_REP
        _Pragma("unroll 1") for (int rep7 = 0; rep7 < T1_REP; ++rep7) { t1_rows(F); __syncthreads(); }
#endif
        if (W_T1 && W_FIRST) { p0_weights<W_T1>(F); __syncthreads(); } t1_rows(F); if (W_T1 && !W_FIRST) { __syncthreads(); p0_weights<W_T1>(F); } if (BOTH(7)) GRID_BAR(); }
    STAMP(8);
    REPFOR(8)
#if FFN_MSPLIT
    if (IN(8) && IN(9)) {
        _Pragma("unroll") for (int mh = 0; mh < 2; ++mh) { const size_t r0 = (size_t)mh * (SEQ / 2);
            { pg8::Gemm g{F.H() + r0 * DM, F.Wf1_t(), SEQ / 2, DFF, DM}; pg8::StaticOrder S; S.init(SEQ / 2, DFF, F.G, (int)blockIdx.x);
              pg8::EpiActTiled<1> E{F.ACT() + r0 * DFF, DFF, 0};
              pg8::gemm_phase<pg8::EpiAct<1, ACT_TILED>, pg8::StaticOrder, GEMM_ALIGN, GEMM_SP2, H_TILED, W_TILED != 0, false, GEMM_EPIOV != 0>(F.lds + RING_OFF, g, S, E); }
            GRID_BAR();
            { pg8::Gemm g{F.ACT() + r0 * DFF, F.Wf2_t(), SEQ / 2, DM, DFF}; pg8::StaticOrder S; S.init(SEQ / 2, DM, F.G, (int)blockIdx.x);
              EPI_T(0) E{F.FF() + r0 * DM, DM EPI_T0};
              pg8::gemm_phase<EPI_T(0), pg8::StaticOrder, GEMM_ALIGN, GEMM_SP2, ACT_TILED, W_TILED != 0, false, false>(F.lds + RING_OFF, g, S, E); }
            GRID_BAR(); }
    }
#else
    if (IN(8)) { XCD_SKEW();
        if (W_P8 && TEAM_B(8)) { p0_weights<W_P8>(F); __syncthreads(); }
        pg8::Gemm g{F.H(), F.Wf1_t(), SEQ, DFF, DM}; SPLIT_ORDER S; SPLIT_INIT(S, SEQ, DFF, F.G, (int)blockIdx.x, DM / 64);
        #if ACT_TILED
        pg8::EpiAct<1, ACT_TILED> E{F.ACT(), DFF, 0};
        pg8::gemm_phase<pg8::EpiAct<1, ACT_TILED>, SPLIT_ORDER, GEMM_ALIGN, GEMM_SP2, H_TILED, W_TILED != 0, false, GEMM_EPIOV != 0>(F.lds + RING_OFF, g, S, E);
#else
        pg8::EpiAct<1, 0> E{F.ACT(), DFF, 0};
        pg8::gemm_phase<pg8::EpiAct<1, 0>, SPLIT_ORDER, GEMM_ALIGN, GEMM_SP2, H_TILED, W_TILED != 0, false, GEMM_EPIOV != 0>(F.lds + RING_OFF, g, S, E);
#endif
#ifdef W8_REP
        p0_weights<W_P8>(F); __syncthreads();
#endif
        if (W_P8 && !TEAM_B(8)) { p0_weights<W_P8>(F); }
        if (BOTH(8)) GRID_BAR();
    }
    STAMP(9);
    REPFOR(9)
#if MK_CLK
    unsigned long long clk_c0 = 0, clk_r0 = 0;
    if (blockIdx.x == 0 && F.tid == 0) { clk_c0 = __builtin_amdgcn_s_memtime(); clk_r0 = __builtin_amdgcn_s_memrealtime(); }
#endif
    if (IN(9)) { XCD_SKEW();
#ifdef HALF_CU_P9
        pg8::Gemm g{F.ACT(), F.Wf2_t(), SEQ, DM, DFF}; pg8::StaticOrder S; S.init(SEQ, DM, (blockIdx.x & 8) ? 1 : F.G / 2, (blockIdx.x & 8) ? 1000000 : (int)((blockIdx.x & 7) | ((blockIdx.x >> 4) << 3)));
#else
        pg8::Gemm g{F.ACT(), F.Wf2_t(), SEQ, DM, DFF}; pg8::StaticOrder S; S.init(SEQ, DM, F.G, (int)blockIdx.x GREP(8));
#endif
        EPI_T(0) E{F.FF(), DM EPI_T0};
        pg8::gemm_phase<EPI_T(0), pg8::StaticOrder, GEMM_ALIGN, GEMM_SP2, ACT_TILED, W_TILED != 0, FF2_KREV != 0, false>(F.lds + RING_OFF, g, S, E);
        if (BOTH(9)) GRID_BAR();
    }
#endif
    STAMP(10);
    REPFOR(10)
#if MK_CLK
    if (blockIdx.x == 0 && F.tid == 0) { const unsigned long long c1 = __builtin_amdgcn_s_memtime(), r1 = __builtin_amdgcn_s_memrealtime();
        ((unsigned long long*)(ws + WS_END + 8192))[0] = c1 - clk_c0; ((unsigned long long*)(ws + WS_END + 8192))[1] = r1 - clk_r0; }
#endif
    if (IN(10)) { t2_rows(F); }
    STAMP(11);
#undef IN
#undef BOTH
#undef GRID_BAR
}

extern "C" void kernel_launch(void* const* d_in, const int* in_sizes, int n_in, void* d_out, int out_size, void* d_ws, size_t ws_size, hipStream_t stream) {
    static int grid = 0;
    if (grid == 0) {
        if (n_in != 17 || out_size != SEQ * DM || ws_size < WS_END) { fprintf(stderr, "kernel_launch: unexpected shapes (n_in %d out %d ws %zu)\n", n_in, out_size, ws_size); grid = -1; return; }
        int dev = 0, cus = 0, per_cu = 0;
        if (hipGetDevice(&dev) != hipSuccess || hipDeviceGetAttribute(&cus, hipDeviceAttributeMultiprocessorCount, dev) != hipSuccess) { grid = -1; return; }
        if (hipFuncSetAttribute((const void*)fwd, hipFuncAttributeMaxDynamicSharedMemorySize, LDS_BYTES) != hipSuccess) { fprintf(stderr, "kernel_launch: hipFuncSetAttribute failed\n"); grid = -1; return; }
        if (hipOccupancyMaxActiveBlocksPerMultiprocessor(&per_cu, (const void*)fwd, NWAVES * 64, LDS_BYTES) != hipSuccess || per_cu < 1)
            fprintf(stderr, "kernel_launch: note: occupancy query reports %d workgroups per CU\n", per_cu);
        (void)hipGetLastError();
        grid = cus;
    }
    if (grid < 0) return;
    (void)hipMemsetAsync((char*)d_ws + WS_CTL, 0, CTL_ZERO_BYTES, stream);
    Args a{};
    for (int i = 0; i < 17; ++i) a.in[i] = (const float*)d_in[i];
    a.out = (float*)d_out; a.ws = (unsigned char*)d_ws;
#if MK_ONE_LAUNCH
    a.ph_lo = 0; a.ph_hi = N_PHASES;
    hipLaunchKernelGGL(fwd, dim3(grid), dim3(NWAVES * 64), LDS_BYTES, stream, a);
#if MK_CLK
    hipLaunchKernelGGL(clk_leak, dim3(1), dim3(1), 0, stream, a);
#endif
#if MK_STAMP
    hipLaunchKernelGGL(stamp_leak, dim3(SEQ * DM / 256), dim3(256), 0, stream, a);
#endif
#else
#if MK_DEBUG
    (void)hipMemsetAsync((char*)d_ws + WS_DBG, 0, 4096, stream);
#endif
    for (int p = 0; p < N_PHASES; ++p) { a.ph_lo = p; a.ph_hi = p + 1; hipLaunchKernelGGL(fwd, dim3(grid), dim3(NWAVES * 64), LDS_BYTES, stream, a);
#if MK_DEBUG
        static const int chk[N_PHASES][3] = {{1, 0, 0}, {2, 0, 0}, {3, 4, 5}, {0, 0, 0}, {0, 0, 0}, {8, 0, 0}, {9, 0, 0}, {13, 0, 0}, {11, 0, 0}, {12, 0, 0}, {14, 0, 0}};
        for (int q = 0; q < 3; ++q) if (chk[p][q]) { Args b = a; b.ph_lo = chk[p][q]; b.ph_hi = 0; hipLaunchKernelGGL(dbg_check, dim3(2048), dim3(64), 0, stream, b); }
#endif
    }
#if MK_DEBUG
    hipLaunchKernelGGL(dbg_leak, dim3(1), dim3(1), 0, stream, a);
#endif
#endif
}
```
